# Optimizing an MI355X kernel written in HIP

```python
import math
import jax, jax.numpy as jnp
from jax import lax
import numpy as np

D_MODEL = 1024
BATCH = 8
SEQ = 4096
DEPTH = 1

HEAD_DIM = 64
SWA_Q_HEADS = 8
SWA_KV_HEADS = 2
SWA_GROUP = SWA_Q_HEADS // SWA_KV_HEADS
WINDOW = 128
SWA_BLOCK = 128
DIFF_HEADS = 4
DIFF_QBLOCK = 128
ROPE_THETA = 10000.0
N_EXPERTS = 32
TOP_K = 4
D_FF = D_MODEL
SWIGLU_LIMIT = 7.0
SWIGLU_ALPHA = 1.702
MOE_BLOCK = 128
RMS_EPS = 1e-5

SWA_Q_W = SWA_Q_HEADS * HEAD_DIM
SWA_KV_W = SWA_KV_HEADS * HEAD_DIM
DIFF_QK_W = DIFF_HEADS * 2 * HEAD_DIM
DIFF_V_W = DIFF_HEADS * 2 * HEAD_DIM
IN_SPLITS = (SWA_Q_W, SWA_KV_W, SWA_KV_W, DIFF_QK_W, DIFF_QK_W, DIFF_V_W, D_MODEL, D_MODEL)
IN_WIDTH = sum(IN_SPLITS)

kernel_name = "hybrid_swa_sink_diffattn_gated_moe"


def rms_norm(x, g):
    xf = x.astype(jnp.float32)
    y = xf * lax.rsqrt(jnp.mean(xf * xf, axis=-1, keepdims=True) + RMS_EPS)
    return (y * g.astype(jnp.float32)).astype(x.dtype)


def rope_tables(seq, dim):
    pos = jnp.arange(seq, dtype=jnp.float32)
    inv_freq = ROPE_THETA ** (-jnp.arange(0, dim, 2, dtype=jnp.float32) / dim)
    ang = pos[:, None] * inv_freq[None, :]
    return jnp.cos(ang), jnp.sin(ang)


def apply_rope(x, cos, sin):
    x1, x2 = jnp.split(x.astype(jnp.float32), 2, axis=-1)
    c = cos[None, :, None, :]
    s = sin[None, :, None, :]
    return jnp.concatenate([x1 * c - x2 * s, x2 * c + x1 * s], axis=-1).astype(x.dtype)


def sliding_window_attention(q, k, v, sinks):
    B, S = q.shape[0], q.shape[1]
    nb = S // SWA_BLOCK
    qb = q.reshape(B, nb, SWA_BLOCK, SWA_KV_HEADS, SWA_GROUP, HEAD_DIM)
    kb = k.reshape(B, nb, SWA_BLOCK, SWA_KV_HEADS, HEAD_DIM)
    vb = v.reshape(B, nb, SWA_BLOCK, SWA_KV_HEADS, HEAD_DIM)

    def with_prev(t):
        prev = jnp.pad(t[:, :-1], ((0, 0), (1, 0), (0, 0), (0, 0), (0, 0)))
        return jnp.concatenate([prev, t], axis=2)

    kc, vc = with_prev(kb), with_prev(vb)
    s = jnp.einsum('bnqhgd,bnkhd->bnhgqk', qb, kc).astype(jnp.float32) * (HEAD_DIM ** -0.5)
    qi = jnp.arange(SWA_BLOCK)[:, None] + SWA_BLOCK
    kj = jnp.arange(2 * SWA_BLOCK)[None, :]
    band = (kj <= qi) & (qi - kj < WINDOW)
    has_prev = (jnp.arange(nb)[:, None, None] > 0) | (kj[None] >= SWA_BLOCK)
    mask = band[None] & has_prev
    s = jnp.where(mask[None, :, None, None], s, -jnp.inf)
    sink = sinks.astype(jnp.float32).reshape(SWA_KV_HEADS, SWA_GROUP)
    sink_b = jnp.broadcast_to(sink[None, None, :, :, None, None], s.shape[:-1] + (1,))
    p = jax.nn.softmax(jnp.concatenate([s, sink_b], axis=-1), axis=-1)[..., :-1]
    o = jnp.einsum('bnhgqk,bnkhd->bnqhgd', p.astype(v.dtype), vc)
    return o.reshape(B, S, SWA_Q_W)


def diff_attention(q, k, v, lam):
    B, S = q.shape[0], q.shape[1]
    nb = S // DIFF_QBLOCK
    kpos = jnp.arange(S)
    scale = HEAD_DIM ** -0.5

    def block(i):
        start = i * DIFF_QBLOCK
        qi = lax.dynamic_slice_in_dim(q, start, DIFF_QBLOCK, axis=1)
        s = jnp.einsum('bqhcd,bkhcd->bhcqk', qi, k).astype(jnp.float32) * scale
        qpos = start + jnp.arange(DIFF_QBLOCK)
        causal = kpos[None, :] <= qpos[:, None]
        p = jax.nn.softmax(jnp.where(causal, s, -jnp.inf), axis=-1)
        a = p[:, :, 0] - lam * p[:, :, 1]
        return jnp.einsum('bhqk,bkhe->bqhe', a.astype(v.dtype), v)

    o = lax.map(block, jnp.arange(nb))
    return o.transpose(1, 0, 2, 3, 4).reshape(B, S, DIFF_HEADS, 2 * HEAD_DIM)


def moe_ffn(x, router_w, router_b, w1, b1, w2, b2):
    B, S, D = x.shape
    N = B * S
    xf = x.reshape(N, D)
    logits = (xf @ router_w + router_b).astype(jnp.float32)
    top_vals, top_idx = lax.top_k(logits, TOP_K)
    gates = jax.nn.softmax(top_vals, axis=-1)
    A = N * TOP_K
    flat_e = top_idx.reshape(A).astype(jnp.int32)
    flat_tok = jnp.arange(A, dtype=jnp.int32) // TOP_K
    flat_w = gates.reshape(A)
    order = jnp.argsort(flat_e, stable=True)
    se, stok, sw = flat_e[order], flat_tok[order], flat_w[order]
    counts = jnp.bincount(flat_e, length=N_EXPERTS).astype(jnp.int32)
    padded = (counts + MOE_BLOCK - 1) // MOE_BLOCK * MOE_BLOCK
    grp_start = jnp.cumsum(counts) - counts
    pad_end = jnp.cumsum(padded)
    pad_start = pad_end - padded
    dest = pad_start[se] + jnp.arange(A, dtype=jnp.int32) - grp_start[se]
    n_rows = (-(-A // MOE_BLOCK) + N_EXPERTS) * MOE_BLOCK
    n_blocks = n_rows // MOE_BLOCK
    row_tok = jnp.zeros((n_rows,), jnp.int32).at[dest].set(stok)
    row_w = jnp.zeros((n_rows,), jnp.float32).at[dest].set(sw)
    block_start = jnp.arange(n_blocks, dtype=jnp.int32) * MOE_BLOCK
    block_e = jnp.minimum(jnp.searchsorted(pad_end, block_start, side='right'), N_EXPERTS - 1)
    xb = xf[row_tok].reshape(n_blocks, MOE_BLOCK, D)

    def expert_block(args):
        xblk, e = args
        h = xblk @ w1[e] + b1[e]
        g, u = jnp.split(h, 2, axis=-1)
        g = jnp.minimum(g, SWIGLU_LIMIT)
        u = jnp.clip(u, -SWIGLU_LIMIT, SWIGLU_LIMIT)
        act = g * jax.nn.sigmoid(SWIGLU_ALPHA * g) * (u + 1.0)
        return act @ w2[e] + b2[e]

    yb = lax.map(expert_block, (xb, block_e)).reshape(n_rows, D)
    y = jnp.zeros((N, D), yb.dtype).at[row_tok].add(yb * row_w[:, None].astype(yb.dtype))
    return y.reshape(B, S, D).astype(x.dtype)


def setup_inputs(seed: int = 0) -> dict:
    key = jax.random.key(seed)
    ks = jax.random.split(key, 22)
    n = lambda k, shape, s: jax.random.normal(k, shape, jnp.float32) * s
    L, D, E, F = DEPTH, D_MODEL, N_EXPERTS, D_FF
    return {
        "x": n(ks[0], (BATCH, SEQ, D), 1.0),
        "attn_norm_g": 1.0 + n(ks[1], (L, D), 0.01),
        "w_in": n(ks[2], (L, D, IN_WIDTH), D ** -0.5),
        "b_in": n(ks[3], (L, IN_WIDTH), 0.02),
        "swa_sinks": n(ks[4], (L, SWA_Q_HEADS), 0.5),
        "diff_lambda_q1": n(ks[5], (L, HEAD_DIM), 0.1),
        "diff_lambda_k1": n(ks[6], (L, HEAD_DIM), 0.1),
        "diff_lambda_q2": n(ks[7], (L, HEAD_DIM), 0.1),
        "diff_lambda_k2": n(ks[8], (L, HEAD_DIM), 0.1),
        "diff_subln_g": 1.0 + n(ks[9], (L, 2 * HEAD_DIM), 0.01),
        "w_swa_out": n(ks[10], (L, SWA_Q_W, D), SWA_Q_W ** -0.5),
        "w_diff_out": n(ks[11], (L, DIFF_V_W, D), DIFF_V_W ** -0.5),
        "w_o": n(ks[12], (L, D, D), D ** -0.5),
        "ffn_norm_g": 1.0 + n(ks[13], (L, D), 0.01),
        "router_w": n(ks[14], (L, D, E), D ** -0.5),
        "router_b": n(ks[15], (L, E), 0.01),
        "w1": n(ks[16], (L, E, D, 2 * F), D ** -0.5),
        "b1": n(ks[17], (L, E, 2 * F), 0.01),
        "w2": n(ks[18], (L, E, F, D), F ** -0.5),
        "b2": n(ks[19], (L, E, D), 0.01),
        "final_norm_g": 1.0 + n(ks[20], (D,), 0.01),
    }


def reference(x, attn_norm_g, w_in, b_in, swa_sinks, diff_lambda_q1, diff_lambda_k1,
              diff_lambda_q2, diff_lambda_k2, diff_subln_g, w_swa_out, w_diff_out, w_o,
              ffn_norm_g, router_w, router_b, w1, b1, w2, b2, final_norm_g):
    B, S = x.shape[0], x.shape[1]
    cos, sin = rope_tables(S, HEAD_DIM)
    split_at = [int(i) for i in np.cumsum(IN_SPLITS)[:-1]]
    f32 = jnp.float32
    for l in range(DEPTH):
        h = rms_norm(x, attn_norm_g[l])
        proj = h @ w_in[l] + b_in[l]
        qa, ka, va, qb, kb, vb, ga, gb = jnp.split(proj, split_at, axis=-1)
        qa = apply_rope(qa.reshape(B, S, SWA_Q_HEADS, HEAD_DIM), cos, sin)
        ka = apply_rope(ka.reshape(B, S, SWA_KV_HEADS, HEAD_DIM), cos, sin)
        va = va.reshape(B, S, SWA_KV_HEADS, HEAD_DIM)
        ya = sliding_window_attention(qa, ka, va, swa_sinks[l]) @ w_swa_out[l]
        qb = apply_rope(qb.reshape(B, S, 2 * DIFF_HEADS, HEAD_DIM), cos, sin).reshape(B, S, DIFF_HEADS, 2, HEAD_DIM)
        kb = apply_rope(kb.reshape(B, S, 2 * DIFF_HEADS, HEAD_DIM), cos, sin).reshape(B, S, DIFF_HEADS, 2, HEAD_DIM)
        vb = vb.reshape(B, S, DIFF_HEADS, 2 * HEAD_DIM)
        lam_init = 0.8 - 0.6 * math.exp(-0.3 * l)
        lam = (jnp.exp(jnp.sum(diff_lambda_q1[l].astype(f32) * diff_lambda_k1[l].astype(f32)))
               - jnp.exp(jnp.sum(diff_lambda_q2[l].astype(f32) * diff_lambda_k2[l].astype(f32)))
               + lam_init)
        ob = rms_norm(diff_attention(qb, kb, vb, lam), diff_subln_g[l]) * (1.0 - lam_init)
        yb = ob.reshape(B, S, DIFF_V_W) @ w_diff_out[l]
        mixed = jax.nn.sigmoid(ga) * ya + jax.nn.sigmoid(gb) * yb
        x = x + mixed @ w_o[l]
        x = x + moe_ffn(rms_norm(x, ffn_norm_g[l]), router_w[l], router_b[l], w1[l], b1[l], w2[l], b2[l])
    return rms_norm(x, final_norm_g)
```

```cpp
#include <hip/hip_runtime.h>
#include <cstdio>
#include <cstdint>

namespace nv {
constexpr int D = 1024, NB = 8, S = 4096, NTOK = NB * S, INW = 4352, NE = 32, TOPK = 4, FF = 1024;
constexpr int OFF_QA = 0, OFF_KA = 512, OFF_VA = 640, OFF_QB = 768, OFF_KB = 1280, OFF_VB = 1792, OFF_GA = 2304, OFF_GB = 3328;
constexpr int NASSIGN = NTOK * TOPK;
constexpr int MAXROWS = NASSIGN + NE * 64;
constexpr int MAXTILES = MAXROWS / 64;
constexpr size_t MiB = 1u << 20;
constexpr size_t WS_H = 0;
constexpr size_t WS_P = 128 * MiB;
constexpr size_t WS_SWA = 672 * MiB;
constexpr size_t WS_DIF = 736 * MiB;
constexpr size_t WS_YB = 800 * MiB;
constexpr size_t WS_ROPE = 928 * MiB;
constexpr size_t WS_LOG = 930 * MiB;
constexpr size_t WS_TE = 936 * MiB;
constexpr size_t WS_TW = 937 * MiB;
constexpr size_t WS_TP = 938 * MiB;
constexpr size_t WS_RTOK = 939 * MiB;
constexpr size_t WS_RW = 940 * MiB;
constexpr size_t WS_CNT = 941 * MiB;
constexpr size_t WS_END = 942 * MiB;

__device__ const float INV_FREQ[32] = {1.000000000e+00f, 7.498942614e-01f, 5.623413324e-01f, 4.216965139e-01f, 3.162277639e-01f, 2.371373773e-01f, 1.778279394e-01f, 1.333521307e-01f, 1.000000015e-01f, 7.498941571e-02f, 5.623413250e-02f, 4.216965288e-02f, 3.162277490e-02f, 2.371373773e-02f, 1.778279431e-02f, 1.333521493e-02f, 9.999999776e-03f, 7.498941850e-03f, 5.623413250e-03f, 4.216964822e-03f, 3.162277630e-03f, 2.371373586e-03f, 1.778279431e-03f, 1.333521446e-03f, 1.000000047e-03f, 7.498942432e-04f, 5.623413017e-04f, 4.216965172e-04f, 3.162277571e-04f, 2.371373703e-04f, 1.778279402e-04f, 1.333521504e-04f};

__device__ __forceinline__ float wave_sum(float v) {
#pragma unroll
    for (int o = 1; o < 64; o <<= 1) v += __shfl_xor(v, o);
    return v;
}
__device__ __forceinline__ float sigmoidf_(float x) { return 1.f / (1.f + __expf(-x)); }

__global__ void __launch_bounds__(256) k_rmsnorm(const float* in, const float* g, float* out, int nrows) {
    const int row = blockIdx.x * 4 + (threadIdx.x >> 6), lane = threadIdx.x & 63;
    if (row >= nrows) return;
    const float4* p = (const float4*)(in + (size_t)row * D);
    float4 v[4]; float s = 0.f;
#pragma unroll
    for (int j = 0; j < 4; ++j) { v[j] = p[lane + 64 * j]; s += v[j].x * v[j].x + v[j].y * v[j].y + v[j].z * v[j].z + v[j].w * v[j].w; }
    const float rstd = rsqrtf(wave_sum(s) * (1.f / D) + 1e-5f);
    float4* o = (float4*)(out + (size_t)row * D);
#pragma unroll
    for (int j = 0; j < 4; ++j) { const float4 gg = ((const float4*)g)[lane + 64 * j];
        o[lane + 64 * j] = make_float4(v[j].x * rstd * gg.x, v[j].y * rstd * gg.y, v[j].z * rstd * gg.z, v[j].w * rstd * gg.w); }
}

struct GA { const float* A; const int* ridx; const float* Bm; const float* bias; float* C; const float* resid; const int* texp; const float* roww;
            long sB; int lda, ldb, ldc, M, N, K, sBias, pad; };
template <int MODE> __global__ void __launch_bounds__(256) k_gemm(GA a) {
    __shared__ float As[16][68]; __shared__ float Bs[16][64]; __shared__ float Bs2[MODE == 2 ? 16 : 1][64];
    const int tm = blockIdx.y, tn = blockIdx.x;
    const float* Bm = a.Bm; const float* bias = a.bias;
    if (a.texp) { const int e = a.texp[tm]; if (e < 0) return; Bm += (size_t)e * a.sB; if (bias) bias += (size_t)e * a.sBias; }
    const int tid = threadIdx.x, ty = tid >> 4, tx = tid & 15;
    const int arow = tid >> 2, ak = (tid & 3) * 4;
    const int mg = tm * 64 + arow;
    const size_t aoff = (size_t)((MODE != 3 && a.ridx) ? a.ridx[mg] : mg) * a.lda;
    const int bk = tid >> 4, bn = (tid & 15) * 4;
    const int ng = tn * 64 + bn;
    float acc[4][4], acc2[4][4];
#pragma unroll
    for (int i = 0; i < 4; ++i)
#pragma unroll
        for (int j = 0; j < 4; ++j) { acc[i][j] = 0.f; acc2[i][j] = 0.f; }
    for (int k0 = 0; k0 < a.K; k0 += 16) {
        const float4 av = *(const float4*)(a.A + aoff + k0 + ak);
        As[ak + 0][arow] = av.x; As[ak + 1][arow] = av.y; As[ak + 2][arow] = av.z; As[ak + 3][arow] = av.w;
        float4 bv = make_float4(0.f, 0.f, 0.f, 0.f);
        if (ng < a.N) bv = *(const float4*)(Bm + (size_t)(k0 + bk) * a.ldb + ng);
        *(float4*)&Bs[bk][bn] = bv;
        if (MODE == 2) { const float4 bv2 = *(const float4*)(Bm + (size_t)(k0 + bk) * a.ldb + ng + FF); *(float4*)&Bs2[bk][bn] = bv2; }
        __syncthreads();
#pragma unroll
        for (int kk = 0; kk < 16; ++kk) {
            const float4 a4 = *(const float4*)&As[kk][ty * 4]; const float4 b4 = *(const float4*)&Bs[kk][tx * 4];
            const float aa[4] = {a4.x, a4.y, a4.z, a4.w}; const float bb[4] = {b4.x, b4.y, b4.z, b4.w};
#pragma unroll
            for (int i = 0; i < 4; ++i)
#pragma unroll
                for (int j = 0; j < 4; ++j) acc[i][j] += aa[i] * bb[j];
            if (MODE == 2) { const float4 c4 = *(const float4*)&Bs2[kk][tx * 4]; const float cc[4] = {c4.x, c4.y, c4.z, c4.w};
#pragma unroll
                for (int i = 0; i < 4; ++i)
#pragma unroll
                    for (int j = 0; j < 4; ++j) acc2[i][j] += aa[i] * cc[j]; }
        }
        __syncthreads();
    }
    const int n0 = tn * 64 + tx * 4;
    if (n0 >= a.N) return;
#pragma unroll
    for (int i = 0; i < 4; ++i) {
        const int m = tm * 64 + ty * 4 + i;
        float v[4];
#pragma unroll
        for (int j = 0; j < 4; ++j) {
            float x = acc[i][j];
            if (MODE == 0) { if (bias) x += bias[n0 + j]; }
            if (MODE == 1) { x += a.resid[(size_t)m * a.ldc + n0 + j]; }
            if (MODE == 2) { float g = x + bias[n0 + j], u = acc2[i][j] + bias[FF + n0 + j];
                g = fminf(g, 7.f); u = fminf(fmaxf(u, -7.f), 7.f); x = g * sigmoidf_(1.702f * g) * (u + 1.f); }
            if (MODE == 3) { x = (x + bias[n0 + j]) * a.roww[m]; }
            v[j] = x;
        }
        if (MODE == 3) { const int tok = a.ridx[m]; float* dst = a.C + (size_t)tok * a.ldc + n0;
            if (a.roww[m] != 0.f) {
#pragma unroll
                for (int j = 0; j < 4; ++j) atomicAdd(dst + j, v[j]); }
        } else *(float4*)(a.C + (size_t)m * a.ldc + n0) = make_float4(v[0], v[1], v[2], v[3]);
    }
}

__global__ void k_rope_table(float* tab) {
    const int idx = blockIdx.x * 256 + threadIdx.x; if (idx >= S * 32) return;
    const int s = idx >> 5, i = idx & 31;
    const float ang = (float)s * INV_FREQ[i];
    const double rev = (double)ang * 0.15915494309189535; const double fr = rev - rint(rev);
    tab[2 * idx] = __builtin_amdgcn_cosf((float)fr); tab[2 * idx + 1] = __builtin_amdgcn_sinf((float)fr);
}
__global__ void __launch_bounds__(256) k_rope(float* proj, const float* tab) {
    const size_t idx = (size_t)blockIdx.x * 256 + threadIdx.x;
    const int i = (int)(idx & 31); const size_t r = idx >> 5; const int hh = (int)(r % 26); const size_t tok = r / 26;
    if (tok >= (size_t)NTOK) return;
    const int col = hh < 8 ? hh * 64 : (hh < 10 ? OFF_KA + (hh - 8) * 64 : (hh < 18 ? OFF_QB + (hh - 10) * 64 : OFF_KB + (hh - 18) * 64));
    const int s = (int)(tok % S);
    const float c = tab[(s * 32 + i) * 2], sn = tab[(s * 32 + i) * 2 + 1];
    float* p = proj + tok * INW + col + i;
    const float x1 = p[0], x2 = p[32];
    p[0] = x1 * c - x2 * sn; p[32] = x2 * c + x1 * sn;
}

__global__ void __launch_bounds__(256) k_swa(const float* proj, const float* sinks, float* out) {
    const int idx = blockIdx.x * 256 + threadIdx.x;
    const int q = idx % S, hq = (idx / S) % 8, b = idx / (S * 8), kvh = hq >> 2;
    const int qw0 = q & ~63;
    const float* base = proj + (size_t)b * S * INW;
    float qv[64], o[64];
#pragma unroll
    for (int d = 0; d < 64; ++d) { qv[d] = base[(size_t)q * INW + OFF_QA + hq * 64 + d] * 0.125f; o[d] = 0.f; }
    float m = -1e30f, l = 0.f;
    const int j0 = qw0 - 127 < 0 ? 0 : qw0 - 127, j1 = qw0 + 63;
    for (int j = j0; j <= j1; ++j) {
        const float* kr = base + (size_t)j * INW + OFF_KA + kvh * 64;
        float sc = 0.f;
#pragma unroll
        for (int d = 0; d < 64; ++d) sc += qv[d] * kr[d];
        const bool ok = (j <= q) && (q - j < 128);
        if (ok) {
            const float* vr = base + (size_t)j * INW + OFF_VA + kvh * 64;
            if (sc > m) { const float f = __expf(m - sc); l *= f;
#pragma unroll
                for (int d = 0; d < 64; ++d) o[d] *= f;
                m = sc; }
            const float p = __expf(sc - m); l += p;
#pragma unroll
            for (int d = 0; d < 64; ++d) o[d] += p * vr[d];
        }
    }
    l += __expf(sinks[hq] - m);
    const float il = 1.f / l;
    float* op = out + ((size_t)b * S + q) * 512 + hq * 64;
#pragma unroll
    for (int d = 0; d < 64; ++d) op[d] = o[d] * il;
}

__global__ void __launch_bounds__(256) k_diff(const float* proj, const float* lq1, const float* lk1, const float* lq2, const float* lk2, float* out) {
    const int idx = blockIdx.x * 256 + threadIdx.x;
    const int q = idx % S, vq = (idx / S) % 4, h = (idx / (S * 4)) % 4, b = idx / (S * 16);
    const int jend = (q | 63);
    const float* base = proj + (size_t)b * S * INW;
    float s1 = 0.f, s2 = 0.f;
    for (int d = 0; d < 64; ++d) { s1 += lq1[d] * lk1[d]; s2 += lq2[d] * lk2[d]; }
    const float lam = __expf(s1) - __expf(s2) + 0.2f;
    float res[32];
#pragma unroll
    for (int d = 0; d < 32; ++d) res[d] = 0.f;
    for (int c = 0; c < 2; ++c) {
        float qv[64], o[32];
#pragma unroll
        for (int d = 0; d < 64; ++d) qv[d] = base[(size_t)q * INW + OFF_QB + (2 * h + c) * 64 + d] * 0.125f;
#pragma unroll
        for (int d = 0; d < 32; ++d) o[d] = 0.f;
        float m = -1e30f, l = 0.f;
        for (int j = 0; j <= jend; ++j) {
            const float* kr = base + (size_t)j * INW + OFF_KB + (2 * h + c) * 64;
            float sc = 0.f;
#pragma unroll
            for (int d = 0; d < 64; ++d) sc += qv[d] * kr[d];
            if (j <= q) {
                const float* vr = base + (size_t)j * INW + OFF_VB + h * 128 + vq * 32;
                if (sc > m) { const float f = __expf(m - sc); l *= f;
#pragma unroll
                    for (int d = 0; d < 32; ++d) o[d] *= f;
                    m = sc; }
                const float p = __expf(sc - m); l += p;
#pragma unroll
                for (int d = 0; d < 32; ++d) o[d] += p * vr[d];
            }
        }
        const float il = (c == 0 ? 1.f : -lam) / l;
#pragma unroll
        for (int d = 0; d < 32; ++d) res[d] += o[d] * il;
    }
    float* op = out + ((size_t)b * S + q) * 512 + h * 128 + vq * 32;
#pragma unroll
    for (int d = 0; d < 32; ++d) op[d] = res[d];
}
__global__ void __launch_bounds__(256) k_diffnorm(float* dif, const float* g) {
    const int idx = blockIdx.x * 256 + threadIdx.x; if (idx >= NTOK * 4) return;
    float* p = dif + (size_t)idx * 128; float s = 0.f;
    for (int d = 0; d < 128; ++d) s += p[d] * p[d];
    const float r = rsqrtf(s * (1.f / 128.f) + 1e-5f) * 0.8f;
    for (int d = 0; d < 128; ++d) p[d] = p[d] * r * g[d];
}
__global__ void __launch_bounds__(256) k_gate(float* ya, const float* yb, const float* proj) {
    const size_t idx = (size_t)blockIdx.x * 256 + threadIdx.x; if (idx >= (size_t)NTOK * D) return;
    const size_t tok = idx >> 10; const int c = (int)(idx & 1023);
    const float ga = proj[tok * INW + OFF_GA + c], gb = proj[tok * INW + OFF_GB + c];
    ya[idx] = sigmoidf_(ga) * ya[idx] + sigmoidf_(gb) * yb[idx];
}
__global__ void __launch_bounds__(256) k_route(const float* logits, int* te, float* tw, int* tp, int* cnt) {
    const int tok = blockIdx.x * 256 + threadIdx.x; if (tok >= NTOK) return;
    float lg[32];
#pragma unroll
    for (int e = 0; e < 32; ++e) lg[e] = logits[(size_t)tok * 32 + e];
    float tv[4]; int ti[4];
#pragma unroll
    for (int k = 0; k < 4; ++k) { float best = -3.0e38f; int bi = 0;
#pragma unroll
        for (int e = 0; e < 32; ++e) { if (lg[e] > best) { best = lg[e]; bi = e; } }
        tv[k] = best; ti[k] = bi;
#pragma unroll
        for (int e = 0; e < 32; ++e) if (e == bi) lg[e] = -3.0e38f; }
    float ex[4], sum = 0.f;
#pragma unroll
    for (int k = 0; k < 4; ++k) { ex[k] = __expf(tv[k] - tv[0]); sum += ex[k]; }
#pragma unroll
    for (int k = 0; k < 4; ++k) { te[tok * 4 + k] = ti[k]; tw[tok * 4 + k] = ex[k] / sum; tp[tok * 4 + k] = atomicAdd(&cnt[ti[k]], 1); }
}
__global__ void k_offsets(const int* cnt, int* base, int* texp) {
    __shared__ int sb[33];
    if (threadIdx.x == 0) { int acc = 0; for (int e = 0; e < 32; ++e) { sb[e] = acc; acc += (cnt[e] + 63) / 64 * 64; } sb[32] = acc; }
    __syncthreads();
    if (threadIdx.x < 33) base[threadIdx.x] = sb[threadIdx.x];
    for (int t = threadIdx.x; t < MAXTILES; t += 256) { const int r0 = t * 64; int e = -1;
        if (r0 < sb[32]) { e = 0; while (r0 >= sb[e + 1]) ++e; }
        texp[t] = e; }
}
__global__ void __launch_bounds__(256) k_scatter(const int* te, const float* tw, const int* tp, const int* base, int* rtok, float* rw) {
    const int i = blockIdx.x * 256 + threadIdx.x; if (i >= NASSIGN) return;
    const int slot = base[te[i]] + tp[i]; rtok[slot] = i >> 2; rw[slot] = tw[i];
}
}

extern "C" void kernel_launch(void* const* d_in, const int* in_sizes, int n_in, void* d_out, int out_size, void* d_ws, size_t ws_size, hipStream_t stream) {
    using namespace nv;
    if (ws_size < WS_END) { fprintf(stderr, "workspace too small: %zu\n", ws_size); return; }
    const float* x = (const float*)d_in[0]; const float* attn_g = (const float*)d_in[1]; const float* w_in = (const float*)d_in[2]; const float* b_in = (const float*)d_in[3];
    const float* sinks = (const float*)d_in[4]; const float* lq1 = (const float*)d_in[5]; const float* lk1 = (const float*)d_in[6]; const float* lq2 = (const float*)d_in[7]; const float* lk2 = (const float*)d_in[8];
    const float* subln_g = (const float*)d_in[9]; const float* w_swa_out = (const float*)d_in[10]; const float* w_diff_out = (const float*)d_in[11]; const float* w_o = (const float*)d_in[12];
    const float* ffn_g = (const float*)d_in[13]; const float* router_w = (const float*)d_in[14]; const float* router_b = (const float*)d_in[15];
    const float* w1 = (const float*)d_in[16]; const float* b1 = (const float*)d_in[17]; const float* w2 = (const float*)d_in[18]; const float* b2 = (const float*)d_in[19]; const float* final_g = (const float*)d_in[20];
    char* ws = (char*)d_ws; float* out = (float*)d_out;
    float* H = (float*)(ws + WS_H); float* P = (float*)(ws + WS_P); float* SWA = (float*)(ws + WS_SWA); float* DIF = (float*)(ws + WS_DIF); float* YB = (float*)(ws + WS_YB);
    float* ROPE = (float*)(ws + WS_ROPE); float* LOG = (float*)(ws + WS_LOG); int* TE = (int*)(ws + WS_TE); float* TW = (float*)(ws + WS_TW); int* TP = (int*)(ws + WS_TP);
    int* RTOK = (int*)(ws + WS_RTOK); float* RW = (float*)(ws + WS_RW); int* CNT = (int*)(ws + WS_CNT); int* BASE = CNT + 64; int* TEXP = CNT + 128;

    hipMemsetAsync(ws + WS_RTOK, 0, 3 * MiB, stream);
    k_rope_table<<<S * 32 / 256, 256, 0, stream>>>(ROPE);
    k_rmsnorm<<<NTOK / 4, 256, 0, stream>>>(x, attn_g, H, NTOK);
    { GA a{}; a.A = H; a.lda = D; a.Bm = w_in; a.ldb = INW; a.bias = b_in; a.C = P; a.ldc = INW; a.M = NTOK; a.N = INW; a.K = D;
      k_gemm<0><<<dim3(INW / 64, NTOK / 64), 256, 0, stream>>>(a); }
    k_rope<<<(unsigned)(((size_t)NTOK * 26 * 32) / 256), 256, 0, stream>>>(P, ROPE);
    k_swa<<<NTOK * 8 / 256, 256, 0, stream>>>(P, sinks, SWA);
    k_diff<<<NTOK * 16 / 256, 256, 0, stream>>>(P, lq1, lk1, lq2, lk2, DIF);
    k_diffnorm<<<NTOK * 4 / 256, 256, 0, stream>>>(DIF, subln_g);
    { GA a{}; a.A = SWA; a.lda = 512; a.Bm = w_swa_out; a.ldb = D; a.C = H; a.ldc = D; a.M = NTOK; a.N = D; a.K = 512;
      k_gemm<0><<<dim3(D / 64, NTOK / 64), 256, 0, stream>>>(a); }
    { GA a{}; a.A = DIF; a.lda = 512; a.Bm = w_diff_out; a.ldb = D; a.C = YB; a.ldc = D; a.M = NTOK; a.N = D; a.K = 512;
      k_gemm<0><<<dim3(D / 64, NTOK / 64), 256, 0, stream>>>(a); }
    k_gate<<<NTOK * D / 256, 256, 0, stream>>>(H, YB, P);
    { GA a{}; a.A = H; a.lda = D; a.Bm = w_o; a.ldb = D; a.C = out; a.ldc = D; a.resid = x; a.M = NTOK; a.N = D; a.K = D;
      k_gemm<1><<<dim3(D / 64, NTOK / 64), 256, 0, stream>>>(a); }
    k_rmsnorm<<<NTOK / 4, 256, 0, stream>>>(out, ffn_g, YB, NTOK);
    { GA a{}; a.A = YB; a.lda = D; a.Bm = router_w; a.ldb = NE; a.bias = router_b; a.C = LOG; a.ldc = NE; a.M = NTOK; a.N = NE; a.K = D;
      k_gemm<0><<<dim3(1, NTOK / 64), 256, 0, stream>>>(a); }
    k_route<<<NTOK / 256, 256, 0, stream>>>(LOG, TE, TW, TP, CNT);
    k_offsets<<<1, 256, 0, stream>>>(CNT, BASE, TEXP);
    k_scatter<<<NASSIGN / 256, 256, 0, stream>>>(TE, TW, TP, BASE, RTOK, RW);
    { GA a{}; a.A = YB; a.lda = D; a.ridx = RTOK; a.Bm = w1; a.ldb = 2 * FF; a.sB = (long)D * 2 * FF; a.bias = b1; a.sBias = 2 * FF; a.C = P; a.ldc = FF; a.texp = TEXP; a.M = MAXROWS; a.N = FF; a.K = D;
      k_gemm<2><<<dim3(FF / 64, MAXTILES), 256, 0, stream>>>(a); }
    { GA a{}; a.A = P; a.lda = FF; a.ridx = RTOK; a.roww = RW; a.Bm = w2; a.ldb = D; a.sB = (long)FF * D; a.bias = b2; a.sBias = D; a.C = out; a.ldc = D; a.texp = TEXP; a.M = MAXROWS; a.N = D; a.K = FF;
      k_gemm<3><<<dim3(D / 64, MAXTILES), 256, 0, stream>>>(a); }
    k_rmsnorm<<<NTOK / 4, 256, 0, stream>>>(out, final_g, out, NTOK);
}
```

```cpp
#include <hip/hip_runtime.h>
#include <hip/hip_bf16.h>
#include <cstdio>
#include <cstdint>
#include <cmath>
namespace pg8 {
#define PG8_LAS __attribute__((address_space(3)))
typedef unsigned short bf16_t;
typedef short bf16x8 __attribute__((ext_vector_type(8)));
typedef float f32x4 __attribute__((ext_vector_type(4)));
typedef float f32x2 __attribute__((ext_vector_type(2)));
typedef unsigned u32x4 __attribute__((ext_vector_type(4)));
typedef unsigned u32x2 __attribute__((ext_vector_type(2)));
typedef int v8i __attribute__((ext_vector_type(8)));
typedef int v4i __attribute__((ext_vector_type(4)));
constexpr int BM = 256, BK = 64, HALF = 128, HTB = HALF * BK * 2  , STAGE_BYTES = 8 * HTB, NXCD = 8, WGM = 8;

__host__ __device__ __forceinline__ int lds_byte(int r, int c) { const int st = (r >> 4) * 2 + (c >> 5), rr = r & 15, cc = c & 31, ob = rr * 64 + cc * 2; return st * 1024 + (ob ^ (((ob >> 9) & 1) << 5)); }
__host__ __device__ __forceinline__ void stage_rc(int b, int& R, int& C) { const int st = b / 1024, sb = b % 1024, swz = sb ^ (((sb >> 9) & 1) << 5); R = (st >> 1) * 16 + swz / 64; C = (st & 1) * 32 + (swz % 64) / 2; }
__host__ __device__ __forceinline__ int perm32(int rho) { const int n = rho >> 4, i = rho & 15; return 8 * (i >> 2) + 4 * n + (i & 3); }

struct Unit { int pm, pn, e, cnt; };
struct Gemm { const void* A; const void* Bt; int RB; size_t hstepB; };

struct StaticOrder {
    int nM, nN, nwg, G, c;
    __device__ void init(int M, int N, int G_, int c_) { nM = M / BM; nN = N / BM; nwg = nM * nN; G = G_; c = c_; }
    __device__ bool next(int i, Unit& u) const {
        const long L = (long)i * G + c; if (L >= nwg) return false;
        int wgid = (int)L; { const int q = nwg / NXCD, r = nwg % NXCD, xcd = wgid % NXCD, off = wgid / NXCD; wgid = (xcd < r ? xcd * (q + 1) : r * (q + 1) + (xcd - r) * q) + off; }
        const int nig = WGM * nN, gid = wgid / nig, fm = gid * WGM, gsz = (nM - fm) < WGM ? (nM - fm) : WGM;
        u.pm = fm + ((wgid % nig) % gsz); u.pn = (wgid % nig) / gsz; u.e = 0; u.cnt = 0; return true;
    }
    __device__ __forceinline__ int arow(int, const Unit& u, int r) const { return u.pm * BM + r; }
    __device__ __forceinline__ size_t boff(const Unit& u, int RB) const { return (size_t)u.pn * BM * RB; }
    __device__ __forceinline__ int fetch(int) const { return 0; }
    __device__ __forceinline__ void post(int, int) const {}
};
struct QueueOrder {
    int nM, nN, nwg; unsigned* ctr; volatile PG8_LAS int* mail;
    __device__ void init(int M, int N, unsigned* ctr_, volatile PG8_LAS int* mail_, int x_) { nM = M / BM; nN = N / BM; nwg = nM * nN; ctr = ctr_ + 64 * x_; mail = mail_; }
    __device__ void prime() const {
        if (threadIdx.x == 0) { const int t0_ = (int)__hip_atomic_fetch_add(ctr, 3u, __ATOMIC_RELAXED, __HIP_MEMORY_SCOPE_AGENT);
            for (int k = 0; k < 3; ++k) mail[k] = (int)(blockIdx.x & 7) + NXCD * (t0_ + k); }
        __syncthreads();
    }
    __device__ bool next(int i, Unit& u) const {
        const int L = __builtin_amdgcn_readfirstlane(mail[i & 3]); if (L >= nwg) return false;
        int wgid = L; { const int q = nwg / NXCD, r = nwg % NXCD, xcd = wgid % NXCD, off = wgid / NXCD; wgid = (xcd < r ? xcd * (q + 1) : r * (q + 1) + (xcd - r) * q) + off; }
        const int nig = WGM * nN, gid = wgid / nig, fm = gid * WGM, gsz = (nM - fm) < WGM ? (nM - fm) : WGM;
        u.pm = fm + ((wgid % nig) % gsz); u.pn = (wgid % nig) / gsz; u.e = 0; u.cnt = 0; return true;
    }
    __device__ __forceinline__ int arow(int, const Unit& u, int r) const { return u.pm * BM + r; }
    __device__ __forceinline__ size_t boff(const Unit& u, int RB) const { return (size_t)u.pn * BM * RB; }
    __device__ __forceinline__ int fetch(int) const { int v = 0; if (threadIdx.x == 0) v = (int)(blockIdx.x & 7) + NXCD * (int)__hip_atomic_fetch_add(ctr, 1u, __ATOMIC_RELAXED, __HIP_MEMORY_SCOPE_AGENT); return v; }
    __device__ __forceinline__ void post(int ui, int v) const { if (threadIdx.x == 0) mail[(ui + 3) & 3] = v; }
};

__device__ __forceinline__ unsigned cvt_pk_bf16(float lo, float hi) { unsigned r; asm volatile("v_cvt_pk_bf16_f32 %0, %1, %2" : "=v"(r) : "v"(lo), "v"(hi)); return r; }
__device__ __forceinline__ float bf_lo(unsigned w) { return __uint_as_float(w << 16); }
__device__ __forceinline__ float bf_hi(unsigned w) { return __uint_as_float(w & 0xffff0000u); }
__device__ __forceinline__ float sigm(float x) { return __builtin_amdgcn_rcpf(1.f + __builtin_amdgcn_exp2f(-1.4426950408889634f * x)); }

template <bool FP8, class Epi, class Sched>
__device__ __forceinline__ void gemm_phase(PG8_LAS unsigned char* lds, const Gemm g, const Sched& S, const Epi& E) {
    int tid = threadIdx.x; asm volatile("" : "+v"(tid));
    const int wid = __builtin_amdgcn_readfirstlane(tid >> 6), lane = tid & 63, wr = wid >> 2, wc = wid & 3, fr = lane & 15, fq = lane >> 4;
    const int RB = g.RB, nt = RB / (BK * 2);
    unsigned voffB[2];
#pragma unroll
    for (int i = 0; i < 2; ++i) { int R, C; stage_rc(tid * 16 + i * 8192, R, C); const int Rb = (R & ~31) + perm32(R & 31); voffB[i] = (unsigned)(Rb * RB + C * 2); }
    const size_t kstep = (size_t)(BK * 2);
    const size_t hstepB = g.hstepB;
    const unsigned ldsw = (unsigned)wid * 1024u;
    const int aoff = lds_byte(wr * 64 + fr, fq * 8), boff = lds_byte(wc * 32 + fr, fq * 8);
    constexpr int POFF = 1024;
#define PG8_SA(b, h) (((b) * 2 + (h)) * HTB)
#define PG8_SB(b, h) ((4 + (b) * 2 + (h)) * HTB)
#define PG8_STAGE(bufoff, gbase, voff) do { const char* gb_ = (const char*)(gbase); asm volatile("" : "+s"(gb_));     \
        _Pragma("unroll") for (int _i = 0; _i < 2; ++_i) { unsigned vo_ = (voff)[_i]; asm volatile("" : "+v"(vo_)); \
        __builtin_amdgcn_global_load_lds((const unsigned*)(gb_ + vo_), (PG8_LAS unsigned*)(lds + (bufoff) + ldsw + _i * 8192), 16, 0, 0); } } while (0)
#define PG8_LDA(dst, b, h) do { _Pragma("unroll") for (int m = 0; m < 4; ++m) { const v4i lo_ = *(const PG8_LAS v4i*)(lds + PG8_SA(b, h) + aoff + m * 2048), hi_ = *(const PG8_LAS v4i*)(lds + PG8_SA(b, h) + aoff + m * 2048 + POFF); \
        dst[m] = __builtin_shufflevector(lo_, hi_, 0, 1, 2, 3, 4, 5, 6, 7); } } while (0)
#define PG8_LDB(dst, b, h) do { _Pragma("unroll") for (int n = 0; n < 2; ++n) { const v4i lo_ = *(const PG8_LAS v4i*)(lds + PG8_SB(b, h) + boff + n * 2048), hi_ = *(const PG8_LAS v4i*)(lds + PG8_SB(b, h) + boff + n * 2048 + POFF); \
        dst[n] = __builtin_shufflevector(lo_, hi_, 0, 1, 2, 3, 4, 5, 6, 7); } } while (0)
#define PG8_MMA(ai, bj, At, Bt) do { __builtin_amdgcn_s_setprio(1); _Pragma("unroll") for (int m = 0; m < 4; ++m) _Pragma("unroll") for (int n = 0; n < 2; ++n) { \
        if constexpr (FP8) asm volatile("v_mfma_f32_16x16x128_f8f6f4 %0, %1, %2, %0" : "+v"(acc[ai][bj][m][n]) : "v"(Bt[n]), "v"(At[m]));     \
        else { acc[ai][bj][m][n] = __builtin_amdgcn_mfma_f32_16x16x32_bf16(__builtin_bit_cast(bf16x8, __builtin_shufflevector(Bt[n], Bt[n], 0, 1, 2, 3)), __builtin_bit_cast(bf16x8, __builtin_shufflevector(At[m], At[m], 0, 1, 2, 3)), acc[ai][bj][m][n], 0, 0, 0); \
               acc[ai][bj][m][n] = __builtin_amdgcn_mfma_f32_16x16x32_bf16(__builtin_bit_cast(bf16x8, __builtin_shufflevector(Bt[n], Bt[n], 4, 5, 6, 7)), __builtin_bit_cast(bf16x8, __builtin_shufflevector(At[m], At[m], 4, 5, 6, 7)), acc[ai][bj][m][n], 0, 0, 0); } } \
        __builtin_amdgcn_s_setprio(0); } while (0)
#define PG8_WAIT_V(n) asm volatile("s_waitcnt vmcnt(" #n ")" ::: "memory")
#define PG8_WAIT_L(n) asm volatile("s_waitcnt lgkmcnt(" #n ")" ::: "memory")
#define PG8_BAR __builtin_amdgcn_s_barrier()
#define PG8_SCHED __builtin_amdgcn_sched_barrier(0)
#define PG8_OA(dst, ui_, u_) do { int t_ = threadIdx.x; asm volatile("" : "+v"(t_)); _Pragma("unroll") for (int _i = 0; _i < 2; ++_i) { int R_, C_; stage_rc(t_ * 16 + _i * 8192, R_, C_); \
        _Pragma("unroll") for (int _h = 0; _h < 2; ++_h) dst[_h][_i] = (unsigned)S.arow(ui_, u_, _h * HALF + R_) * (unsigned)RB + (unsigned)C_ * 2u; } } while (0)
    Unit cur, nxt; int ui = 0;
    if (!S.next(0, cur)) return;
    f32x4 acc[2][2][4][2];
#pragma unroll
    for (int a = 0; a < 2; ++a)
#pragma unroll
        for (int b = 0; b < 2; ++b)
#pragma unroll
            for (int m = 0; m < 4; ++m)
#pragma unroll
                for (int n = 0; n < 2; ++n) acc[a][b][m][n] = (f32x4){0.f, 0.f, 0.f, 0.f};
    v8i At[4], B0[2], B1[2];
    unsigned oaC[2][2];
    PG8_OA(oaC, 0, cur);
    const char* const gA = (const char*)g.A;
    const char* cB = (const char*)g.Bt + S.boff(cur, RB);
    PG8_STAGE(PG8_SB(0, 0), cB, voffB); PG8_STAGE(PG8_SB(0, 1), cB + hstepB, voffB); PG8_STAGE(PG8_SA(0, 0), gA, oaC[0]); PG8_STAGE(PG8_SA(0, 1), gA, oaC[1]);
    if (wr == 1) PG8_BAR;
    PG8_WAIT_V(2); PG8_BAR;
    PG8_STAGE(PG8_SB(1, 0), cB + kstep, voffB); PG8_STAGE(PG8_SA(1, 0), gA + kstep, oaC[0]); PG8_STAGE(PG8_SB(1, 1), cB + hstepB + kstep, voffB);
    PG8_WAIT_V(6); PG8_BAR;
    for (;;) {
        const bool has_next = S.next(ui + 1, nxt);
        const char* nB = has_next ? (const char*)g.Bt + S.boff(nxt, RB) : cB;
        for (int t = 0; t < nt; t += 2) {
            const bool last = (t == nt - 2);
            const bool first = (t == 0) && (ui > 0);
            if constexpr (Epi::MID) { if (t == nt / 2) { int fr_ = fr, fq_ = fq; asm volatile("" : "+v"(fr_), "+v"(fq_)); E.mid(acc, cur, wr, wc, fr_, fq_); } }
            const char* a1 = gA + (size_t)(t + 1) * kstep;
            const char* a2 = last ? gA : gA + (size_t)(t + 2) * kstep; const char* b2 = last ? nB : cB + (size_t)(t + 2) * kstep;
            const char* a3 = a2 + kstep; const char* b3 = b2 + kstep;
            unsigned o2[2][2];
#pragma unroll
            for (int h = 0; h < 2; ++h)
#pragma unroll
                for (int i = 0; i < 2; ++i) o2[h][i] = oaC[h][i];
            if (last && has_next) { PG8_OA(o2, ui + 1, nxt); }
            PG8_LDB(B0, 0, 0); PG8_LDB(B1, 0, 1); PG8_SCHED; PG8_LDA(At, 0, 0); if (!first) { PG8_STAGE(PG8_SA(1, 1), a1, oaC[1]); }
            if (!first) { PG8_WAIT_V(8); } PG8_WAIT_L(0); PG8_BAR; PG8_MMA(0, 0, At, B0); PG8_MMA(0, 1, At, B1); PG8_BAR; PG8_SCHED;
            PG8_LDA(At, 0, 1); PG8_STAGE(PG8_SB(0, 0), b2, voffB); PG8_STAGE(PG8_SB(0, 1), b2 + hstepB, voffB); PG8_STAGE(PG8_SA(0, 0), a2, o2[0]);
            if (!first) { PG8_WAIT_V(8); } PG8_WAIT_L(0); PG8_BAR; PG8_MMA(1, 0, At, B0); PG8_MMA(1, 1, At, B1); PG8_BAR; PG8_SCHED;
            PG8_LDB(B0, 1, 0); PG8_LDB(B1, 1, 1); PG8_SCHED; PG8_LDA(At, 1, 0); PG8_STAGE(PG8_SA(0, 1), a2, o2[1]);
            if (!first) { PG8_WAIT_V(8); } PG8_WAIT_L(0); PG8_BAR; PG8_MMA(0, 0, At, B0); PG8_MMA(0, 1, At, B1); PG8_BAR; PG8_SCHED;
            PG8_LDA(At, 1, 1); PG8_STAGE(PG8_SB(1, 0), b3, voffB); PG8_STAGE(PG8_SB(1, 1), b3 + hstepB, voffB); PG8_STAGE(PG8_SA(1, 0), a3, o2[0]);
            PG8_WAIT_V(8); PG8_WAIT_L(0); PG8_BAR; PG8_MMA(1, 0, At, B0); PG8_MMA(1, 1, At, B1); PG8_BAR; PG8_SCHED;
            if (last && has_next) { PG8_STAGE(PG8_SA(1, 1), a3, o2[1]); }
        }
        if (wr == 0) PG8_BAR;
        if constexpr (FP8) asm volatile("s_nop 15\n\ts_nop 15\n\ts_nop 15" ::: "memory");
        { int fr_ = fr, fq_ = fq; asm volatile("" : "+v"(fr_), "+v"(fq_));
          const int qv_ = S.fetch(ui); E(acc, cur, ui, wr, wc, fr_, fq_); S.post(ui, qv_); }
        if (!has_next) break;
#pragma unroll
        for (int a = 0; a < 2; ++a)
#pragma unroll
            for (int b = 0; b < 2; ++b)
#pragma unroll
                for (int m = 0; m < 4; ++m)
#pragma unroll
                    for (int n = 0; n < 2; ++n) acc[a][b][m][n] = (f32x4){0.f, 0.f, 0.f, 0.f};
        cur = nxt; cB = nB; ++ui;
        PG8_OA(oaC, ui, cur);
        if (wr == 1) PG8_BAR;
    }
    PG8_WAIT_V(0);
    PG8_BAR;
#undef PG8_SA
#undef PG8_SB
#undef PG8_STAGE
#undef PG8_LDA
#undef PG8_LDB
#undef PG8_MMA
#undef PG8_WAIT_V
#undef PG8_WAIT_L
#undef PG8_BAR
#undef PG8_SCHED
#undef PG8_OA
}
}
#include <hip/hip_bf16.h>
#include <cmath>
namespace attn_body {
using bf16=__hip_bfloat16;
using bf16x8=__attribute__((ext_vector_type(8)))short;
using s16x4=__attribute__((ext_vector_type(4)))short;
using f32x16=__attribute__((ext_vector_type(16)))float;
using u32x4=__attribute__((ext_vector_type(4)))unsigned;
constexpr int SEQ=4096,D=64,QP=512,OP=1024;
constexpr int NW=8,QBLK=32,QB=QBLK*NW,KVBLK=64,NQB=SEQ/QB;
constexpr int ATTN_UNIT_ROWS=QB;
__device__ __forceinline__ int crow(int r,int hi){return (r&3)+8*(r>>2)+4*hi;}
#define SBAR() __builtin_amdgcn_sched_barrier(0)
__device__ __forceinline__ void cmask(f32x16&p0,f32x16&p1,int jb,int qrel,int hi){
  const float NEG=-INFINITY; int kb=64*jb+4*hi;
  #pragma unroll
  for(int r=0;r<16;++r){int kv=kb+(r&3)+8*(r>>2); if(kv>qrel)p0[r]=NEG; if(kv+32>qrel)p1[r]=NEG;}
}

__device__ __forceinline__ void smask(f32x16&p0,f32x16&p1,int jb,int qrel,int hi){
  const float NEG=-INFINITY; int kb=64*jb+4*hi;
  #pragma unroll
  for(int r=0;r<16;++r){int kv=kb+(r&3)+8*(r>>2); if(kv>qrel||kv<=qrel-128)p0[r]=NEG; if(kv+32>qrel||kv+32<=qrel-128)p1[r]=NEG;}
}
constexpr int NSLOT=3, SLOTB=8192;
constexpr int LDS_K=0, LDS_V=NSLOT*SLOTB, LDS_WS=2*NSLOT*SLOTB, LDS_OST=LDS_WS+NW*64*4, LDS_BYTES=LDS_OST+NW*4096;
constexpr float C2=0.125f*1.4426950408889634f;
__device__ __forceinline__ void glds16(const void*gsrc,unsigned lds_dst){unsigned keep;
  asm volatile("s_mov_b32 %0, m0\n\ts_mov_b32 m0, %2\n\ts_nop 0\n\tglobal_load_lds_dwordx4 %1, off\n\ts_mov_b32 m0, %0":"=&s"(keep):"v"(gsrc),"s"(lds_dst):"memory");}
__device__ __forceinline__ float max3f(float a,float b,float c){float r;asm("v_max3_f32 %0, %1, %2, %3":"=v"(r):"v"(a),"v"(b),"v"(c));return r;}
__device__ __forceinline__ float max2f(float a,float b){float r;asm("v_max_f32_e32 %0, %1, %2":"=v"(r):"v"(a),"v"(b));return r;}
__device__ __forceinline__ float fadd_s(float a,float b){float r;asm("v_add_f32_e32 %0, %1, %2":"=v"(r):"v"(a),"v"(b));return r;}
__device__ __forceinline__ float fsub_s(float a,float b){float r;asm("v_sub_f32_e32 %0, %1, %2":"=v"(r):"v"(a),"v"(b));return r;}
typedef float f32x2_t __attribute__((ext_vector_type(2))); typedef __bf16 bf16x2_t __attribute__((ext_vector_type(2)));
__device__ __forceinline__ unsigned cvtpk_s(float lo,float hi){f32x2_t v={lo,hi};bf16x2_t b=__builtin_convertvector(v,bf16x2_t);return __builtin_bit_cast(unsigned,b);}
#define WAIT_BAR(N) asm volatile("s_waitcnt vmcnt(" #N ") lgkmcnt(0)\n\ts_barrier":::"memory")

__device__ __forceinline__ void qkt(f32x16&p0,f32x16&p1,const char*Kslot,const bf16x8*qr,const f32x16&negm,int r32,int hi){
  const char*kb=Kslot+hi*1024+r32*16;
  #pragma unroll
  for(int d0=0;d0<4;++d0){
    const bf16x8 b0=*reinterpret_cast<const bf16x8*>(kb+d0*2048);
    const bf16x8 b1=*reinterpret_cast<const bf16x8*>(kb+d0*2048+512);
    if(d0==0){p0=__builtin_amdgcn_mfma_f32_32x32x16_bf16(b0,qr[0],negm,0,0,0);p1=__builtin_amdgcn_mfma_f32_32x32x16_bf16(b1,qr[0],negm,0,0,0);}
    else{p0=__builtin_amdgcn_mfma_f32_32x32x16_bf16(b0,qr[d0],p0,0,0,0);p1=__builtin_amdgcn_mfma_f32_32x32x16_bf16(b1,qr[d0],p1,0,0,0);}}
}
typedef __attribute__((address_space(3))) const char* lds_cptr;
typedef short v4i16_t __attribute__((ext_vector_type(4)));
__device__ __forceinline__ void kload8(bf16x8*kf,lds_cptr kp){
  kf[0]=*(const __attribute__((address_space(3))) bf16x8*)(kp);      kf[1]=*(const __attribute__((address_space(3))) bf16x8*)(kp+512);
  kf[2]=*(const __attribute__((address_space(3))) bf16x8*)(kp+2048); kf[3]=*(const __attribute__((address_space(3))) bf16x8*)(kp+2560);
  kf[4]=*(const __attribute__((address_space(3))) bf16x8*)(kp+4096); kf[5]=*(const __attribute__((address_space(3))) bf16x8*)(kp+4608);
  kf[6]=*(const __attribute__((address_space(3))) bf16x8*)(kp+6144); kf[7]=*(const __attribute__((address_space(3))) bf16x8*)(kp+6656);
}
__device__ __forceinline__ void kload2(bf16x8*kf,lds_cptr kp,int j){ kf[2*j]=*(const __attribute__((address_space(3))) bf16x8*)(kp+j*2048); kf[2*j+1]=*(const __attribute__((address_space(3))) bf16x8*)(kp+j*2048+512); }
__device__ __forceinline__ s16x4 vtr(lds_cptr p){ return __builtin_bit_cast(s16x4,__builtin_amdgcn_ds_read_tr16_b64_v4i16((__attribute__((address_space(3))) v4i16_t*)p)); }
__device__ __forceinline__ float rowmax(const f32x16&p0,const f32x16&p1){
  float a=max3f(p0[0],p0[1],p1[0]),b=max3f(p0[2],p0[3],p1[1]);a=max3f(a,p1[2],p1[3]);
  #pragma unroll
  for(int r=4;r<16;r+=4){a=max3f(a,p0[r],p0[r+1]);b=max3f(b,p0[r+2],p0[r+3]);a=max3f(a,p1[r],p1[r+1]);b=max3f(b,p1[r+2],p1[r+3]);}
  const float m=max2f(a,b);
  auto rr=__builtin_amdgcn_permlane32_swap(__float_as_uint(m),__float_as_uint(m),false,false);
  return max2f(__uint_as_float(rr[0]),__uint_as_float(rr[1]));
}
__device__ __forceinline__ void pv(f32x16*o,int vb,bf16x8 pa0,bf16x8 pa1,bf16x8 pa2,bf16x8 pa3){
  #pragma unroll
  for(int d0=0;d0<2;++d0){s16x4 lo[4],hi[4];
    #pragma unroll
    for(int ks=0;ks<4;++ks){
      asm volatile("ds_read_b64_tr_b16 %0,%1 offset:%c2":"=&v"(lo[ks]):"v"(vb),"i"(d0*4096+ks*1024):"memory");
      asm volatile("ds_read_b64_tr_b16 %0,%1 offset:%c2":"=&v"(hi[ks]):"v"(vb),"i"(d0*4096+ks*1024+512):"memory");}
    asm volatile("s_waitcnt lgkmcnt(0)":::"memory");SBAR();
    #define PK(k) (bf16x8){lo[k][0],lo[k][1],lo[k][2],lo[k][3],hi[k][0],hi[k][1],hi[k][2],hi[k][3]}
    o[d0]=__builtin_amdgcn_mfma_f32_32x32x16_bf16(pa0,PK(0),o[d0],0,0,0);
    o[d0]=__builtin_amdgcn_mfma_f32_32x32x16_bf16(pa1,PK(1),o[d0],0,0,0);
    o[d0]=__builtin_amdgcn_mfma_f32_32x32x16_bf16(pa2,PK(2),o[d0],0,0,0);
    o[d0]=__builtin_amdgcn_mfma_f32_32x32x16_bf16(pa3,PK(3),o[d0],0,0,0);
    #undef PK
  }
}

#ifndef ATTN_STORE16
#define ATTN_STORE16(p,v) (*(u32x4*)(p)=(v))
#endif
template<int MODE,int KP,int VP,int THRL> __device__ __forceinline__ void attn_unit(long rowbase,int q0,const bf16*Qh,const bf16*__restrict__ Kh0,const bf16*__restrict__ Vh0,bf16*Oh,float sink2a,float sink2b,char*shm){
  int tid=threadIdx.x; asm volatile("":"+v"(tid));
  const int lane=tid&63,r32=lane&31,hi=lane>>5; const int wid=__builtin_amdgcn_readfirstlane(tid>>6);
  const int t0=(MODE==1&&q0>=128)?(q0/KVBLK-2):0;
  const int wrow=(MODE==1)?(wid&3)*QBLK:wid*QBLK, whd=(MODE==1)?(wid>>2)*D:0;
  const float sink2=(MODE==1&&(wid>>2))?sink2b:sink2a;
  const bf16*Qw=Qh+whd+(rowbase+q0+wrow)*QP;
  const bf16*Kh=Kh0+(rowbase+(long)t0*KVBLK)*KP,*Vh=Vh0+(rowbase+(long)t0*KVBLK)*VP;
  const unsigned lds0=(unsigned)(uintptr_t)shm;
  float*wsf=(float*)(shm+LDS_WS)+wid*64;
  const bf16*ksrc=Kh+(long)lane*KP+wid*8;
  const bf16*vsrc=Vh+(long)(16*(wid&3)+(lane>>2))*VP+(wid>>2)*32+(lane&3)*8;
  const unsigned kdst=lds0+LDS_K+wid*1024, vdst=lds0+LDS_V+wid*1024;
  #define DMA_K(t,slot) glds16(ksrc+(long)(t)*KVBLK*KP,(unsigned)__builtin_amdgcn_readfirstlane(kdst+(slot)))
  #define DMA_V(t,slot) glds16(vsrc+(long)(t)*KVBLK*VP,(unsigned)__builtin_amdgcn_readfirstlane(vdst+(slot)))
  const int vb0=(int)(lds0+LDS_V)+((lane>>4)&1)*32+(lane&3)*8+(4*hi+((lane&15)>>2))*64;
  const char*Kbase=shm+LDS_K; bf16x8 kf[8];
  const lds_cptr shm3=(lds_cptr)shm; const lds_cptr kp0=shm3+LDS_K+hi*1024+r32*16; const lds_cptr vp0=shm3+LDS_V+((lane>>4)&1)*32+(lane&3)*8+(4*hi+((lane&15)>>2))*64;
  const int NT=(MODE==1)?4:(q0+QB)/KVBLK;
  const int jb0=(MODE==1)?(t0-q0/KVBLK):0;
  DMA_K(0,0);DMA_V(0,0);DMA_K(1,SLOTB);
  bf16x8 qr[4];
  #pragma unroll
  for(int d0=0;d0<4;++d0)qr[d0]=*reinterpret_cast<const bf16x8*>(&Qw[(long)r32*QP+d0*16+hi*8]);
  float mhat=0.f,l_reg=0.f;f32x16 o[2];o[0]=f32x16{};o[1]=f32x16{};f32x16 negm=f32x16{};asm volatile("":"+v"(negm));
  const int qrel=wrow+r32;
  #define CMASK(P0,P1,t) do{int jb_=(t)-(NT-4); if(MODE==1)smask(P0,P1,(t)+jb0,qrel,hi); else if(jb_>=0)cmask(P0,P1,jb_,qrel,hi);}while(0)
  bool resc=false;
  #define START(P0,P1) do{ const float rm=rowmax(P0,P1); resc=false; \
    { const float dl=max2f(rm,-64.f); mhat=fadd_s(mhat,dl); \
      _Pragma("unroll") for(int r=0;r<16;++r){P0[r]=fsub_s(P0[r],dl);P1[r]=fsub_s(P1[r],dl);} \
      _Pragma("unroll") for(int r=0;r<16;++r)negm[r]=-mhat; asm volatile("":"+v"(negm)); } \
    _Pragma("unroll") for(int r=0;r<16;++r)P0[r]=__builtin_amdgcn_exp2f(P0[r]); }while(0)
  #define RESC() do{ if(resc){ asm volatile("s_waitcnt lgkmcnt(0)":::"memory"); \
      _Pragma("unroll") for(int d_=0;d_<2;++d_) _Pragma("unroll") for(int r=0;r<16;++r)o[d_][r]*=wsf[crow(r,hi)]; } }while(0)
  f32x16 pA0,pA1,pB0,pB1;
  int sl_prev=0,sl_cur=0,sl_next=SLOTB;
  #define ROT() do{sl_prev=sl_cur;sl_cur=sl_next;sl_next=(sl_next==(NSLOT-1)*SLOTB)?0:sl_next+SLOTB;}while(0)
  DMA_K(2,2*SLOTB);
  WAIT_BAR(3);
  qkt(pA0,pA1,Kbase,qr,negm,r32,hi);asm volatile("s_nop 15\n\ts_nop 7":"+v"(pA0),"+v"(pA1));CMASK(pA0,pA1,0);
  START(pA0,pA1);
  _Pragma("unroll") for(int r=0;r<16;++r)pA1[r]=__builtin_amdgcn_exp2f(pA1[r]);
  WAIT_BAR(0);
  DMA_K(3,0);DMA_V(1,SLOTB);
  ROT();
  kload8(kf,kp0+sl_cur);
  WAIT_BAR(2);
  s16x4 vlo[8],vhi[8]; u32x4 pw0,pw1,pw2,pw3;
  #define PKW(P,B) cvtpk_s(P[B],P[B+1])
  #define PAF(k) __builtin_bit_cast(bf16x8,pw##k)
  #define VFR(i) (bf16x8){vlo[i][0],vlo[i][1],vlo[i][2],vlo[i][3],vhi[i][0],vhi[i][1],vhi[i][2],vhi[i][3]}
  #define PIN(x) asm volatile("":"+v"(x))
  #define MX3(a,b,c) __builtin_fmaxf(__builtin_fmaxf((a),(b)),(c))
  #define GAPA(MF,A0,A1,A2,A3,W0,W1,PW) do{ MF; sacc+=A0; sacc+=A1; sacc+=A2; sacc+=A3; PIN(sacc); W0; W1; PIN(PW); SBAR(); }while(0)
  #define EX(v) __builtin_amdgcn_exp2f(v)
  #define GAPB(MF,X,B) do{ MF; X[B]=EX(X[B]); X[B+1]=EX(X[B+1]); X[B+2]=EX(X[B+2]); X[B+3]=EX(X[B+3]); PIN(X); SBAR(); }while(0)
  #define VRD(i) do{ vlo[i]=vtr(vp_+(((i)>>2)*4096+((i)&3)*1024)); vhi[i]=vtr(vp_+(((i)>>2)*4096+((i)&3)*1024+512)); }while(0)
  #define KRD(G,j) do{ if(G){ kload2(kf,kp0+sl_next,j); SBAR(); } }while(0)
  #define STEP(C0,C1,P0,P1,t,GK,GV,GL) do{ SBAR(); \
    const lds_cptr vp_=vp0+sl_prev; \
    VRD(0); SBAR(); float sacc=(P0[0]+P0[1]); \
    GAPA(C0=__builtin_amdgcn_mfma_f32_32x32x16_bf16(kf[0],qr[0],negm,0,0,0), P0[2],P0[3],P0[4],P0[5],     pw0[0]=PKW(P0,0), pw0[1]=PKW(P0,2), pw0); \
    VRD(4); SBAR(); GAPA(C1=__builtin_amdgcn_mfma_f32_32x32x16_bf16(kf[1],qr[0],negm,0,0,0), P0[6],P0[7],P0[8],P0[9],     pw0[2]=PKW(P0,4), pw0[3]=PKW(P0,6), pw0); \
    VRD(1); SBAR(); GAPA(C0=__builtin_amdgcn_mfma_f32_32x32x16_bf16(kf[2],qr[1],C0,0,0,0),   P0[10],P0[11],P0[12],P0[13], pw1[0]=PKW(P0,8), pw1[1]=PKW(P0,10), pw1); \
    VRD(5); SBAR(); GAPA(C1=__builtin_amdgcn_mfma_f32_32x32x16_bf16(kf[3],qr[1],C1,0,0,0),   P0[14],P0[15],P1[0],P1[1],   pw1[2]=PKW(P0,12),pw1[3]=PKW(P0,14), pw1); \
    VRD(2); SBAR(); GAPA(C0=__builtin_amdgcn_mfma_f32_32x32x16_bf16(kf[4],qr[2],C0,0,0,0),   P1[2],P1[3],P1[4],P1[5],     pw2[0]=PKW(P1,0), pw2[1]=PKW(P1,2), pw2); \
    VRD(6); SBAR(); GAPA(C1=__builtin_amdgcn_mfma_f32_32x32x16_bf16(kf[5],qr[2],C1,0,0,0),   P1[6],P1[7],P1[8],P1[9],     pw2[2]=PKW(P1,4), pw2[3]=PKW(P1,6), pw2); \
    VRD(3); SBAR(); GAPA(C0=__builtin_amdgcn_mfma_f32_32x32x16_bf16(kf[6],qr[3],C0,0,0,0),   P1[10],P1[11],P1[12],P1[13], pw3[0]=PKW(P1,8), pw3[1]=PKW(P1,10), pw3); \
    VRD(7); SBAR(); GAPA(C1=__builtin_amdgcn_mfma_f32_32x32x16_bf16(kf[7],qr[3],C1,0,0,0),   P1[14],P1[15],0.f,0.f,       pw3[2]=PKW(P1,12),pw3[3]=PKW(P1,14), pw3); \
    l_reg+=sacc; \
    if(GK){DMA_K((t)+3,sl_cur);} if(GV){DMA_V((t)+1,sl_next);} \
    CMASK(C0,C1,t); \
    { float a=MX3(C0[0],C0[1],C1[0]),b=MX3(C0[2],C0[3],C1[1]); a=MX3(a,C1[2],C1[3]); \
      _Pragma("unroll") for(int r=4;r<16;r+=4){a=MX3(a,C0[r],C0[r+1]);b=MX3(b,C0[r+2],C0[r+3]);a=MX3(a,C1[r],C1[r+1]);b=MX3(b,C1[r+2],C1[r+3]);} \
      float rm=__builtin_fmaxf(a,b); { auto rr=__builtin_amdgcn_permlane32_swap(__float_as_uint(rm),__float_as_uint(rm),false,false); rm=__builtin_fmaxf(__uint_as_float(rr[0]),__uint_as_float(rr[1])); } \
      resc=false; \
      if(__builtin_expect(__any(rm>(float)THRL),0)){ const float dl=__builtin_fmaxf(rm,0.f); mhat+=dl; \
        _Pragma("unroll") for(int r=0;r<16;++r){C0[r]-=dl;C1[r]-=dl;} \
        _Pragma("unroll") for(int r=0;r<16;++r)negm[r]=-mhat; asm volatile("":"+v"(negm)); \
        const float f=__builtin_amdgcn_exp2f(-dl); l_reg*=f; if(hi==0)wsf[r32]=f; resc=true; } } \
    SBAR(); \
    GAPB(o[0]=__builtin_amdgcn_mfma_f32_32x32x16_bf16(PAF(0),VFR(0),o[0],0,0,0), C0,0); \
    GAPB(o[1]=__builtin_amdgcn_mfma_f32_32x32x16_bf16(PAF(0),VFR(4),o[1],0,0,0), C0,4); \
    KRD(GL,0); GAPB(o[0]=__builtin_amdgcn_mfma_f32_32x32x16_bf16(PAF(1),VFR(1),o[0],0,0,0), C0,8); \
    KRD(GL,1); GAPB(o[1]=__builtin_amdgcn_mfma_f32_32x32x16_bf16(PAF(1),VFR(5),o[1],0,0,0), C0,12); \
    KRD(GL,2); GAPB(o[0]=__builtin_amdgcn_mfma_f32_32x32x16_bf16(PAF(2),VFR(2),o[0],0,0,0), C1,0); \
    KRD(GL,3); GAPB(o[1]=__builtin_amdgcn_mfma_f32_32x32x16_bf16(PAF(2),VFR(6),o[1],0,0,0), C1,4); \
    GAPB(o[0]=__builtin_amdgcn_mfma_f32_32x32x16_bf16(PAF(3),VFR(3),o[0],0,0,0), C1,8); \
    GAPB(o[1]=__builtin_amdgcn_mfma_f32_32x32x16_bf16(PAF(3),VFR(7),o[1],0,0,0), C1,12); \
    }while(0)
  int t=1;
  #undef CMASK
  #define CMASK(P0,P1,t) do{}while(0)
  for(;t+5<NT;t+=2){
    STEP(pB0,pB1,pA0,pA1,t,true,true,true);     WAIT_BAR(2); RESC(); ROT();
    STEP(pA0,pA1,pB0,pB1,t+1,true,true,true);   WAIT_BAR(2); RESC(); ROT();
  }
  #undef CMASK
  #define CMASK(P0,P1,t) do{int jb_=(t)-(NT-4); if(MODE==1)smask(P0,P1,(t)+jb0,qrel,hi); else if(jb_>=0)cmask(P0,P1,jb_,qrel,hi);}while(0)
  #define ENDW(tt) do{ if((tt)+3<NT){WAIT_BAR(2);} else if((tt)+2<NT){WAIT_BAR(1);} else {WAIT_BAR(0);} }while(0)
  for(;t+1<NT;t+=2){
    STEP(pB0,pB1,pA0,pA1,t,(t+3<NT),(t+1<NT),(t+1<NT));       ENDW(t);   RESC(); ROT();
    STEP(pA0,pA1,pB0,pB1,t+1,(t+4<NT),(t+2<NT),(t+2<NT));     ENDW(t+1); RESC(); ROT();
  }
  STEP(pB0,pB1,pA0,pA1,NT-1,false,false,false); RESC();
  { float sacc=pB0[0]+pB0[1]; _Pragma("unroll") for(int r=2;r<16;++r)sacc+=pB0[r]; _Pragma("unroll") for(int r=0;r<16;++r)sacc+=pB1[r]; l_reg+=sacc;
    pw0=(u32x4){PKW(pB0,0),PKW(pB0,2),PKW(pB0,4),PKW(pB0,6)};pw1=(u32x4){PKW(pB0,8),PKW(pB0,10),PKW(pB0,12),PKW(pB0,14)};pw2=(u32x4){PKW(pB1,0),PKW(pB1,2),PKW(pB1,4),PKW(pB1,6)};pw3=(u32x4){PKW(pB1,8),PKW(pB1,10),PKW(pB1,12),PKW(pB1,14)};
    SBAR(); pv(o,vb0+sl_cur,PAF(0),PAF(1),PAF(2),PAF(3)); }
  #undef PKW
  #undef PAF
  #undef VFR
  #undef PIN
  #undef MX3
  #undef GAPA
  #undef GAPB
  #undef EX
  #undef VRD
  #undef KRD
  #undef STEP
  #undef ENDW
  {auto rr=__builtin_amdgcn_permlane32_swap(__float_as_uint(l_reg),__float_as_uint(l_reg),false,false);l_reg=__uint_as_float(rr[0])+__uint_as_float(rr[1]);}
  if(MODE==1)l_reg+=__builtin_amdgcn_exp2f(sink2-mhat);
  if(hi==0)wsf[32+r32]=l_reg;asm volatile("s_waitcnt lgkmcnt(0)":::"memory");
  float rli[16];
  #pragma unroll
  for(int r=0;r<16;++r)rli[r]=__builtin_amdgcn_rcpf(wsf[32+crow(r,hi)]);
  bf16*Ow=Oh+whd+(rowbase+q0+wrow)*OP;
  { bf16*stg=(bf16*)(shm+LDS_OST)+wid*2048;
    #pragma unroll
    for(int r=0;r<16;++r){const int orow=crow(r,hi);
      #pragma unroll
      for(int d0=0;d0<2;++d0)stg[orow*64+d0*32+r32]=__float2bfloat16(o[d0][r]*rli[r]);}
    asm volatile("s_waitcnt lgkmcnt(0)":::"memory");
    #pragma unroll
    for(int i=0;i<4;++i){const int row=i*8+(lane>>3),ch=lane&7; const u32x4 v=*(const u32x4*)(stg+row*64+ch*8); ATTN_STORE16(Ow+(long)row*OP+ch*8,v);} }
  asm volatile("s_waitcnt lgkmcnt(0)\n\ts_barrier":::"memory");
  #undef DMA_K
  #undef DMA_V
  #undef CMASK
  #undef START
  #undef RESC
  #undef ROT
}
constexpr int V2SLOT=16384;
constexpr int L2_K=0, L2_V=NSLOT*SLOTB, L2_WS=L2_V+NSLOT*V2SLOT, L2_OST=L2_WS+NW*64*4, L2_BYTES=L2_OST+NW*4096;
template<int THRL> __device__ __forceinline__ void attn_unit128(long rowbase,int q0,const bf16*Qh,const bf16*__restrict__ Kh0,const bf16*__restrict__ Vh0,bf16*Oh,bool cmb,float lam,const float*gsub,char*shm){
  constexpr int KP=512,VP=512;
  int tid=threadIdx.x; asm volatile("":"+v"(tid));
  const int lane=tid&63,r32=lane&31,hi=lane>>5; const int wid=__builtin_amdgcn_readfirstlane(tid>>6);
  const bf16*Qw=Qh+(rowbase+q0+wid*QBLK)*QP;
  const bf16*Kh=Kh0+rowbase*KP,*Vh=Vh0+rowbase*VP;
  const unsigned lds0=(unsigned)(uintptr_t)shm;
  float*wsf=(float*)(shm+L2_WS)+wid*64;
  const bf16*ksrc=Kh+(long)lane*KP+wid*8;
  const bf16*vsrc=Vh+(long)(16*(wid&3)+(lane>>2))*VP+(wid>>2)*32+(lane&3)*8;
  const unsigned kdst=lds0+L2_K+wid*1024, vdst=lds0+L2_V+wid*1024;
  #define DK128(t,slot) glds16(ksrc+(long)(t)*KVBLK*KP,(unsigned)__builtin_amdgcn_readfirstlane(kdst+(slot)))
  #define DV128(t,slot) do{ glds16(vsrc+(long)(t)*KVBLK*VP,(unsigned)__builtin_amdgcn_readfirstlane(vdst+(slot))); glds16(vsrc+(long)(t)*KVBLK*VP+64,(unsigned)__builtin_amdgcn_readfirstlane(vdst+(slot)+8192)); }while(0)
  const lds_cptr shm3=(lds_cptr)shm; const lds_cptr kp0=shm3+L2_K+hi*1024+r32*16; const lds_cptr vp0=shm3+L2_V+((lane>>4)&1)*32+(lane&3)*8+(4*hi+((lane&15)>>2))*64;
  const int NT=(q0+QB)/KVBLK;
  DK128(0,0);DV128(0,0);DK128(1,SLOTB);
  typedef __attribute__((address_space(3))) bf16x8* lds_q8;
  const lds_q8 qst=(lds_q8)(shm3+L2_OST+wid*4096+lane*16);
  { bf16x8 qt[4];
    #pragma unroll
    for(int d0=0;d0<4;++d0)qt[d0]=*reinterpret_cast<const bf16x8*>(&Qw[(long)r32*QP+d0*16+hi*8]);
    #pragma unroll
    for(int d0=0;d0<4;++d0)qst[d0*64]=qt[d0]; }
  float mhat=0.f,l_reg=0.f;f32x16 o[4];o[0]=f32x16{};o[1]=f32x16{};o[2]=f32x16{};o[3]=f32x16{};f32x16 negm=f32x16{};asm volatile("":"+v"(negm));
  const int qrel=wid*QBLK+r32;
  bool resc=false;
  f32x16 C0,C1; u32x4 pw0,pw1,pw2,pw3; bf16x8 kf[8]; s16x4 vfl[16],vfh[16];
  int ip=0,ic=0,in=1;
  #define ROT128() do{ip=ic;ic=in;in=(in==NSLOT-1)?0:in+1;}while(0)
  #define MF32(a,b,c) __builtin_amdgcn_mfma_f32_32x32x16_bf16(a,b,c,0,0,0)
  #define PV32(acc,a,b) do{ const bf16x8 a_=(a), b_=(b); asm volatile("v_mfma_f32_32x32x16_bf16 %0, %1, %2, %0":"+v"(acc):"v"(a_),"v"(b_)); }while(0)
  #define PIN(x) asm volatile("":"+v"(x))
  #define EXP2(CX,B) do{ CX[B]=__builtin_amdgcn_exp2f(CX[B]); CX[(B)+1]=__builtin_amdgcn_exp2f(CX[(B)+1]); sacc+=CX[B]; sacc+=CX[(B)+1]; }while(0)
  #define PACK2(CX,B,PN,W) do{ PN[W]=cvtpk_s(CX[B],CX[(B)+1]); }while(0)
  #define QK128(slotb) do{ kload8(kf,kp0+(slotb)); const bf16x8 q0_=qst[0],q1_=qst[64],q2_=qst[128],q3_=qst[192]; \
    C0=MF32(kf[0],q0_,negm); C1=MF32(kf[1],q0_,negm); C0=MF32(kf[2],q1_,C0); C1=MF32(kf[3],q1_,C1); \
    C0=MF32(kf[4],q2_,C0);   C1=MF32(kf[5],q2_,C1);   C0=MF32(kf[6],q3_,C0); C1=MF32(kf[7],q3_,C1); }while(0)
  #define QK128P(slotb) do{ kload8(kf,kp0+(slotb)); const bf16x8 q0_=qst[0],q1_=qst[64],q2_=qst[128],q3_=qst[192]; float sacc=0.f; SBAR(); \
    C0=MF32(kf[0],q0_,negm); EXP2(C1,0);  EXP2(C1,2);  PIN(sacc); PIN(C1); SBAR(); \
    C0=MF32(kf[2],q1_,C0);   EXP2(C1,4);  EXP2(C1,6);  PIN(sacc); PIN(C1); SBAR(); \
    C0=MF32(kf[4],q2_,C0);   EXP2(C1,8);  EXP2(C1,10); PIN(sacc); PIN(C1); SBAR(); \
    C0=MF32(kf[6],q3_,C0);   EXP2(C1,12); EXP2(C1,14); PIN(sacc); PIN(C1); SBAR(); \
    PACK2(C1,0,pw2,0); PACK2(C1,2,pw2,1); PACK2(C1,4,pw2,2); PACK2(C1,6,pw2,3); PACK2(C1,8,pw3,0); PACK2(C1,10,pw3,1); PACK2(C1,12,pw3,2); PACK2(C1,14,pw3,3); PIN(pw2); PIN(pw3); l_reg+=sacc; SBAR(); \
    C1=MF32(kf[1],q0_,negm); C1=MF32(kf[3],q1_,C1); C1=MF32(kf[5],q2_,C1); C1=MF32(kf[7],q3_,C1); }while(0)
  #define MX3(a,b,c) __builtin_fmaxf(__builtin_fmaxf((a),(b)),(c))
  #define ROWMAX128(rm) do{ float a_=MX3(C0[0],C0[1],C1[0]),b_=MX3(C0[2],C0[3],C1[1]); a_=MX3(a_,C1[2],C1[3]); \
      _Pragma("unroll") for(int r=4;r<16;r+=4){a_=MX3(a_,C0[r],C0[r+1]);b_=MX3(b_,C0[r+2],C0[r+3]);a_=MX3(a_,C1[r],C1[r+1]);b_=MX3(b_,C1[r+2],C1[r+3]);} \
      rm=__builtin_fmaxf(a_,b_); { auto rr=__builtin_amdgcn_permlane32_swap(__float_as_uint(rm),__float_as_uint(rm),false,false); rm=__builtin_fmaxf(__uint_as_float(rr[0]),__uint_as_float(rr[1])); } }while(0)
  #define VRD128(i,vp_) do{ vfl[i]=vtr((vp_)+(((i)>>2)*4096+((i)&3)*1024)); vfh[i]=vtr((vp_)+(((i)>>2)*4096+((i)&3)*1024+512)); }while(0)
  #define VFR128(i) (bf16x8){vfl[i][0],vfl[i][1],vfl[i][2],vfl[i][3],vfh[i][0],vfh[i][1],vfh[i][2],vfh[i][3]}
  #define GAP128(g,PP,vp_) do{ PV32(o[(g)&3],__builtin_bit_cast(bf16x8,PP),VFR128(4*((g)&3)+((g)>>2))); \
      if((g)+2<16){ VRD128(4*(((g)+2)&3)+(((g)+2)>>2),vp_); } if(((g)&1)==0){ EXP2(C0,g); PIN(C0); } \
      if((g)>=8){ if((g)<12){ PACK2(C0,2*((g)-8),pw0,(g)-8); PIN(pw0); } else { PACK2(C0,2*((g)-8),pw1,(g)-12); PIN(pw1); } } PIN(sacc); SBAR(); }while(0)
  #define PHASEB128(vp_) do{ float sacc=0.f; VRD128(0,vp_); VRD128(4,vp_); SBAR(); \
      GAP128(0,pw0,vp_);  GAP128(1,pw0,vp_);  GAP128(2,pw0,vp_);  GAP128(3,pw0,vp_); \
      GAP128(4,pw1,vp_);  GAP128(5,pw1,vp_);  GAP128(6,pw1,vp_);  GAP128(7,pw1,vp_); \
      GAP128(8,pw2,vp_);  GAP128(9,pw2,vp_);  GAP128(10,pw2,vp_); GAP128(11,pw2,vp_); \
      GAP128(12,pw3,vp_); GAP128(13,pw3,vp_); GAP128(14,pw3,vp_); GAP128(15,pw3,vp_); \
      l_reg+=sacc; }while(0)
  #define RESC128() do{ if(resc){ asm volatile("s_waitcnt lgkmcnt(0)\n\ts_nop 15\n\ts_nop 15":::"memory"); \
      _Pragma("unroll") for(int d_=0;d_<4;++d_) _Pragma("unroll") for(int r=0;r<16;++r)o[d_][r]*=wsf[crow(r,hi)]; } }while(0)
  #define STEP128(t,GK,GV,MASKED) do{ SBAR(); \
    QK128P(ic*SLOTB); \
    if(GK){DK128((t)+2,ip*SLOTB);} if(GV){DV128((t)+1,in*V2SLOT);} \
    if(MASKED){ const int jb_=(t)-(NT-4); if(jb_>=0)cmask(C0,C1,jb_,qrel,hi); } \
    { float rm; ROWMAX128(rm); resc=false; \
      if(__builtin_expect(__any(rm>(float)THRL),0)){ const float dl=__builtin_fmaxf(rm,0.f); mhat+=dl; \
        _Pragma("unroll") for(int r=0;r<16;++r){C0[r]-=dl;C1[r]-=dl;} \
        _Pragma("unroll") for(int r=0;r<16;++r)negm[r]=-mhat; asm volatile("":"+v"(negm)); \
        const float f=__builtin_amdgcn_exp2f(-dl); l_reg*=f; if(hi==0)wsf[r32]=f; resc=true; } } \
    SBAR(); \
    { const lds_cptr vpp_=vp0+ip*V2SLOT; PHASEB128(vpp_); } \
    }while(0)
  WAIT_BAR(3);
  QK128(0);
  if(NT==4)cmask(C0,C1,0,qrel,hi);
  { float rm; ROWMAX128(rm); const float dl=__builtin_fmaxf(rm,-64.f); mhat=dl;
    #pragma unroll
    for(int r=0;r<16;++r){C0[r]-=dl;C1[r]-=dl;}
    #pragma unroll
    for(int r=0;r<16;++r)negm[r]=-mhat;
    asm volatile("":"+v"(negm));
    float sacc=0.f;
    #pragma unroll
    for(int w=0;w<4;++w){ EXP2(C0,2*w); PACK2(C0,2*w,pw0,w); EXP2(C0,8+2*w); PACK2(C0,8+2*w,pw1,w); }
    l_reg=sacc; }
  DK128(2,2*SLOTB); DV128(1,V2SLOT);
  WAIT_BAR(3);
  ROT128();
  #pragma unroll 1
  for(int t=1;t<NT;++t){
    const bool gk=t+2<NT,gv=t+1<NT,msk=t>=NT-4;
    STEP128(t,gk,gv,msk);
    if(gk){WAIT_BAR(3);}else if(gv){WAIT_BAR(2);}else{WAIT_BAR(0);}
    RESC128(); if(gv)ROT128();
  }
  { float sacc=0.f;
    #pragma unroll
    for(int w=0;w<4;++w){ EXP2(C1,2*w); PACK2(C1,2*w,pw2,w); EXP2(C1,8+2*w); PACK2(C1,8+2*w,pw3,w); }
    l_reg+=sacc; }
  { const lds_cptr vpp_=vp0+ic*V2SLOT;
    #pragma unroll
    for(int i=0;i<16;++i)VRD128(i,vpp_);
    #pragma unroll
    for(int g=0;g<16;++g){ const int db=g&3,kc=g>>2; const u32x4 pp=kc==0?pw0:kc==1?pw1:kc==2?pw2:pw3; PV32(o[db],__builtin_bit_cast(bf16x8,pp),VFR128(4*db+kc)); }
    asm volatile("s_nop 15\n\ts_nop 15\n\ts_nop 7":"+v"(o[0]),"+v"(o[1]),"+v"(o[2]),"+v"(o[3])); }
  {auto rr=__builtin_amdgcn_permlane32_swap(__float_as_uint(l_reg),__float_as_uint(l_reg),false,false);l_reg=__uint_as_float(rr[0])+__uint_as_float(rr[1]);}
  if(hi==0)wsf[32+r32]=l_reg;asm volatile("s_waitcnt lgkmcnt(0)":::"memory");
  float rli[16];
  #pragma unroll
  for(int r=0;r<16;++r)rli[r]=__builtin_amdgcn_rcpf(wsf[32+crow(r,hi)]);
  bf16*Ow=Oh+(rowbase+q0+wid*QBLK)*OP;
  { bf16*stg=(bf16*)(shm+L2_OST)+wid*2048;
    u32x4 my[2][4];
    #pragma unroll
    for(int rd=0;rd<2;++rd){
      #pragma unroll
      for(int r=0;r<16;++r){const int orow=crow(r,hi);
        #pragma unroll
        for(int d0=0;d0<2;++d0)stg[orow*64+d0*32+r32]=__float2bfloat16(o[2*rd+d0][r]*rli[r]);}
      asm volatile("s_waitcnt lgkmcnt(0)":::"memory");
      #pragma unroll
      for(int i=0;i<4;++i){const int row=i*8+(lane>>3),ch=lane&7; my[rd][i]=*(const u32x4*)(stg+row*64+ch*8);}
      asm volatile("s_waitcnt lgkmcnt(0)":::"memory"); }
    if(!cmb){
      #pragma unroll
      for(int rd=0;rd<2;++rd)
        #pragma unroll
        for(int i=0;i<4;++i){const int row=i*8+(lane>>3),ch=lane&7; ATTN_STORE16(Ow+(long)row*OP+rd*64+ch*8,my[rd][i]);}
    } else {
      u32x4 o1[2][4]; float gv[2][8];
      #pragma unroll
      for(int rd=0;rd<2;++rd){
        #pragma unroll
        for(int i=0;i<4;++i){const int row=i*8+(lane>>3),ch=lane&7; o1[rd][i]=*(const u32x4*)(Ow+(long)row*OP+rd*64+ch*8);}
        #pragma unroll
        for(int j=0;j<8;++j)gv[rd][j]=gsub[rd*64+(lane&7)*8+j]; }
      #define BFLO(w) __uint_as_float((w)<<16)
      #define BFHI(w) __uint_as_float((w)&0xffff0000u)
      float dv[2][4][8]; float ss[4]={0.f,0.f,0.f,0.f};
      #pragma unroll
      for(int rd=0;rd<2;++rd)
        #pragma unroll
        for(int i=0;i<4;++i){ const u32x4 a=o1[rd][i],b2=my[rd][i];
          dv[rd][i][0]=BFLO(a[0])-lam*BFLO(b2[0]); dv[rd][i][1]=BFHI(a[0])-lam*BFHI(b2[0]); dv[rd][i][2]=BFLO(a[1])-lam*BFLO(b2[1]); dv[rd][i][3]=BFHI(a[1])-lam*BFHI(b2[1]);
          dv[rd][i][4]=BFLO(a[2])-lam*BFLO(b2[2]); dv[rd][i][5]=BFHI(a[2])-lam*BFHI(b2[2]); dv[rd][i][6]=BFLO(a[3])-lam*BFLO(b2[3]); dv[rd][i][7]=BFHI(a[3])-lam*BFHI(b2[3]);
          #pragma unroll
          for(int j=0;j<8;++j)ss[i]+=dv[rd][i][j]*dv[rd][i][j]; }
      #pragma unroll
      for(int i=0;i<4;++i){ ss[i]+=__shfl_xor(ss[i],1); ss[i]+=__shfl_xor(ss[i],2); ss[i]+=__shfl_xor(ss[i],4); ss[i]=0.8f/sqrtf(ss[i]*(1.f/128.f)+1e-5f); }
      #pragma unroll
      for(int rd=0;rd<2;++rd)
        #pragma unroll
        for(int i=0;i<4;++i){ const int row=i*8+(lane>>3),ch=lane&7; const float rr_=ss[i]; u32x4 w;
          w[0]=cvtpk_s(dv[rd][i][0]*rr_*gv[rd][0],dv[rd][i][1]*rr_*gv[rd][1]); w[1]=cvtpk_s(dv[rd][i][2]*rr_*gv[rd][2],dv[rd][i][3]*rr_*gv[rd][3]);
          w[2]=cvtpk_s(dv[rd][i][4]*rr_*gv[rd][4],dv[rd][i][5]*rr_*gv[rd][5]); w[3]=cvtpk_s(dv[rd][i][6]*rr_*gv[rd][6],dv[rd][i][7]*rr_*gv[rd][7]);
          ATTN_STORE16(Ow+(long)row*OP+rd*64+ch*8,w); }
      #undef BFLO
      #undef BFHI
    } }
  asm volatile("s_waitcnt lgkmcnt(0)\n\ts_barrier":::"memory");
  #undef DK128
  #undef DV128
  #undef ROT128
  #undef MF32
  #undef PV32
  #undef QK128
  #undef QK128P
  #undef MX3
  #undef ROWMAX128
  #undef PIN
  #undef VRD128
  #undef VFR128
  #undef EXP2
  #undef PACK2
  #undef GAP128
  #undef PHASEB128
  #undef RESC128
  #undef STEP128
}
constexpr int ATTN_LDS_BYTES=(LDS_BYTES>L2_BYTES)?LDS_BYTES:L2_BYTES;
#undef SBAR
#undef WAIT_BAR
}
#define GAS __attribute__((address_space(1)))
#define LAS __attribute__((address_space(3)))
typedef unsigned short bf16;
typedef unsigned v4u __attribute__((ext_vector_type(4)));
typedef float f32x4 __attribute__((ext_vector_type(4)));
typedef short bf16x8 __attribute__((ext_vector_type(8)));
typedef GAS unsigned gu32;
typedef GAS unsigned long long gu64;
#define RLX_AGENT __ATOMIC_RELAXED, __HIP_MEMORY_SCOPE_AGENT
#define LDS_WAIT() asm volatile("s_waitcnt lgkmcnt(0)" ::: "memory")
#define VM_WAIT() asm volatile("s_waitcnt vmcnt(0)" ::: "memory")
__device__ __forceinline__ unsigned long long rt() { return __builtin_amdgcn_s_memrealtime(); }
__device__ __forceinline__ unsigned f2bf(float f) { unsigned u = __builtin_bit_cast(unsigned, f); return (u + 0x7fffu + ((u >> 16) & 1u)) >> 16; }
__device__ __forceinline__ unsigned pk2(float lo, float hi) { return f2bf(lo) | (f2bf(hi) << 16); }

#define XB_TMO      128
#define XB_XCNT(j)  (256  + 64 * (j))
#define XB_XSUB(j)  (1280 + 64 * (j))
#define XB_XGEN(j)  (2304 + 64 * (j))
#define XB_TOP      3328
#define XB_TOPGEN   3392
#define XCD_BAR_WORDS 3456
#define XB_SPIN_CAP (1u << 18)

__device__ __forceinline__ unsigned xb_ld(unsigned* p)              { return __hip_atomic_load(p, __ATOMIC_RELAXED, __HIP_MEMORY_SCOPE_AGENT); }
__device__ __forceinline__ unsigned xb_add(unsigned* p, unsigned v) { return __hip_atomic_fetch_add(p, v, __ATOMIC_RELAXED, __HIP_MEMORY_SCOPE_AGENT); }
__device__ __forceinline__ unsigned xb_xcc_id() { return (unsigned)__builtin_amdgcn_s_getreg((3 << 11) | 20) & 0xFu; }
#define XB_SPIN(cond, bar) do { unsigned _sp = 0; while (cond) { __builtin_amdgcn_s_sleep(1); \
    if ((++_sp & 255u) == 0u) { if (xb_ld(&(bar)[XB_TMO])) break; if (_sp > XB_SPIN_CAP) { atomicAdd(&(bar)[XB_TMO], 1u); break; } } } } while (0)

struct XcdBarrier {
    unsigned* bar; unsigned x;
    volatile LAS unsigned* st;
};

__device__ __forceinline__ XcdBarrier xcd_barrier_post(unsigned* bar, volatile LAS unsigned* st) {
    XcdBarrier b; b.bar = bar; b.x = xb_xcc_id(); b.st = st;
    if (threadIdx.x == 0) (void)xb_add(&bar[XB_XCNT(b.x)], 1u);
    return b;
}
__device__ __forceinline__ void xcd_barrier_complete(unsigned* bar, unsigned x, unsigned& nloc, unsigned& nx) {
    const unsigned G = gridDim.x * gridDim.y * gridDim.z;
    unsigned sum, cnt, mine, sp = 0u;
    for (;;) {
        sum = 0u; cnt = 0u; mine = 0u;
#pragma unroll
        for (unsigned j = 0; j < 16; ++j) { const unsigned c = xb_ld(&bar[XB_XCNT(j)]); sum += c; cnt += (c > 0u) ? 1u : 0u; mine = (j == x) ? c : mine; }
        if (sum == G) break;
        __builtin_amdgcn_s_sleep(1);
        if ((++sp & 255u) == 0u) { if (xb_ld(&bar[XB_TMO])) break; if (sp > XB_SPIN_CAP) { atomicAdd(&bar[XB_TMO], 1u); break; } }
    }
    nloc = mine > 0u ? mine : 1u; nx = cnt > 0u ? cnt : 1u;
}

__device__ __forceinline__ void xcd_barrier(const XcdBarrier& b) {
    asm volatile("s_waitcnt vmcnt(0)" ::: "memory");
    __syncthreads();
    if (threadIdx.x == 0) {
        unsigned* bar = b.bar;
        __builtin_amdgcn_s_waitcnt(0);
        unsigned nloc = b.st[0], nx = b.st[1];
        if (nloc == 0u) { xcd_barrier_complete(bar, b.x, nloc, nx); b.st[0] = nloc; b.st[1] = nx; }
        const unsigned old = xb_add(&bar[XB_XSUB(b.x)], 1u);
        const unsigned gen = old / nloc;
        if (old + 1u == (gen + 1u) * nloc) {
            __builtin_amdgcn_fence(__ATOMIC_RELEASE, "agent");
            asm volatile("s_waitcnt vmcnt(0)" ::: "memory");
            const unsigned og = xb_add(&bar[XB_TOP], 1u);
            const unsigned tg = og / nx;
            if (og + 1u == (tg + 1u) * nx) xb_add(&bar[XB_TOPGEN], 1u);
            else XB_SPIN(xb_ld(&bar[XB_TOPGEN]) == tg, bar);
            __builtin_amdgcn_fence(__ATOMIC_ACQUIRE, "agent");
            xb_add(&bar[XB_XGEN(b.x)], 1u);
            asm volatile("s_waitcnt vmcnt(0)" ::: "memory");
        } else {
            XB_SPIN(xb_ld(&bar[XB_XGEN(b.x)]) == gen, bar);
            __builtin_amdgcn_fence(__ATOMIC_ACQUIRE, "agent");
            asm volatile("s_waitcnt vmcnt(0)" ::: "memory");
        }
    }
    __syncthreads();
}

constexpr int NWAVES = 8;
constexpr int NB = 8, SEQ = 4096, D = 1024, M = NB * SEQ, INW = 4352, NE = 32, FF = 1024;
constexpr float RMS_EPS = 1e-5f;
constexpr float QSCALE = 0.125f * 1.4426950408889634f;
constexpr float LOG2E = 1.4426950408889634f;
constexpr float SX = 16.f, SW = 512.f, SH = 4.f, SY = 64.f;
constexpr size_t MiB = 1u << 20;
constexpr size_t WS_CTL = 0, CTL_ZERO_BYTES = 1 * MiB;
constexpr size_t WS_ROPE = 1 * MiB;
constexpr size_t WS_ETOK = 2 * MiB;
constexpr size_t WS_EW = 6 * MiB;
constexpr size_t WS_ERS = 10 * MiB;
constexpr size_t WS_RWF = 14 * MiB;
constexpr size_t WS_WIN = 16 * MiB;
constexpr size_t WS_WA = 25 * MiB, WS_WO = 27 * MiB;
constexpr size_t WS_W1 = 30 * MiB;
constexpr size_t WS_W2 = 158 * MiB;
constexpr size_t WS_XN = 222 * MiB;
constexpr size_t WS_RS0 = 14 * MiB + 512 * 1024;
constexpr size_t WS_X1Q = 494 * MiB;
constexpr size_t WS_QA = 286 * MiB, WS_KA = 318 * MiB, WS_VA = 326 * MiB, WS_QB = 334 * MiB, WS_KB = 366 * MiB, WS_VB = 398 * MiB;
constexpr size_t WS_SGA = 430 * MiB, WS_SGB = 494 * MiB, WS_OSWA = 558 * MiB, WS_OD1 = 590 * MiB, WS_OD2 = 622 * MiB, WS_T = 654 * MiB;
constexpr size_t WS_H = 286 * MiB;
constexpr size_t WS_X1B = 430 * MiB;
constexpr size_t WS_Y = 558 * MiB;
constexpr size_t WS_END = 815 * MiB;
constexpr int CW_TMO = 0, CW_CODE = 1, CW_BAR = 4096, CW_CNT = 8192, CW_Q1 = 10240;
constexpr int NCONV = 64;
static_assert((CW_CNT + 64 * NE) * 4 <= (int)CTL_ZERO_BYTES, "CTL words inside the memset region");
constexpr int RING_OFF = 0, RING_BYTES = 131072;
constexpr int LDSCTL_OFF = RING_BYTES, MISC_OFF = LDSCTL_OFF + 320;
constexpr int SCHED_OFF = LDSCTL_OFF + 512;
constexpr int GTAB_OFF = SCHED_OFF + 1024;
constexpr int LDS_BYTES = 147456;
static_assert(GTAB_OFF + 17 * 512 <= LDS_BYTES, "LDS map");

__device__ const float INV_FREQ[32] = {1.000000000e+00f, 7.498942614e-01f, 5.623413324e-01f, 4.216965139e-01f, 3.162277639e-01f, 2.371373773e-01f, 1.778279394e-01f, 1.333521307e-01f, 1.000000015e-01f, 7.498941571e-02f, 5.623413250e-02f, 4.216965288e-02f, 3.162277490e-02f, 2.371373773e-02f, 1.778279431e-02f, 1.333521493e-02f, 9.999999776e-03f, 7.498941850e-03f, 5.623413250e-03f, 4.216964822e-03f, 3.162277630e-03f, 2.371373586e-03f, 1.778279431e-03f, 1.333521446e-03f, 1.000000047e-03f, 7.498942432e-04f, 5.623413017e-04f, 4.216965172e-04f, 3.162277571e-04f, 2.371373703e-04f, 1.778279402e-04f, 1.333521504e-04f};

struct Frame {
    LAS unsigned char* lds;
    volatile LAS unsigned* MISC;
    gu32* ctl;
    unsigned char* ws;
    int tid, lane, wave;
    int vcu, G;
    const float* in[21]; float* out;
};
__device__ __forceinline__ float wave_sum(float v) {
#pragma unroll
    for (int o = 1; o < 64; o <<= 1) v += __shfl_xor(v, o);
    return v;
}
__device__ __forceinline__ int proj_mode(int hb) { return hb < 4 ? 0 : hb == 4 ? 1 : hb == 5 ? 2 : hb < 10 ? 0 : hb < 14 ? 1 : hb < 18 ? 2 : 3; }
__device__ __forceinline__ void proj_dst(int hb, size_t& off, int& ldc, int& col0) {
    if (hb < 4) { off = WS_QA; ldc = 512; col0 = 128 * hb; }
    else if (hb == 4) { off = WS_KA; ldc = 128; col0 = 0; }
    else if (hb == 5) { off = WS_VA; ldc = 128; col0 = 0; }
    else if (hb < 10) { off = WS_QB; ldc = 512; col0 = 128 * (hb - 6); }
    else if (hb < 14) { off = WS_KB; ldc = 512; col0 = 128 * (hb - 10); }
    else if (hb < 18) { off = WS_VB; ldc = 512; col0 = 128 * (hb - 14); }
    else if (hb < 26) { off = WS_SGA; ldc = 1024; col0 = 128 * (hb - 18); }
    else { off = WS_SGB; ldc = 1024; col0 = 128 * (hb - 26); }
}
__device__ __forceinline__ int proj_rowmap(int n) { const int hb = n >> 7; if (proj_mode(hb) > 1) return n; const int d = n & 63; return (n & ~63) + 8 * ((d & 31) >> 2) + 4 * (d >> 5) + (d & 3); }

template <int RMODE> __device__ __forceinline__ void p0_transpose_item(const float* W, int K, int N, bf16* WT, const float* kscale, LAS float* scr, int item, int lane, int pitch = 0, int koff = 0) {
    if (pitch == 0) pitch = K;
    const int nblk = N / 32, kb = item / nblk, nb = item % nblk, k0 = 64 * kb, n0 = 32 * nb;
#pragma unroll 8
    for (int i = 0; i < 32; ++i) { const int kk = 2 * i + (lane >> 5); float v = W[(size_t)(k0 + kk) * N + n0 + (lane & 31)]; if (kscale) v *= kscale[k0 + kk]; scr[kk * 33 + (lane & 31)] = v; }
    LDS_WAIT(); asm volatile("" ::: "memory");
    const int c = lane & 7;
#pragma unroll
    for (int j = 0; j < 4; ++j) { const int n = (lane >> 3) + 8 * j; const LAS float* s = scr + (8 * c) * 33 + n;
        v4u o; o.x = pk2(s[0 * 33], s[1 * 33]); o.y = pk2(s[2 * 33], s[3 * 33]); o.z = pk2(s[4 * 33], s[5 * 33]); o.w = pk2(s[6 * 33], s[7 * 33]);
        const int drow = RMODE ? proj_rowmap(n0 + n) : (n0 + n);
        *(GAS v4u*)(WT + (size_t)drow * pitch + koff + k0 + 8 * c) = o; }
    LDS_WAIT(); asm volatile("" ::: "memory");
}
struct Fp8Item { const float* W; unsigned char* WT; const float* kscale; int K, N, k0, n0; };
__device__ __forceinline__ Fp8Item fp8_item_make(const float* W, int K, int N, unsigned char* WT, const float* kscale, int item) {
    const int nblk = N / 32, kb = item / nblk, nb = item % nblk; Fp8Item it{W, WT, kscale, K, N, 128 * kb, 32 * nb}; return it; }
__device__ __forceinline__ void fp8_item_load(const Fp8Item& it, f32x4 (&v)[4][4], f32x4 (&ksv)[4], int lane) {
    const int n4 = lane & 7, kq = lane >> 3;
#pragma unroll
    for (int p = 0; p < 4; ++p)
#pragma unroll
        for (int r = 0; r < 4; ++r) v[p][r] = __builtin_nontemporal_load((const GAS f32x4*)(it.W + (size_t)(it.k0 + 32 * p + 4 * kq + r) * it.N + it.n0 + 4 * n4));
#pragma unroll
    for (int p = 0; p < 4; ++p) ksv[p] = it.kscale ? *(const GAS f32x4*)(it.kscale + it.k0 + 32 * p + 4 * kq) : (f32x4){1.f, 1.f, 1.f, 1.f};
}
__device__ __forceinline__ void fp8_item_finish(const Fp8Item& it, const f32x4 (&v)[4][4], const f32x4 (&ksv)[4], float scale, LAS unsigned* scr, int lane) {
    const int n4 = lane & 7, kq = lane >> 3;
#pragma unroll
    for (int p = 0; p < 4; ++p) { float ks[4];
#pragma unroll
        for (int r = 0; r < 4; ++r) ks[r] = ksv[p][r] * scale;
#pragma unroll
        for (int j = 0; j < 4; ++j) { int w = 0; w = __builtin_amdgcn_cvt_pk_fp8_f32(v[p][0][j] * ks[0], v[p][1][j] * ks[1], w, false); w = __builtin_amdgcn_cvt_pk_fp8_f32(v[p][2][j] * ks[2], v[p][3][j] * ks[3], w, true);
            scr[(8 * p + kq) * 33 + 4 * n4 + j] = (unsigned)w; } }
    LDS_WAIT(); asm volatile("" ::: "memory");
    const int c = lane & 7, nn = lane >> 3;
#pragma unroll
    for (int i = 0; i < 4; ++i) { const int n = nn + 8 * i; const LAS unsigned* sp = scr + (4 * c) * 33 + n;
        v4u o; o.x = sp[0]; o.y = sp[33]; o.z = sp[66]; o.w = sp[99];
        __builtin_nontemporal_store(o, (GAS v4u*)(it.WT + (size_t)(it.n0 + n) * it.K + it.k0 + 16 * c)); }
    LDS_WAIT(); asm volatile("" ::: "memory");
}
__device__ __forceinline__ void rms_rows2_to_bf16(const float* xrow, const float* g, bf16* orow, float* invr, int lane) {
    const GAS f32x4* xr = (const GAS f32x4*)xrow + lane;
    f32x4 v[2][4]; float s[2] = {0.f, 0.f};
#pragma unroll
    for (int q = 0; q < 2; ++q)
#pragma unroll
        for (int j = 0; j < 4; ++j) v[q][j] = __builtin_nontemporal_load(xr + q * (D / 4) + 64 * j);
#pragma unroll
    for (int q = 0; q < 2; ++q)
#pragma unroll
        for (int j = 0; j < 4; ++j) s[q] += (v[q][j].x * v[q][j].x + v[q][j].y * v[q][j].y) + (v[q][j].z * v[q][j].z + v[q][j].w * v[q][j].w);
    f32x4 gg[4];
#pragma unroll
    for (int j = 0; j < 4; ++j) gg[j] = ((const GAS f32x4*)g)[lane + 64 * j];
#pragma unroll
    for (int q = 0; q < 2; ++q) { const float rt_ = sqrtf(wave_sum(s[q]) * (1.f / D) + RMS_EPS), rstd = 1.f / rt_; if (lane == 0) invr[q] = rt_;
        GAS unsigned long long* o8 = (GAS unsigned long long*)(orow + (size_t)q * D) + lane;
#pragma unroll
        for (int j = 0; j < 4; ++j) o8[64 * j] = (unsigned long long)pk2(v[q][j].x * rstd * gg[j].x, v[q][j].y * rstd * gg[j].y) | ((unsigned long long)pk2(v[q][j].z * rstd * gg[j].z, v[q][j].w * rstd * gg[j].w) << 32); }
}
__device__ __forceinline__ void p0_prologue(Frame& F) {
    LAS float* scr = (LAS float*)(F.lds + RING_OFF + F.wave * 16384);
    const int gw = F.vcu * NWAVES + F.wave, NGW = F.G * NWAVES;
    const float* w_in = F.in[2]; const float* wa = F.in[10]; const float* wb = F.in[11]; const float* wo = F.in[12];
    bf16* WIN = (bf16*)(F.ws + WS_WIN); bf16* WA = (bf16*)(F.ws + WS_WA); bf16* WO = (bf16*)(F.ws + WS_WO);
    constexpr int I_IN = (D / 64) * (INW / 32), I_A = (512 / 64) * (D / 32), I_O = (D / 64) * (D / 32);
    constexpr int NITEMS = I_IN + 2 * I_A + I_O;
    for (int it = gw; it < NITEMS; it += NGW) {
        int r = it;
        if (r < I_IN) { p0_transpose_item<1>(w_in, D, INW, WIN, nullptr, scr, r, F.lane); continue; } r -= I_IN;
        if (r < I_A) { p0_transpose_item<0>(wa, 512, D, WA, nullptr, scr, r, F.lane, 1024, 0); continue; } r -= I_A;
        if (r < I_A) { p0_transpose_item<0>(wb, 512, D, WA, nullptr, scr, r, F.lane, 1024, 512); continue; } r -= I_A;
        p0_transpose_item<0>(wo, D, D, WO, nullptr, scr, r, F.lane);
    }
    bf16* XN = (bf16*)(F.ws + WS_XN);
    for (int m = 2 * gw; m < M; m += 2 * NGW) rms_rows2_to_bf16(F.in[0] + (size_t)m * D, F.in[1], XN + (size_t)m * D, (float*)(F.ws + WS_RS0) + m, F.lane);
    const int gt = F.vcu * (NWAVES * 64) + F.tid, NGT = F.G * NWAVES * 64;
    unsigned* rope = (unsigned*)(F.ws + WS_ROPE);
    for (int idx = gt; idx < SEQ * 32; idx += NGT) { const int s = idx >> 5, i = idx & 31; const float ang = (float)s * INV_FREQ[i];
        const double rev = (double)ang * 0.15915494309189535; const double fr = rev - rint(rev);
        rope[idx] = pk2(__builtin_amdgcn_cosf((float)fr), __builtin_amdgcn_sinf((float)fr)); }
    v4u* rwf = (v4u*)(F.ws + WS_RWF);
    for (int idx = gt; idx < 64 * 64; idx += NGT) { const int ks = idx >> 6, ln = idx & 63, e = ln & 31, kb = 16 * ks + 8 * (ln >> 5);
        float v[8]; unsigned h[8], l[8];
#pragma unroll
        for (int j = 0; j < 8; ++j) { v[j] = F.in[13][kb + j] * F.in[14][(size_t)(kb + j) * NE + e]; h[j] = f2bf(v[j]); l[j] = f2bf(v[j] - __uint_as_float(h[j] << 16)); }
        v4u oh, ol; oh.x = h[0] | (h[1] << 16); oh.y = h[2] | (h[3] << 16); oh.z = h[4] | (h[5] << 16); oh.w = h[6] | (h[7] << 16);
        ol.x = l[0] | (l[1] << 16); ol.y = l[2] | (l[3] << 16); ol.z = l[4] | (l[5] << 16); ol.w = l[6] | (l[7] << 16);
        rwf[idx] = oh; rwf[4096 + idx] = ol; }
}

__device__ __forceinline__ Fp8Item moe_item(const float* w1, const float* w2, unsigned char* W1, unsigned char* W2, const float* g, int r) {
    constexpr int I_1 = (D / 128) * (2 * FF / 32), I_2 = (FF / 128) * (D / 32);
    if (r < NE * I_1) { const int e = r / I_1; return fp8_item_make(w1 + (size_t)e * D * 2 * FF, D, 2 * FF, W1 + (size_t)e * 2 * FF * D, g, r % I_1); }
    const int r2 = r - NE * I_1, e = r2 / I_2; return fp8_item_make(w2 + (size_t)e * FF * D, FF, D, W2 + (size_t)e * D * FF, nullptr, r2 % I_2);
}
__device__ __forceinline__ void moe_weight_convert(Frame& F, int gw, int NGW, LAS unsigned* scr) {
    constexpr int NIT = NE * ((D / 128) * (2 * FF / 32) + (FF / 128) * (D / 32));
    const float* w1 = F.in[16]; const float* w2 = F.in[18]; unsigned char* W1 = F.ws + WS_W1; unsigned char* W2 = F.ws + WS_W2; const float* g = F.in[13];
    int ra = gw, rb = gw + NGW;
    if (ra >= NIT) return;
    Fp8Item a = moe_item(w1, w2, W1, W2, g, ra), b = moe_item(w1, w2, W1, W2, g, rb < NIT ? rb : NIT - 1);
    f32x4 va[4][4], vb[4][4], ka[4], kb[4];
    fp8_item_load(a, va, ka, F.lane); fp8_item_load(b, vb, kb, F.lane);
#pragma unroll 1
    for (;;) {
        fp8_item_finish(a, va, ka, SW, scr, F.lane);
        ra += 2 * NGW; const bool more_a = ra < NIT;
        a = moe_item(w1, w2, W1, W2, g, more_a ? ra : NIT - 1); fp8_item_load(a, va, ka, F.lane);
        if (rb < NIT) fp8_item_finish(b, vb, kb, SW, scr, F.lane);
        rb += 2 * NGW; const bool more_b = rb < NIT;
        b = moe_item(w1, w2, W1, W2, g, more_b ? rb : NIT - 1); fp8_item_load(b, vb, kb, F.lane);
        if (!more_a) break;
    }
    asm volatile("s_waitcnt vmcnt(0)" ::: "memory");
}
struct EpiProj {
    static constexpr bool MID = false;
    unsigned char* ws; const float* bias; const unsigned* rope; int noepi;
    __device__ __forceinline__ void operator()(const pg8::f32x4 (&acc)[2][2][4][2], const pg8::Unit& u, int, int wr, int wc, int fr, int fq) const {
        using namespace pg8;
        if (noepi) { asm volatile("s_waitcnt vmcnt(0)" ::: "memory"); return; }
        const int hb0 = 2 * u.pn, m0 = proj_mode(hb0), m1 = proj_mode(hb0 + 1);
        const int dlo = 4 * (4 * (wc & 1) + fq);
        u32x4 cs[2][4];
        if (m0 <= 1 || m1 <= 1) {
#pragma unroll
            for (int ai = 0; ai < 2; ++ai)
#pragma unroll
                for (int m = 0; m < 4; ++m) { const int s = (u.pm * BM + ai * HALF + wr * 64 + m * 16 + fr) & (SEQ - 1);
                    cs[ai][m] = *(const u32x4*)(rope + (size_t)(s * 32 + dlo)); }
        }
        f32x4 bv[2][2];
#pragma unroll
        for (int bj = 0; bj < 2; ++bj) { const int hb = hb0 + bj, mode = bj ? m1 : m0; const float* bp = bias + 128 * hb + (mode <= 1 ? 64 * (wc >> 1) + dlo : wc * 32 + 8 * fq);
            bv[bj][0] = *(const f32x4*)bp; bv[bj][1] = *(const f32x4*)(bp + (mode <= 1 ? 32 : 4)); }
#pragma unroll
        for (int bj = 0; bj < 2; ++bj) {
            const int hb = hb0 + bj, mode = bj ? m1 : m0; size_t off; int ldc, col0; proj_dst(hb, off, ldc, col0);
            bf16_t* dst = (bf16_t*)(ws + off);
            if (mode <= 1) {
                const int hcol = col0 + 64 * (wc >> 1);
                const float sc = mode == 0 ? QSCALE : 1.f;
#pragma unroll
                for (int ai = 0; ai < 2; ++ai)
#pragma unroll
                    for (int m = 0; m < 4; ++m) { const int row = u.pm * BM + ai * HALF + wr * 64 + m * 16 + fr;
                        const u32x4 cw = cs[ai][m];
                        const f32x4 x1 = acc[ai][bj][m][0] + bv[bj][0], x2 = acc[ai][bj][m][1] + bv[bj][1];
                        const f32x4 c = {bf_lo(cw.x), bf_lo(cw.y), bf_lo(cw.z), bf_lo(cw.w)}, sn = {bf_hi(cw.x), bf_hi(cw.y), bf_hi(cw.z), bf_hi(cw.w)};
                        const f32x4 o1 = (x1 * c - x2 * sn) * sc, o2 = (x2 * c + x1 * sn) * sc;
                        bf16_t* rp = dst + (size_t)row * ldc + hcol + dlo;
                        u32x2 w1, w2; w1.x = cvt_pk_bf16(o1[0], o1[1]); w1.y = cvt_pk_bf16(o1[2], o1[3]); w2.x = cvt_pk_bf16(o2[0], o2[1]); w2.y = cvt_pk_bf16(o2[2], o2[3]);
                        *(u32x2*)rp = w1; *(u32x2*)(rp + 32) = w2; }
            } else {
                const int c8 = wc * 32 + 8 * fq;
#pragma unroll
                for (int ai = 0; ai < 2; ++ai)
#pragma unroll
                    for (int m = 0; m < 4; ++m) { const int row = u.pm * BM + ai * HALF + wr * 64 + m * 16 + fr;
                        f32x4 v0 = acc[ai][bj][m][0] + bv[bj][0], v1 = acc[ai][bj][m][1] + bv[bj][1];
                        if (mode == 3) {
                            unsigned w0 = 0u, w1 = 0u;
#pragma unroll
                            for (int j = 0; j < 4; ++j) { w0 |= (unsigned)(int)(sigm(v0[j]) * 255.f + 0.5f) << (8 * j); w1 |= (unsigned)(int)(sigm(v1[j]) * 255.f + 0.5f) << (8 * j); }
                            u32x2 w; w.x = w0; w.y = w1; *(u32x2*)((unsigned char*)dst + (size_t)row * ldc + col0 + c8) = w;
                        } else {
                        u32x4 w; w.x = cvt_pk_bf16(v0[0], v0[1]); w.y = cvt_pk_bf16(v0[2], v0[3]); w.z = cvt_pk_bf16(v1[0], v1[1]); w.w = cvt_pk_bf16(v1[2], v1[3]);
                        *(u32x4*)(dst + (size_t)row * ldc + col0 + c8) = w; } }
            }
        }
    }
};
struct EpiGateFused {
    static constexpr bool MID = true;
    pg8::bf16_t* T; const unsigned char* sga; const unsigned char* sgb;
    __device__ __forceinline__ void mid(pg8::f32x4 (&acc)[2][2][4][2], const pg8::Unit& u, int wr, int wc, int fr, int fq) const {
        using namespace pg8;
        u32x2 ga[2][4][2], gb[2][4][2];
#pragma unroll
        for (int ai = 0; ai < 2; ++ai)
#pragma unroll
            for (int m = 0; m < 4; ++m)
#pragma unroll
                for (int bj = 0; bj < 2; ++bj) { const size_t o = (size_t)(u.pm * BM + ai * HALF + wr * 64 + m * 16 + fr) * D + u.pn * BM + wc * 32 + 8 * fq + bj * HALF;
                    ga[ai][m][bj] = *(const u32x2*)(sga + o); gb[ai][m][bj] = *(const u32x2*)(sgb + o); }
#pragma unroll
        for (int ai = 0; ai < 2; ++ai)
#pragma unroll
            for (int m = 0; m < 4; ++m)
#pragma unroll
                for (int bj = 0; bj < 2; ++bj)
#pragma unroll
                    for (int n = 0; n < 2; ++n) { const unsigned a = n ? ga[ai][m][bj].y : ga[ai][m][bj].x, b = n ? gb[ai][m][bj].y : gb[ai][m][bj].x; f32x4 r;
#pragma unroll
                        for (int j = 0; j < 4; ++j) { const unsigned bb = (b >> (8 * j)) & 0xffu; r[j] = (float)((a >> (8 * j)) & 0xffu) * __builtin_amdgcn_rcpf((float)(bb ? bb : 1u)); }
                        acc[ai][bj][m][n] = acc[ai][bj][m][n] * r; }
    }
    __device__ __forceinline__ void operator()(const pg8::f32x4 (&acc)[2][2][4][2], const pg8::Unit& u, int, int wr, int wc, int fr, int fq) const {
        using namespace pg8;
        u32x2 gb[2][4][2];
#pragma unroll
        for (int ai = 0; ai < 2; ++ai)
#pragma unroll
            for (int m = 0; m < 4; ++m)
#pragma unroll
                for (int bj = 0; bj < 2; ++bj) gb[ai][m][bj] = *(const u32x2*)(sgb + (size_t)(u.pm * BM + ai * HALF + wr * 64 + m * 16 + fr) * D + u.pn * BM + wc * 32 + 8 * fq + bj * HALF);
#pragma unroll
        for (int ai = 0; ai < 2; ++ai)
#pragma unroll
            for (int m = 0; m < 4; ++m)
#pragma unroll
                for (int bj = 0; bj < 2; ++bj) { const size_t o = (size_t)(u.pm * BM + ai * HALF + wr * 64 + m * 16 + fr) * D + u.pn * BM + wc * 32 + 8 * fq + bj * HALF;
                    const u32x2 g2 = gb[ai][m][bj]; const f32x4 a0 = acc[ai][bj][m][0] * (1.f / 255.f), a1 = acc[ai][bj][m][1] * (1.f / 255.f);
                    float g[8];
#pragma unroll
                    for (int j = 0; j < 4; ++j) { const unsigned b0 = (g2.x >> (8 * j)) & 0xffu, b1 = (g2.y >> (8 * j)) & 0xffu; g[j] = (float)(b0 ? b0 : 1u); g[4 + j] = (float)(b1 ? b1 : 1u); }
                    u32x4 w; w.x = cvt_pk_bf16(a0[0] * g[0], a0[1] * g[1]); w.y = cvt_pk_bf16(a0[2] * g[2], a0[3] * g[3]); w.z = cvt_pk_bf16(a1[0] * g[4], a1[1] * g[5]); w.w = cvt_pk_bf16(a1[2] * g[6], a1[3] * g[7]);
                    *(u32x4*)(T + o) = w; }
    }
};
__device__ __forceinline__ unsigned pk4_fp8(float a, float b, float c, float d) { int w = 0; w = __builtin_amdgcn_cvt_pk_fp8_f32(a, b, w, false); w = __builtin_amdgcn_cvt_pk_fp8_f32(c, d, w, true); return (unsigned)w; }
__device__ __forceinline__ float clamp8(float v) { return __builtin_amdgcn_fmed3f(v, -448.f, 448.f); }
struct EpiX1 {
    static constexpr bool MID = false;
    const pg8::bf16_t* xn; const float* invr; const float* g0; pg8::bf16_t* x1; unsigned char* x1q;
    __device__ __forceinline__ void operator()(const pg8::f32x4 (&acc)[2][2][4][2], const pg8::Unit& u, int, int wr, int wc, int fr, int fq) const {
        using namespace pg8;
        f32x4 gi[2][2];
#pragma unroll
        for (int bj = 0; bj < 2; ++bj) { const float* gp = g0 + u.pn * BM + wc * 32 + 8 * fq + bj * HALF; gi[bj][0] = *(const f32x4*)gp; gi[bj][1] = *(const f32x4*)(gp + 4); }
#pragma unroll
        for (int ai = 0; ai < 2; ++ai) {
            u32x4 xv[4][2]; float ir[4];
#pragma unroll
            for (int m = 0; m < 4; ++m) { const int row = u.pm * BM + ai * HALF + wr * 64 + m * 16 + fr; ir[m] = invr[row];
#pragma unroll
                for (int bj = 0; bj < 2; ++bj) xv[m][bj] = *(const u32x4*)(xn + (size_t)row * D + u.pn * BM + wc * 32 + 8 * fq + bj * HALF); }
            if (ai == 0) {
#pragma unroll
                for (int bj = 0; bj < 2; ++bj)
#pragma unroll
                    for (int q = 0; q < 2; ++q)
#pragma unroll
                        for (int j = 0; j < 4; ++j) gi[bj][q][j] = __builtin_amdgcn_rcpf(gi[bj][q][j]); }
#pragma unroll
            for (int m = 0; m < 4; ++m)
#pragma unroll
                for (int bj = 0; bj < 2; ++bj) { const size_t o = (size_t)(u.pm * BM + ai * HALF + wr * 64 + m * 16 + fr) * D + u.pn * BM + wc * 32 + 8 * fq + bj * HALF;
                    const u32x4 xw = xv[m][bj]; const float r_ = ir[m];
                    const f32x4 x0 = (f32x4){bf_lo(xw.x), bf_hi(xw.x), bf_lo(xw.y), bf_hi(xw.y)} * gi[bj][0] * r_, x1v = (f32x4){bf_lo(xw.z), bf_hi(xw.z), bf_lo(xw.w), bf_hi(xw.w)} * gi[bj][1] * r_;
                    const f32x4 v0 = x0 + acc[ai][bj][m][0], v1 = x1v + acc[ai][bj][m][1];
                    u32x4 wb; wb.x = cvt_pk_bf16(v0[0], v0[1]); wb.y = cvt_pk_bf16(v0[2], v0[3]); wb.z = cvt_pk_bf16(v1[0], v1[1]); wb.w = cvt_pk_bf16(v1[2], v1[3]);
                    *(u32x4*)(x1 + o) = wb;
                    u32x2 w; w.x = pk4_fp8(clamp8(v0[0] * SX), clamp8(v0[1] * SX), clamp8(v0[2] * SX), clamp8(v0[3] * SX)); w.y = pk4_fp8(clamp8(v1[0] * SX), clamp8(v1[1] * SX), clamp8(v1[2] * SX), clamp8(v1[3] * SX));
                    *(u32x2*)(x1q + o) = w; }
        }
    }
};
template <int NCT, bool GATHER> struct GroupSched {
    const LAS int* sch; const LAS unsigned short* gtab; int G, c;
    __device__ __forceinline__ bool next(int i, pg8::Unit& u) const {
        const int L = i * G + c; if (L >= sch[32] * NCT) return false;
        int e = 0;
#pragma unroll 1
        for (int j = 16; j >= 1; j >>= 1) if (sch[e + j] * NCT <= L) e += j;
        const int local = L - sch[e] * NCT; u.e = e; u.pm = local / NCT; u.pn = local % NCT; u.cnt = sch[64 + e]; return true;
    }
    __device__ __forceinline__ int arow(int ui, const pg8::Unit& u, int r) const { if (GATHER) return (int)gtab[ui * 256 + r]; return (sch[u.e] + u.pm) * 256 + r; }
    __device__ __forceinline__ size_t boff(const pg8::Unit& u, int RB) const {
        if (GATHER) return ((size_t)u.e * 2 * FF + (size_t)u.pn * 128) * RB;
        return ((size_t)u.e * D + (size_t)u.pn * 256) * RB; }
    __device__ __forceinline__ int fetch(int) const { return 0; }
    __device__ __forceinline__ void post(int, int) const {}
};
struct EpiMoe1 {
    static constexpr bool MID = false;
    unsigned char* H; const float* b1; const float* ers; const LAS int* sch; int noepi;
    __device__ __forceinline__ void operator()(const pg8::f32x4 (&acc)[2][2][4][2], const pg8::Unit& u, int, int wr, int wc, int fr, int fq) const {
        using namespace pg8;
        if (noepi) { asm volatile("s_waitcnt vmcnt(0)" ::: "memory"); return; }
        const int j0 = u.pn * 128 + wc * 32 + 8 * fq; const float* bb = b1 + (size_t)u.e * 2 * FF + j0;
        const f32x4 bg0 = *(const f32x4*)bb, bg1 = *(const f32x4*)(bb + 4), bu0 = *(const f32x4*)(bb + FF), bu1 = *(const f32x4*)(bb + FF + 4);
        const int hrow0 = (sch[u.e] + u.pm) * 256;
        float rsv[2][4];
#pragma unroll
        for (int ai = 0; ai < 2; ++ai)
#pragma unroll
            for (int m = 0; m < 4; ++m) { const int slot = u.pm * 256 + ai * HALF + wr * 64 + m * 16 + fr; rsv[ai][m] = ers[(size_t)u.e * M + (slot < u.cnt ? slot : u.cnt - 1)]; }
#pragma unroll
        for (int ai = 0; ai < 2; ++ai)
#pragma unroll
            for (int m = 0; m < 4; ++m) { const int rl = ai * HALF + wr * 64 + m * 16 + fr, slot = u.pm * 256 + rl;
                const float rs = rsv[ai][m] * (1.f / (SX * SW));
                const f32x4 g0 = acc[ai][0][m][0] * rs + bg0, g1 = acc[ai][0][m][1] * rs + bg1, u0 = acc[ai][1][m][0] * rs + bu0, u1 = acc[ai][1][m][1] * rs + bu1;
                f32x4 gg[2] = {g0, g1}, uu[2] = {u0, u1}, rr[2];
#pragma unroll
                for (int q = 0; q < 2; ++q) { f32x4 g = gg[q], t;
#pragma unroll
                    for (int j = 0; j < 4; ++j) { g[j] = fminf(g[j], 7.f); uu[q][j] = __builtin_amdgcn_fmed3f(uu[q][j], -7.f, 7.f); }
                    t = g * (-1.702f * LOG2E);
#pragma unroll
                    for (int j = 0; j < 4; ++j) t[j] = __builtin_amdgcn_exp2f(t[j]);
                    t = t + 1.f;
#pragma unroll
                    for (int j = 0; j < 4; ++j) t[j] = __builtin_amdgcn_rcpf(t[j]);
                    rr[q] = (g * t) * (uu[q] * SH + SH); }
                u32x2 w; w.x = pk4_fp8(rr[0][0], rr[0][1], rr[0][2], rr[0][3]); w.y = pk4_fp8(rr[1][0], rr[1][1], rr[1][2], rr[1][3]);
                *(u32x2*)(H + (size_t)(hrow0 + rl) * FF + j0) = w; }
    }
};
struct EpiMoe2 {
    static constexpr bool MID = false;
    unsigned char* Y; const float* b2; const int* etok; const float* ew; int noepi;
    __device__ __forceinline__ void operator()(const pg8::f32x4 (&acc)[2][2][4][2], const pg8::Unit& u, int, int wr, int wc, int fr, int fq) const {
        using namespace pg8;
        if (noepi) { asm volatile("s_waitcnt vmcnt(0)" ::: "memory"); return; }
        const int c0 = u.pn * 256 + wc * 32 + 8 * fq; const float* bb = b2 + (size_t)u.e * D + c0;
        f32x4 bv[2][2];
#pragma unroll
        for (int bj = 0; bj < 2; ++bj) { bv[bj][0] = *(const f32x4*)(bb + bj * HALF); bv[bj][1] = *(const f32x4*)(bb + bj * HALF + 4); }
        int tkv[2][4]; float wv[2][4];
#pragma unroll
        for (int ai = 0; ai < 2; ++ai)
#pragma unroll
            for (int m = 0; m < 4; ++m) { const int slot = u.pm * 256 + ai * HALF + wr * 64 + m * 16 + fr; const size_t o = (size_t)u.e * M + (slot < u.cnt ? slot : u.cnt - 1);
                const int t_ = etok[o]; tkv[ai][m] = slot < u.cnt ? t_ : M * 4; wv[ai][m] = ew[o]; }
#pragma unroll
        for (int ai = 0; ai < 2; ++ai)
#pragma unroll
            for (int m = 0; m < 4; ++m) { const int slot = u.pm * 256 + ai * HALF + wr * 64 + m * 16 + fr;
                const int tk = tkv[ai][m]; const float w8 = wv[ai][m]; (void)slot;
                {
#pragma unroll
                    for (int bj = 0; bj < 2; ++bj) { const f32x4 v0 = (acc[ai][bj][m][0] * (1.f / (SH * SW)) + bv[bj][0]) * (w8 * SY), v1 = (acc[ai][bj][m][1] * (1.f / (SH * SW)) + bv[bj][1]) * (w8 * SY);
                        u32x2 w; w.x = pk4_fp8(clamp8(v0[0]), clamp8(v0[1]), clamp8(v0[2]), clamp8(v0[3])); w.y = pk4_fp8(clamp8(v1[0]), clamp8(v1[1]), clamp8(v1[2]), clamp8(v1[3]));
                        *(u32x2*)(Y + (size_t)tk * D + c0 + bj * HALF) = w; } } }
    }
};

__device__ __forceinline__ void attn_phase_all(Frame& F, char* lds) {
    typedef attn_body::bf16 abf; using attn_body::attn_unit; using attn_body::attn_unit128;
    const int v = F.vcu;
    const abf* QA = (const abf*)(F.ws + WS_QA); const abf* KA = (const abf*)(F.ws + WS_KA); const abf* VA = (const abf*)(F.ws + WS_VA); abf* OS = (abf*)(F.ws + WS_OSWA);
    const abf* QB_ = (const abf*)(F.ws + WS_QB); const abf* KB = (const abf*)(F.ws + WS_KB); const abf* VB = (const abf*)(F.ws + WS_VB); abf* OD = (abf*)(F.ws + WS_OSWA) + 512;
    float lam; { const float p1 = F.in[5][F.lane] * F.in[6][F.lane], p2 = F.in[7][F.lane] * F.in[8][F.lane]; lam = __expf(wave_sum(p1)) - __expf(wave_sum(p2)) + 0.2f; }
    { const int vv = v;
        { const int bh = vv >> 3, h = bh & 3, b = bh >> 2, s = vv & 7;
#pragma unroll 1
          for (int i = 0; i < 4; ++i) { const int qb = (i >> 1) ? 15 - s : s, c = i & 1;
              attn_unit128<8>((long)b * SEQ, qb * 256, QB_ + (2 * h + c) * 64, KB + (2 * h + c) * 64, VB + h * 128, OD + h * 128, c != 0, lam, F.in[9], lds); } }
        {
#pragma unroll 1
          for (int i = 0; i < 4; ++i) { const int un = 4 * vv + i, qb = un & 31, pj = (un >> 5) & 3, b = un >> 7, hq = 2 * pj;
              attn_unit<1, 128, 128, 8>((long)b * SEQ, qb * 128, QA + hq * 64, KA + (hq >> 2) * 64, VA + (hq >> 2) * 64, OS + hq * 64, F.in[4][hq] * LOG2E, F.in[4][hq + 1] * LOG2E, lds); } }
    }
}

struct Args { const float* in[21]; float* out; unsigned char* ws; int ph_lo, ph_hi, noepi, pad; };
constexpr int N_PHASES = 10;
__global__ void __launch_bounds__(NWAVES * 64, 2) mk_fwd(Args args) {
    extern __shared__ __attribute__((aligned(16))) unsigned char lds[];
    Frame F;
    F.lds = (LAS unsigned char*)lds;
    F.MISC = (volatile LAS unsigned*)(F.lds + MISC_OFF);
    F.tid = threadIdx.x; F.lane = F.tid & 63; F.wave = __builtin_amdgcn_readfirstlane(F.tid >> 6);
    F.G = gridDim.x; { const int bx = blockIdx.x; F.vcu = (F.G % 8 == 0) ? (bx % 8) * (F.G / 8) + bx / 8 : bx; }
    F.ws = args.ws; F.ctl = (gu32*)(args.ws + WS_CTL); F.out = args.out;
#pragma unroll
    for (int i = 0; i < 21; ++i) F.in[i] = args.in[i];
    for (int u = F.tid; u < (LDS_BYTES - LDSCTL_OFF) / 4; u += NWAVES * 64) ((LAS unsigned*)(F.lds + LDSCTL_OFF))[u] = 0u;
    __syncthreads();
    const bool one = (args.ph_hi - args.ph_lo) > 1;
    XcdBarrier bar; bar.bar = (unsigned*)(F.ctl + CW_BAR); bar.x = 0; bar.st = nullptr;
    if (one) bar = xcd_barrier_post((unsigned*)(F.ctl + CW_BAR), F.MISC + 8);
    const int lo = args.ph_lo, hi = args.ph_hi;
#define IN(k) (lo <= (k) && (k) < hi)
#define SEAM(k) do { if (IN(k) && IN((k) + 1)) xcd_barrier(bar); } while (0)
    unsigned char* ws = F.ws;
    const LAS int* sch = (const LAS int*)(F.lds + SCHED_OFF);

    if (IN(0)) { p0_prologue(F); }
    SEAM(0);
    if (IN(1)) {
        pg8::Gemm g{ws + WS_XN, ws + WS_WIN, D * 2, (size_t)pg8::HALF * D * 2};
        if ((int)blockIdx.x < NCONV) { moe_weight_convert(F, (int)blockIdx.x * NWAVES + F.wave, NCONV * NWAVES, (LAS unsigned*)(F.lds + RING_OFF + F.wave * 16384)); __syncthreads(); }
        pg8::QueueOrder S; S.init(M, INW, (unsigned*)(F.ctl + CW_Q1), (volatile LAS int*)(F.MISC + 16), (int)(blockIdx.x & 7)); S.prime();
        EpiProj E{ws, F.in[3], (const unsigned*)(ws + WS_ROPE), args.noepi};
        pg8::gemm_phase<false>(F.lds + RING_OFF, g, S, E);
    }
    SEAM(1);
    if (IN(2)) { attn_phase_all(F, (char*)lds + RING_OFF); }
    SEAM(2);
    if (IN(4)) {
        pg8::StaticOrder S; S.init(M, D, F.G, (int)blockIdx.x);
        pg8::Gemm g{ws + WS_OSWA, ws + WS_WA, D * 2, (size_t)pg8::HALF * D * 2};
        EpiGateFused E{(pg8::bf16_t*)(ws + WS_T), ws + WS_SGA, ws + WS_SGB};
        pg8::gemm_phase<false>(F.lds + RING_OFF, g, S, E);
    }
    SEAM(4);
    if (IN(5)) {
        pg8::Gemm g{ws + WS_T, ws + WS_WO, D * 2, (size_t)pg8::HALF * D * 2};
        pg8::StaticOrder S; S.init(M, D, F.G, (int)blockIdx.x);
        EpiX1 E{(const pg8::bf16_t*)(ws + WS_XN), (const float*)(ws + WS_RS0), F.in[1], (pg8::bf16_t*)(ws + WS_X1B), ws + WS_X1Q};
        pg8::gemm_phase<false>(F.lds + RING_OFF, g, S, E);
    }
    SEAM(5);
    if (IN(6)) {
        typedef float f32x16 __attribute__((ext_vector_type(16)));
        const int lane = F.lane, r32 = lane & 31, hi = lane >> 5;
        LAS int* wcnt = (LAS int*)(F.lds + RING_OFF);
        const int n_it = (M / 32) / (F.G * 4);
        for (int it = 0; it < n_it; ++it) {
            const int tile = (it * F.G + F.vcu) * 4 + (F.wave & 3), tok = tile * 32 + r32;
            int ti[4] = {0, 0, 0, 0}; float ex[4] = {0.f, 0.f, 0.f, 0.f}; float isum = 0.f, rstd = 0.f; int run0 = 0, run1 = 0, run2 = 0, run3 = 0;
            if (F.wave < 4) {
                const v4u* rwf = (const v4u*)(ws + WS_RWF);
                const pg8::bf16_t* xr = (const pg8::bf16_t*)(ws + WS_X1B) + (size_t)tok * D + 8 * hi;
                f32x16 acc = {}; float ss = 0.f;
#pragma unroll 8
                for (int ks = 0; ks < 64; ++ks) {
                    const v4u bh = *(const v4u*)(xr + 16 * ks);
                    ss += pg8::bf_lo(bh.x) * pg8::bf_lo(bh.x) + pg8::bf_hi(bh.x) * pg8::bf_hi(bh.x) + pg8::bf_lo(bh.y) * pg8::bf_lo(bh.y) + pg8::bf_hi(bh.y) * pg8::bf_hi(bh.y)
                        + pg8::bf_lo(bh.z) * pg8::bf_lo(bh.z) + pg8::bf_hi(bh.z) * pg8::bf_hi(bh.z) + pg8::bf_lo(bh.w) * pg8::bf_lo(bh.w) + pg8::bf_hi(bh.w) * pg8::bf_hi(bh.w);
                    const v4u ah = rwf[ks * 64 + lane], al = rwf[4096 + ks * 64 + lane];
                    acc = __builtin_amdgcn_mfma_f32_32x32x16_bf16(__builtin_bit_cast(bf16x8, ah), __builtin_bit_cast(bf16x8, bh), acc, 0, 0, 0);
                    acc = __builtin_amdgcn_mfma_f32_32x32x16_bf16(__builtin_bit_cast(bf16x8, al), __builtin_bit_cast(bf16x8, bh), acc, 0, 0, 0);
                }
                ss += __shfl_xor(ss, 32);
                rstd = 1.f / sqrtf(ss * (1.f / D) + RMS_EPS);
                float lg[32];
#pragma unroll
                for (int e = 0; e < 32; ++e) { const int he = (e >> 2) & 1, r = (e & 3) + 4 * (e >> 3); const float own = acc[r], oth = __shfl_xor(own, 32);
                    lg[e] = ((he == hi) ? own : oth) * rstd + F.in[15][e]; }
                float tv[4];
#pragma unroll
                for (int k = 0; k < 4; ++k) { float best = -3.0e38f; int bi = 0;
#pragma unroll
                    for (int e = 0; e < 32; ++e) { if (lg[e] > best) { best = lg[e]; bi = e; } }
                    tv[k] = best; ti[k] = bi;
#pragma unroll
                    for (int e = 0; e < 32; ++e) if (e == bi) lg[e] = -3.0e38f; }
                float sum = 0.f;
#pragma unroll
                for (int k = 0; k < 4; ++k) { ex[k] = __builtin_amdgcn_exp2f((tv[k] - tv[0]) * LOG2E); sum += ex[k]; }
                isum = 1.f / sum;
                const unsigned long long lt = (1ull << lane) - 1ull;
                int myc = 0;
#pragma unroll 1
                for (int e = 0; e < 32; ++e) {
                    const unsigned long long m0 = __ballot(hi == 0 && ti[0] == e), m1 = __ballot(hi == 0 && ti[1] == e), m2 = __ballot(hi == 0 && ti[2] == e), m3 = __ballot(hi == 0 && ti[3] == e);
                    const int c0 = __popcll(m0), c1 = __popcll(m1), c2 = __popcll(m2), c3 = __popcll(m3);
                    if (lane == e) myc = c0 + c1 + c2 + c3;
                    if (ti[0] == e) run0 = __popcll(m0 & lt);
                    if (ti[1] == e) run1 = c0 + __popcll(m1 & lt);
                    if (ti[2] == e) run2 = c0 + c1 + __popcll(m2 & lt);
                    if (ti[3] == e) run3 = c0 + c1 + c2 + __popcll(m3 & lt);
                }
                if (lane < 32) wcnt[F.wave * 32 + lane] = myc;
            }
            __syncthreads();
            if (F.wave == 0 && lane < 32) {
                const int c0 = wcnt[lane], c1 = wcnt[32 + lane], c2 = wcnt[64 + lane], c3 = wcnt[96 + lane], tot = c0 + c1 + c2 + c3;
                int base = 0; if (tot > 0) base = (int)__hip_atomic_fetch_add((unsigned*)(F.ctl + CW_CNT + 64 * lane), (unsigned)tot, RLX_AGENT);
                wcnt[128 + lane] = base; wcnt[160 + lane] = base + c0; wcnt[192 + lane] = base + c0 + c1; wcnt[224 + lane] = base + c0 + c1 + c2;
            }
            __syncthreads();
            if (F.wave < 4 && hi == 0) {
                int* etok = (int*)(ws + WS_ETOK); float* ew = (float*)(ws + WS_EW); float* ers = (float*)(ws + WS_ERS);
                const int pos[4] = {wcnt[128 + F.wave * 32 + ti[0]] + run0, wcnt[128 + F.wave * 32 + ti[1]] + run1, wcnt[128 + F.wave * 32 + ti[2]] + run2, wcnt[128 + F.wave * 32 + ti[3]] + run3};
#pragma unroll
                for (int k = 0; k < 4; ++k) { const size_t o = (size_t)ti[k] * M + pos[k];
                    etok[o] = tok * 4 + k; ew[o] = ex[k] * isum; ers[o] = rstd; }
            }
            __syncthreads();
        }
    }
    SEAM(6);
    if (IN(7) || IN(8)) {
        if (F.tid < 32) { ((LAS int*)sch)[64 + F.tid] = (int)__hip_atomic_load((unsigned*)(F.ctl + CW_CNT + 64 * F.tid), RLX_AGENT); }
        __syncthreads();
        if (F.tid == 0) { int a = 0; for (int e = 0; e < 32; ++e) { ((LAS int*)sch)[e] = a; a += (sch[64 + e] + 255) >> 8; } ((LAS int*)sch)[32] = a; }
        __syncthreads();
    }
    if (IN(7)) {
        const LAS unsigned short* gtab = (const LAS unsigned short*)(F.lds + GTAB_OFF);
        GroupSched<8, true> S{sch, gtab, F.G, F.vcu};
        { const int* etok = (const int*)(ws + WS_ETOK);
          int idx[17];
#pragma unroll
          for (int i = 0; i < 17; ++i) { pg8::Unit u; idx[i] = 0;
              if (S.next(i, u) && F.tid < 256) { const int slot = u.pm * 256 + F.tid; if (slot < u.cnt) idx[i] = etok[(size_t)u.e * M + slot] >> 2; } }
          if (F.tid < 256) {
#pragma unroll
              for (int i = 0; i < 17; ++i) ((LAS unsigned short*)gtab)[i * 256 + F.tid] = (unsigned short)idx[i]; } }
        VM_WAIT(); __syncthreads();
        pg8::Gemm g{ws + WS_X1Q, ws + WS_W1, D, (size_t)FF * D};
        EpiMoe1 E{ws + WS_H, F.in[17], (const float*)(ws + WS_ERS), sch, args.noepi};
        pg8::gemm_phase<true>(F.lds + RING_OFF, g, S, E);
    }
    SEAM(7);
    if (IN(8)) {
        GroupSched<4, false> S{sch, nullptr, F.G, F.vcu};
        pg8::Gemm g{ws + WS_H, ws + WS_W2, FF, (size_t)pg8::HALF * FF};
        EpiMoe2 E{ws + WS_Y, F.in[19], (const int*)(ws + WS_ETOK), (const float*)(ws + WS_EW), args.noepi};
        pg8::gemm_phase<true>(F.lds + RING_OFF, g, S, E);
    }
    SEAM(8);
    if (IN(9)) {
        unsigned poison = (__hip_atomic_load(F.ctl + CW_TMO, RLX_AGENT) != 0u) | (__hip_atomic_load((gu32*)((const unsigned*)(F.ctl + CW_BAR) + XB_TMO), RLX_AGENT) != 0u);
        const unsigned char* Y = ws + WS_Y; typedef float f32x2_ __attribute__((ext_vector_type(2)));
        const int gw = F.vcu * NWAVES + F.wave, NGW = F.G * NWAVES;
        f32x4 gfin[2][2];
#pragma unroll
        for (int j = 0; j < 2; ++j) { gfin[j][0] = *(const f32x4*)(F.in[20] + 8 * F.lane + 512 * j); gfin[j][1] = *(const f32x4*)(F.in[20] + 8 * F.lane + 512 * j + 4); }
        for (int m0 = 2 * gw; m0 < M; m0 += 2 * NGW) {
            v4u xa[2][2]; pg8::u32x2 yv[2][2][4];
#pragma unroll
            for (int q = 0; q < 2; ++q)
#pragma unroll
                for (int j = 0; j < 2; ++j) { const size_t c0 = 8 * F.lane + 512 * j; xa[q][j] = __builtin_nontemporal_load((const v4u*)((const pg8::bf16_t*)(ws + WS_X1B) + (size_t)(m0 + q) * D + c0));
#pragma unroll
                    for (int k = 0; k < 4; ++k) yv[q][j][k] = __builtin_nontemporal_load((const pg8::u32x2*)(Y + ((size_t)(m0 + q) * 4 + k) * D + c0)); }
#pragma unroll
            for (int q = 0; q < 2; ++q) { const int m = m0 + q;
                float v[2][8]; float ss = 0.f;
#pragma unroll
                for (int j = 0; j < 2; ++j) { const v4u a = xa[q][j];
                    v[j][0] = pg8::bf_lo(a.x); v[j][1] = pg8::bf_hi(a.x); v[j][2] = pg8::bf_lo(a.y); v[j][3] = pg8::bf_hi(a.y); v[j][4] = pg8::bf_lo(a.z); v[j][5] = pg8::bf_hi(a.z); v[j][6] = pg8::bf_lo(a.w); v[j][7] = pg8::bf_hi(a.w);
#pragma unroll
                    for (int k = 0; k < 4; ++k) { const pg8::u32x2 y = yv[q][j][k]; const f32x2_ a0 = __builtin_amdgcn_cvt_pk_f32_fp8((int)y.x, false), a1 = __builtin_amdgcn_cvt_pk_f32_fp8((int)y.x, true), a2 = __builtin_amdgcn_cvt_pk_f32_fp8((int)y.y, false), a3 = __builtin_amdgcn_cvt_pk_f32_fp8((int)y.y, true);
                        v[j][0] += a0.x * (1.f / SY); v[j][1] += a0.y * (1.f / SY); v[j][2] += a1.x * (1.f / SY); v[j][3] += a1.y * (1.f / SY); v[j][4] += a2.x * (1.f / SY); v[j][5] += a2.y * (1.f / SY); v[j][6] += a3.x * (1.f / SY); v[j][7] += a3.y * (1.f / SY); }
#pragma unroll
                    for (int t = 0; t < 8; ++t) ss += v[j][t] * v[j][t]; }
                float rstd = 1.f / sqrtf(wave_sum(ss) * (1.f / D) + RMS_EPS);
                if (poison) rstd = __builtin_nanf("");
#pragma unroll
                for (int j = 0; j < 2; ++j) { const size_t c0 = 8 * F.lane + 512 * j; const f32x4 g0 = gfin[j][0], g1 = gfin[j][1];
                    *(f32x4*)(F.out + (size_t)m * D + c0) = (f32x4){v[j][0] * rstd * g0[0], v[j][1] * rstd * g0[1], v[j][2] * rstd * g0[2], v[j][3] * rstd * g0[3]};
                    *(f32x4*)(F.out + (size_t)m * D + c0 + 4) = (f32x4){v[j][4] * rstd * g1[0], v[j][5] * rstd * g1[1], v[j][6] * rstd * g1[2], v[j][7] * rstd * g1[3]}; } }
        }
    }
#undef IN
#undef SEAM
}

#ifndef MK_REP
#define MK_REP -1
#endif
#ifndef MK_NOEPI
#define MK_NOEPI 0
#endif
#ifndef MK_CUTS
#define MK_CUTS 1
#endif
extern "C" void kernel_launch(void* const* d_in, const int* in_sizes, int n_in, void* d_out, int out_size, void* d_ws, size_t ws_size, hipStream_t stream) {
    static int grid = 0;
    if (grid == 0) {
        if (n_in != 21 || in_sizes[0] != M * D || out_size != M * D || ws_size < WS_END) { fprintf(stderr, "kernel_launch: unexpected shapes / workspace (n_in %d, ws %zu)\n", n_in, ws_size); grid = -1; return; }
        int dev = 0, cus = 0, per_cu = 0;
        if (hipGetDevice(&dev) != hipSuccess || hipDeviceGetAttribute(&cus, hipDeviceAttributeMultiprocessorCount, dev) != hipSuccess) { grid = -1; return; }
        if (hipFuncSetAttribute((const void*)mk_fwd, hipFuncAttributeMaxDynamicSharedMemorySize, LDS_BYTES) != hipSuccess) { fprintf(stderr, "kernel_launch: hipFuncSetAttribute failed\n"); grid = -1; return; }
        if (hipOccupancyMaxActiveBlocksPerMultiprocessor(&per_cu, (const void*)mk_fwd, NWAVES * 64, LDS_BYTES) != hipSuccess || per_cu < 1) { fprintf(stderr, "kernel_launch: occupancy query says %d\n", per_cu); }
        (void)hipGetLastError();
        grid = cus;
    }
    if (grid < 0) return;
    if (hipMemsetAsync((char*)d_ws + WS_CTL, 0, CTL_ZERO_BYTES, stream) != hipSuccess) return;
    Args a{};
    for (int i = 0; i < 21; ++i) a.in[i] = (const float*)d_in[i];
    a.out = (float*)d_out; a.ws = (unsigned char*)d_ws;
    if (MK_CUTS == 1) { a.ph_lo = 0; a.ph_hi = N_PHASES; hipLaunchKernelGGL(mk_fwd, dim3(grid), dim3(NWAVES * 64), LDS_BYTES, stream, a); }
    else for (int p = 0; p < N_PHASES; ++p) { a.ph_lo = p; a.ph_hi = p + 1; hipLaunchKernelGGL(mk_fwd, dim3(grid), dim3(NWAVES * 64), LDS_BYTES, stream, a);
        if (p == MK_REP) { if (p == 6) (void)hipMemsetAsync((char*)d_ws + WS_CTL, 0, CTL_ZERO_BYTES, stream); a.noepi = MK_NOEPI; hipLaunchKernelGGL(mk_fwd, dim3(grid), dim3(NWAVES * 64), LDS_BYTES, stream, a); a.noepi = 0; } }
}
```

```cpp
#include <hip/hip_runtime.h>
#include <hip/hip_bf16.h>
#include <cstdio>
#include <cstdint>
#include <cmath>
namespace pg8 {
#define PG8_LAS __attribute__((address_space(3)))
typedef unsigned short bf16_t;
typedef short bf16x8 __attribute__((ext_vector_type(8)));
typedef float f32x4 __attribute__((ext_vector_type(4)));
typedef float f32x2 __attribute__((ext_vector_type(2)));
typedef unsigned u32x4 __attribute__((ext_vector_type(4)));
typedef unsigned u32x2 __attribute__((ext_vector_type(2)));
typedef int v8i __attribute__((ext_vector_type(8)));
typedef int v4i __attribute__((ext_vector_type(4)));
constexpr int BM = 256, BK = 64, HALF = 128, HTB = HALF * BK * 2  , STAGE_BYTES = 8 * HTB, NXCD = 8, WGM = 8;

__host__ __device__ __forceinline__ int lds_byte(int r, int c) { const int st = (r >> 4) * 2 + (c >> 5), rr = r & 15, cc = c & 31, ob = rr * 64 + cc * 2; return st * 1024 + (ob ^ (((ob >> 9) & 1) << 5)); }
__host__ __device__ __forceinline__ void stage_rc(int b, int& R, int& C) { const int st = b / 1024, sb = b % 1024, swz = sb ^ (((sb >> 9) & 1) << 5); R = (st >> 1) * 16 + swz / 64; C = (st & 1) * 32 + (swz % 64) / 2; }
__host__ __device__ __forceinline__ int perm32(int rho) { const int n = rho >> 4, i = rho & 15; return 8 * (i >> 2) + 4 * n + (i & 3); }

struct Unit { int pm, pn, e, cnt; };
struct Gemm { const void* A; const void* Bt; int RB; size_t hstepB; };

struct StaticOrder {
    int nM, nN, nwg, G, c;
    __device__ void init(int M, int N, int G_, int c_) { nM = M / BM; nN = N / BM; nwg = nM * nN; G = G_; c = c_; }
    __device__ bool next(int i, Unit& u) const {
        const long L = (long)i * G + c; if (L >= nwg) return false;
        int wgid = (int)L; { const int q = nwg / NXCD, r = nwg % NXCD, xcd = wgid % NXCD, off = wgid / NXCD; wgid = (xcd < r ? xcd * (q + 1) : r * (q + 1) + (xcd - r) * q) + off; }
        const int nig = WGM * nN, gid = wgid / nig, fm = gid * WGM, gsz = (nM - fm) < WGM ? (nM - fm) : WGM;
        u.pm = fm + ((wgid % nig) % gsz); u.pn = (wgid % nig) / gsz; u.e = 0; u.cnt = 0; return true;
    }
    __device__ __forceinline__ int arow(int, const Unit& u, int r) const { return u.pm * BM + r; }
    __device__ __forceinline__ size_t boff(const Unit& u, int RB) const { return (size_t)u.pn * BM * RB; }
    __device__ __forceinline__ int fetch(int) const { return 0; }
    __device__ __forceinline__ void post(int, int) const {}
};
struct QueueOrder {
    int nM, nN, nwg; unsigned* ctr; volatile PG8_LAS int* mail;
    __device__ void init(int M, int N, unsigned* ctr_, volatile PG8_LAS int* mail_, int x_) { nM = M / BM; nN = N / BM; nwg = nM * nN; ctr = ctr_ + 64 * x_; mail = mail_; }
    __device__ void prime() const {
        if (threadIdx.x == 0) { const int t0_ = (int)__hip_atomic_fetch_add(ctr, 3u, __ATOMIC_RELAXED, __HIP_MEMORY_SCOPE_AGENT);
            for (int k = 0; k < 3; ++k) mail[k] = (int)(blockIdx.x & 7) + NXCD * (t0_ + k); }
        __syncthreads();
    }
    __device__ bool next(int i, Unit& u) const {
        const int L = __builtin_amdgcn_readfirstlane(mail[i & 3]); if (L >= nwg) return false;
        int wgid = L; { const int q = nwg / NXCD, r = nwg % NXCD, xcd = wgid % NXCD, off = wgid / NXCD; wgid = (xcd < r ? xcd * (q + 1) : r * (q + 1) + (xcd - r) * q) + off; }
        const int nig = WGM * nN, gid = wgid / nig, fm = gid * WGM, gsz = (nM - fm) < WGM ? (nM - fm) : WGM;
        u.pm = fm + ((wgid % nig) % gsz); u.pn = (wgid % nig) / gsz; u.e = 0; u.cnt = 0; return true;
    }
    __device__ __forceinline__ int arow(int, const Unit& u, int r) const { return u.pm * BM + r; }
    __device__ __forceinline__ size_t boff(const Unit& u, int RB) const { return (size_t)u.pn * BM * RB; }
    __device__ __forceinline__ int fetch(int) const { int v = 0; if (threadIdx.x == 0) v = (int)(blockIdx.x & 7) + NXCD * (int)__hip_atomic_fetch_add(ctr, 1u, __ATOMIC_RELAXED, __HIP_MEMORY_SCOPE_AGENT); return v; }
    __device__ __forceinline__ void post(int ui, int v) const { if (threadIdx.x == 0) mail[(ui + 3) & 3] = v; }
};

__device__ __forceinline__ unsigned cvt_pk_bf16(float lo, float hi) { unsigned r; asm volatile("v_cvt_pk_bf16_f32 %0, %1, %2" : "=v"(r) : "v"(lo), "v"(hi)); return r; }
__device__ __forceinline__ float bf_lo(unsigned w) { return __uint_as_float(w << 16); }
__device__ __forceinline__ float bf_hi(unsigned w) { return __uint_as_float(w & 0xffff0000u); }
__device__ __forceinline__ float sigm(float x) { return __builtin_amdgcn_rcpf(1.f + __builtin_amdgcn_exp2f(-1.4426950408889634f * x)); }

template <bool FP8, class Epi, class Sched>
__device__ __forceinline__ void gemm_phase(PG8_LAS unsigned char* lds, const Gemm g, const Sched& S, const Epi& E) {
    int tid = threadIdx.x; asm volatile("" : "+v"(tid));
    const int wid = __builtin_amdgcn_readfirstlane(tid >> 6), lane = tid & 63, wr = wid >> 2, wc = wid & 3, fr = lane & 15, fq = lane >> 4;
    const int RB = g.RB, nt = RB / (BK * 2);
    unsigned voffB[2];
#pragma unroll
    for (int i = 0; i < 2; ++i) { int R, C; stage_rc(tid * 16 + i * 8192, R, C); const int Rb = (R & ~31) + perm32(R & 31); voffB[i] = (unsigned)(Rb * RB + C * 2); }
    const size_t kstep = (size_t)(BK * 2);
    const size_t hstepB = g.hstepB;
    const unsigned ldsw = (unsigned)wid * 1024u;
    const int aoff = lds_byte(wr * 64 + fr, fq * 8), boff = lds_byte(wc * 32 + fr, fq * 8);
    constexpr int POFF = 1024;
#define PG8_SA(b, h) (((b) * 2 + (h)) * HTB)
#define PG8_SB(b, h) ((4 + (b) * 2 + (h)) * HTB)
#define PG8_STAGE(bufoff, gbase, voff) do { const char* gb_ = (const char*)(gbase); asm volatile("" : "+s"(gb_));     \
        _Pragma("unroll") for (int _i = 0; _i < 2; ++_i) { unsigned vo_ = (voff)[_i]; asm volatile("" : "+v"(vo_)); \
        __builtin_amdgcn_global_load_lds((const unsigned*)(gb_ + vo_), (PG8_LAS unsigned*)(lds + (bufoff) + ldsw + _i * 8192), 16, 0, 0); } } while (0)
#define PG8_LDA(dst, b, h) do { _Pragma("unroll") for (int m = 0; m < 4; ++m) { const v4i lo_ = *(const PG8_LAS v4i*)(lds + PG8_SA(b, h) + aoff + m * 2048), hi_ = *(const PG8_LAS v4i*)(lds + PG8_SA(b, h) + aoff + m * 2048 + POFF); \
        dst[m] = __builtin_shufflevector(lo_, hi_, 0, 1, 2, 3, 4, 5, 6, 7); } } while (0)
#define PG8_LDB(dst, b, h) do { _Pragma("unroll") for (int n = 0; n < 2; ++n) { const v4i lo_ = *(const PG8_LAS v4i*)(lds + PG8_SB(b, h) + boff + n * 2048), hi_ = *(const PG8_LAS v4i*)(lds + PG8_SB(b, h) + boff + n * 2048 + POFF); \
        dst[n] = __builtin_shufflevector(lo_, hi_, 0, 1, 2, 3, 4, 5, 6, 7); } } while (0)
#define PG8_MMA(ai, bj, At, Bt) do { __builtin_amdgcn_s_setprio(1); _Pragma("unroll") for (int m = 0; m < 4; ++m) _Pragma("unroll") for (int n = 0; n < 2; ++n) { \
        if constexpr (FP8) asm volatile("v_mfma_f32_16x16x128_f8f6f4 %0, %1, %2, %0" : "+v"(acc[ai][bj][m][n]) : "v"(Bt[n]), "v"(At[m]));     \
        else { acc[ai][bj][m][n] = __builtin_amdgcn_mfma_f32_16x16x32_bf16(__builtin_bit_cast(bf16x8, __builtin_shufflevector(Bt[n], Bt[n], 0, 1, 2, 3)), __builtin_bit_cast(bf16x8, __builtin_shufflevector(At[m], At[m], 0, 1, 2, 3)), acc[ai][bj][m][n], 0, 0, 0); \
               acc[ai][bj][m][n] = __builtin_amdgcn_mfma_f32_16x16x32_bf16(__builtin_bit_cast(bf16x8, __builtin_shufflevector(Bt[n], Bt[n], 4, 5, 6, 7)), __builtin_bit_cast(bf16x8, __builtin_shufflevector(At[m], At[m], 4, 5, 6, 7)), acc[ai][bj][m][n], 0, 0, 0); } } \
        __builtin_amdgcn_s_setprio(0); } while (0)
#define PG8_WAIT_V(n) asm volatile("s_waitcnt vmcnt(" #n ")" ::: "memory")
#define PG8_WAIT_L(n) asm volatile("s_waitcnt lgkmcnt(" #n ")" ::: "memory")
#define PG8_BAR __builtin_amdgcn_s_barrier()
#define PG8_SCHED __builtin_amdgcn_sched_barrier(0)
#define PG8_OA(dst, ui_, u_) do { int t_ = threadIdx.x; asm volatile("" : "+v"(t_)); _Pragma("unroll") for (int _i = 0; _i < 2; ++_i) { int R_, C_; stage_rc(t_ * 16 + _i * 8192, R_, C_); \
        _Pragma("unroll") for (int _h = 0; _h < 2; ++_h) dst[_h][_i] = (unsigned)S.arow(ui_, u_, _h * HALF + R_) * (unsigned)RB + (unsigned)C_ * 2u; } } while (0)
    Unit cur, nxt; int ui = 0;
    if (!S.next(0, cur)) return;
    f32x4 acc[2][2][4][2];
#pragma unroll
    for (int a = 0; a < 2; ++a)
#pragma unroll
        for (int b = 0; b < 2; ++b)
#pragma unroll
            for (int m = 0; m < 4; ++m)
#pragma unroll
                for (int n = 0; n < 2; ++n) acc[a][b][m][n] = (f32x4){0.f, 0.f, 0.f, 0.f};
    v8i At[4], B0[2], B1[2];
    unsigned oaC[2][2];
    PG8_OA(oaC, 0, cur);
    const char* const gA = (const char*)g.A;
    const char* cB = (const char*)g.Bt + S.boff(cur, RB);
    PG8_STAGE(PG8_SB(0, 0), cB, voffB); PG8_STAGE(PG8_SB(0, 1), cB + hstepB, voffB); PG8_STAGE(PG8_SA(0, 0), gA, oaC[0]); PG8_STAGE(PG8_SA(0, 1), gA, oaC[1]);
    if (wr == 1) PG8_BAR;
    PG8_WAIT_V(2); PG8_BAR;
    PG8_STAGE(PG8_SB(1, 0), cB + kstep, voffB); PG8_STAGE(PG8_SA(1, 0), gA + kstep, oaC[0]); PG8_STAGE(PG8_SB(1, 1), cB + hstepB + kstep, voffB);
    PG8_WAIT_V(6); PG8_BAR;
    for (;;) {
        const bool has_next = S.next(ui + 1, nxt);
        const char* nB = has_next ? (const char*)g.Bt + S.boff(nxt, RB) : cB;
        for (int t = 0; t < nt; t += 2) {
            const bool last = (t == nt - 2);
            const bool first = (t == 0) && (ui > 0);
            if constexpr (Epi::MID) { if (t == nt / 2) { int fr_ = fr, fq_ = fq; asm volatile("" : "+v"(fr_), "+v"(fq_)); E.mid(acc, cur, wr, wc, fr_, fq_); } }
            const char* a1 = gA + (size_t)(t + 1) * kstep;
            const char* a2 = last ? gA : gA + (size_t)(t + 2) * kstep; const char* b2 = last ? nB : cB + (size_t)(t + 2) * kstep;
            const char* a3 = a2 + kstep; const char* b3 = b2 + kstep;
            unsigned o2[2][2];
#pragma unroll
            for (int h = 0; h < 2; ++h)
#pragma unroll
                for (int i = 0; i < 2; ++i) o2[h][i] = oaC[h][i];
            if (last && has_next) { PG8_OA(o2, ui + 1, nxt); }
            PG8_LDB(B0, 0, 0); PG8_LDB(B1, 0, 1); PG8_SCHED; PG8_LDA(At, 0, 0); if (!first) { PG8_STAGE(PG8_SA(1, 1), a1, oaC[1]); }
            if (!first) { PG8_WAIT_V(8); } PG8_WAIT_L(0); PG8_BAR; PG8_MMA(0, 0, At, B0); PG8_MMA(0, 1, At, B1); PG8_BAR; PG8_SCHED;
            PG8_LDA(At, 0, 1); PG8_STAGE(PG8_SB(0, 0), b2, voffB); PG8_STAGE(PG8_SB(0, 1), b2 + hstepB, voffB); PG8_STAGE(PG8_SA(0, 0), a2, o2[0]);
            if (!first) { PG8_WAIT_V(8); } PG8_WAIT_L(0); PG8_BAR; PG8_MMA(1, 0, At, B0); PG8_MMA(1, 1, At, B1); PG8_BAR; PG8_SCHED;
            PG8_LDB(B0, 1, 0); PG8_LDB(B1, 1, 1); PG8_SCHED; PG8_LDA(At, 1, 0); PG8_STAGE(PG8_SA(0, 1), a2, o2[1]);
            if (!first) { PG8_WAIT_V(8); } PG8_WAIT_L(0); PG8_BAR; PG8_MMA(0, 0, At, B0); PG8_MMA(0, 1, At, B1); PG8_BAR; PG8_SCHED;
            PG8_LDA(At, 1, 1); PG8_STAGE(PG8_SB(1, 0), b3, voffB); PG8_STAGE(PG8_SB(1, 1), b3 + hstepB, voffB); PG8_STAGE(PG8_SA(1, 0), a3, o2[0]);
            PG8_WAIT_V(8); PG8_WAIT_L(0); PG8_BAR; PG8_MMA(1, 0, At, B0); PG8_MMA(1, 1, At, B1); PG8_BAR; PG8_SCHED;
            if (last && has_next) { PG8_STAGE(PG8_SA(1, 1), a3, o2[1]); }
        }
        if (wr == 0) PG8_BAR;
        if constexpr (FP8) asm volatile("s_nop 15\n\ts_nop 15\n\ts_nop 15" ::: "memory");
        { int fr_ = fr, fq_ = fq; asm volatile("" : "+v"(fr_), "+v"(fq_));
          const int qv_ = S.fetch(ui); E(acc, cur, ui, wr, wc, fr_, fq_); S.post(ui, qv_); }
        if (!has_next) break;
#pragma unroll
        for (int a = 0; a < 2; ++a)
#pragma unroll
            for (int b = 0; b < 2; ++b)
#pragma unroll
                for (int m = 0; m < 4; ++m)
#pragma unroll
                    for (int n = 0; n < 2; ++n) acc[a][b][m][n] = (f32x4){0.f, 0.f, 0.f, 0.f};
        cur = nxt; cB = nB; ++ui;
        PG8_OA(oaC, ui, cur);
        if (wr == 1) PG8_BAR;
    }
    PG8_WAIT_V(0);
    PG8_BAR;
#undef PG8_SA
#undef PG8_SB
#undef PG8_STAGE
#undef PG8_LDA
#undef PG8_LDB
#undef PG8_MMA
#undef PG8_WAIT_V
#undef PG8_WAIT_L
#undef PG8_BAR
#undef PG8_SCHED
#undef PG8_OA
}
}
#include <hip/hip_bf16.h>
#include <cmath>
namespace attn_body {
using bf16=__hip_bfloat16;
using bf16x8=__attribute__((ext_vector_type(8)))short;
using s16x4=__attribute__((ext_vector_type(4)))short;
using f32x16=__attribute__((ext_vector_type(16)))float;
using u32x4=__attribute__((ext_vector_type(4)))unsigned;
constexpr int SEQ=4096,D=64,QP=512,OP=1024;
constexpr int NW=8,QBLK=32,QB=QBLK*NW,KVBLK=64,NQB=SEQ/QB;
constexpr int ATTN_UNIT_ROWS=QB;
__device__ __forceinline__ int crow(int r,int hi){return (r&3)+8*(r>>2)+4*hi;}
#define SBAR() __builtin_amdgcn_sched_barrier(0)
__device__ __forceinline__ void cmask(f32x16&p0,f32x16&p1,int jb,int qrel,int hi){
  const float NEG=-INFINITY; int kb=64*jb+4*hi;
  #pragma unroll
  for(int r=0;r<16;++r){int kv=kb+(r&3)+8*(r>>2); if(kv>qrel)p0[r]=NEG; if(kv+32>qrel)p1[r]=NEG;}
}

__device__ __forceinline__ void smask(f32x16&p0,f32x16&p1,int jb,int qrel,int hi){
  const float NEG=-INFINITY; int kb=64*jb+4*hi;
  #pragma unroll
  for(int r=0;r<16;++r){int kv=kb+(r&3)+8*(r>>2); if(kv>qrel||kv<=qrel-128)p0[r]=NEG; if(kv+32>qrel||kv+32<=qrel-128)p1[r]=NEG;}
}
constexpr int NSLOT=3, SLOTB=8192;
constexpr int LDS_K=0, LDS_V=NSLOT*SLOTB, LDS_WS=2*NSLOT*SLOTB, LDS_OST=LDS_WS+NW*64*4, LDS_BYTES=LDS_OST+NW*4096;
constexpr float C2=0.125f*1.4426950408889634f;
__device__ __forceinline__ void glds16(const void*gsrc,unsigned lds_dst){unsigned keep;
  asm volatile("s_mov_b32 %0, m0\n\ts_mov_b32 m0, %2\n\ts_nop 0\n\tglobal_load_lds_dwordx4 %1, off\n\ts_mov_b32 m0, %0":"=&s"(keep):"v"(gsrc),"s"(lds_dst):"memory");}
__device__ __forceinline__ float max3f(float a,float b,float c){float r;asm("v_max3_f32 %0, %1, %2, %3":"=v"(r):"v"(a),"v"(b),"v"(c));return r;}
__device__ __forceinline__ float max2f(float a,float b){float r;asm("v_max_f32_e32 %0, %1, %2":"=v"(r):"v"(a),"v"(b));return r;}
__device__ __forceinline__ float fadd_s(float a,float b){float r;asm("v_add_f32_e32 %0, %1, %2":"=v"(r):"v"(a),"v"(b));return r;}
__device__ __forceinline__ float fsub_s(float a,float b){float r;asm("v_sub_f32_e32 %0, %1, %2":"=v"(r):"v"(a),"v"(b));return r;}
typedef float f32x2_t __attribute__((ext_vector_type(2))); typedef __bf16 bf16x2_t __attribute__((ext_vector_type(2)));
__device__ __forceinline__ unsigned cvtpk_s(float lo,float hi){f32x2_t v={lo,hi};bf16x2_t b=__builtin_convertvector(v,bf16x2_t);return __builtin_bit_cast(unsigned,b);}
#define WAIT_BAR(N) asm volatile("s_waitcnt vmcnt(" #N ") lgkmcnt(0)\n\ts_barrier":::"memory")

__device__ __forceinline__ void qkt(f32x16&p0,f32x16&p1,const char*Kslot,const bf16x8*qr,const f32x16&negm,int r32,int hi){
  const char*kb=Kslot+hi*1024+r32*16;
  #pragma unroll
  for(int d0=0;d0<4;++d0){
    const bf16x8 b0=*reinterpret_cast<const bf16x8*>(kb+d0*2048);
    const bf16x8 b1=*reinterpret_cast<const bf16x8*>(kb+d0*2048+512);
    if(d0==0){p0=__builtin_amdgcn_mfma_f32_32x32x16_bf16(b0,qr[0],negm,0,0,0);p1=__builtin_amdgcn_mfma_f32_32x32x16_bf16(b1,qr[0],negm,0,0,0);}
    else{p0=__builtin_amdgcn_mfma_f32_32x32x16_bf16(b0,qr[d0],p0,0,0,0);p1=__builtin_amdgcn_mfma_f32_32x32x16_bf16(b1,qr[d0],p1,0,0,0);}}
}
typedef __attribute__((address_space(3))) const char* lds_cptr;
typedef short v4i16_t __attribute__((ext_vector_type(4)));
__device__ __forceinline__ void kload8(bf16x8*kf,lds_cptr kp){
  kf[0]=*(const __attribute__((address_space(3))) bf16x8*)(kp);      kf[1]=*(const __attribute__((address_space(3))) bf16x8*)(kp+512);
  kf[2]=*(const __attribute__((address_space(3))) bf16x8*)(kp+2048); kf[3]=*(const __attribute__((address_space(3))) bf16x8*)(kp+2560);
  kf[4]=*(const __attribute__((address_space(3))) bf16x8*)(kp+4096); kf[5]=*(const __attribute__((address_space(3))) bf16x8*)(kp+4608);
  kf[6]=*(const __attribute__((address_space(3))) bf16x8*)(kp+6144); kf[7]=*(const __attribute__((address_space(3))) bf16x8*)(kp+6656);
}
__device__ __forceinline__ void kload2(bf16x8*kf,lds_cptr kp,int j){ kf[2*j]=*(const __attribute__((address_space(3))) bf16x8*)(kp+j*2048); kf[2*j+1]=*(const __attribute__((address_space(3))) bf16x8*)(kp+j*2048+512); }
__device__ __forceinline__ s16x4 vtr(lds_cptr p){ return __builtin_bit_cast(s16x4,__builtin_amdgcn_ds_read_tr16_b64_v4i16((__attribute__((address_space(3))) v4i16_t*)p)); }
__device__ __forceinline__ float rowmax(const f32x16&p0,const f32x16&p1){
  float a=max3f(p0[0],p0[1],p1[0]),b=max3f(p0[2],p0[3],p1[1]);a=max3f(a,p1[2],p1[3]);
  #pragma unroll
  for(int r=4;r<16;r+=4){a=max3f(a,p0[r],p0[r+1]);b=max3f(b,p0[r+2],p0[r+3]);a=max3f(a,p1[r],p1[r+1]);b=max3f(b,p1[r+2],p1[r+3]);}
  const float m=max2f(a,b);
  auto rr=__builtin_amdgcn_permlane32_swap(__float_as_uint(m),__float_as_uint(m),false,false);
  return max2f(__uint_as_float(rr[0]),__uint_as_float(rr[1]));
}
__device__ __forceinline__ void pv(f32x16*o,int vb,bf16x8 pa0,bf16x8 pa1,bf16x8 pa2,bf16x8 pa3){
  #pragma unroll
  for(int d0=0;d0<2;++d0){s16x4 lo[4],hi[4];
    #pragma unroll
    for(int ks=0;ks<4;++ks){
      asm volatile("ds_read_b64_tr_b16 %0,%1 offset:%c2":"=&v"(lo[ks]):"v"(vb),"i"(d0*4096+ks*1024):"memory");
      asm volatile("ds_read_b64_tr_b16 %0,%1 offset:%c2":"=&v"(hi[ks]):"v"(vb),"i"(d0*4096+ks*1024+512):"memory");}
    asm volatile("s_waitcnt lgkmcnt(0)":::"memory");SBAR();
    #define PK(k) (bf16x8){lo[k][0],lo[k][1],lo[k][2],lo[k][3],hi[k][0],hi[k][1],hi[k][2],hi[k][3]}
    o[d0]=__builtin_amdgcn_mfma_f32_32x32x16_bf16(pa0,PK(0),o[d0],0,0,0);
    o[d0]=__builtin_amdgcn_mfma_f32_32x32x16_bf16(pa1,PK(1),o[d0],0,0,0);
    o[d0]=__builtin_amdgcn_mfma_f32_32x32x16_bf16(pa2,PK(2),o[d0],0,0,0);
    o[d0]=__builtin_amdgcn_mfma_f32_32x32x16_bf16(pa3,PK(3),o[d0],0,0,0);
    #undef PK
  }
}

#ifndef ATTN_STORE16
#define ATTN_STORE16(p,v) (*(u32x4*)(p)=(v))
#endif
template<int MODE,int KP,int VP,int THRL> __device__ __forceinline__ void attn_unit(long rowbase,int q0,const bf16*Qh,const bf16*__restrict__ Kh0,const bf16*__restrict__ Vh0,bf16*Oh,float sink2a,float sink2b,char*shm){
  int tid=threadIdx.x; asm volatile("":"+v"(tid));
  const int lane=tid&63,r32=lane&31,hi=lane>>5; const int wid=__builtin_amdgcn_readfirstlane(tid>>6);
  const int t0=(MODE==1&&q0>=128)?(q0/KVBLK-2):0;
  const int wrow=(MODE==1)?(wid&3)*QBLK:wid*QBLK, whd=(MODE==1)?(wid>>2)*D:0;
  const float sink2=(MODE==1&&(wid>>2))?sink2b:sink2a;
  const bf16*Qw=Qh+whd+(rowbase+q0+wrow)*QP;
  const bf16*Kh=Kh0+(rowbase+(long)t0*KVBLK)*KP,*Vh=Vh0+(rowbase+(long)t0*KVBLK)*VP;
  const unsigned lds0=(unsigned)(uintptr_t)shm;
  float*wsf=(float*)(shm+LDS_WS)+wid*64;
  const bf16*ksrc=Kh+(long)lane*KP+wid*8;
  const bf16*vsrc=Vh+(long)(16*(wid&3)+(lane>>2))*VP+(wid>>2)*32+(lane&3)*8;
  const unsigned kdst=lds0+LDS_K+wid*1024, vdst=lds0+LDS_V+wid*1024;
  #define DMA_K(t,slot) glds16(ksrc+(long)(t)*KVBLK*KP,(unsigned)__builtin_amdgcn_readfirstlane(kdst+(slot)))
  #define DMA_V(t,slot) glds16(vsrc+(long)(t)*KVBLK*VP,(unsigned)__builtin_amdgcn_readfirstlane(vdst+(slot)))
  const int vb0=(int)(lds0+LDS_V)+((lane>>4)&1)*32+(lane&3)*8+(4*hi+((lane&15)>>2))*64;
  const char*Kbase=shm+LDS_K; bf16x8 kf[8];
  const lds_cptr shm3=(lds_cptr)shm; const lds_cptr kp0=shm3+LDS_K+hi*1024+r32*16; const lds_cptr vp0=shm3+LDS_V+((lane>>4)&1)*32+(lane&3)*8+(4*hi+((lane&15)>>2))*64;
  const int NT=(MODE==1)?4:(q0+QB)/KVBLK;
  const int jb0=(MODE==1)?(t0-q0/KVBLK):0;
  DMA_K(0,0);DMA_V(0,0);DMA_K(1,SLOTB);
  bf16x8 qr[4];
  #pragma unroll
  for(int d0=0;d0<4;++d0)qr[d0]=*reinterpret_cast<const bf16x8*>(&Qw[(long)r32*QP+d0*16+hi*8]);
  float mhat=0.f,l_reg=0.f;f32x16 o[2];o[0]=f32x16{};o[1]=f32x16{};f32x16 negm=f32x16{};asm volatile("":"+v"(negm));
  const int qrel=wrow+r32;
  #define CMASK(P0,P1,t) do{int jb_=(t)-(NT-4); if(MODE==1)smask(P0,P1,(t)+jb0,qrel,hi); else if(jb_>=0)cmask(P0,P1,jb_,qrel,hi);}while(0)
  bool resc=false;
  #define START(P0,P1) do{ const float rm=rowmax(P0,P1); resc=false; \
    { const float dl=max2f(rm,-64.f); mhat=fadd_s(mhat,dl); \
      _Pragma("unroll") for(int r=0;r<16;++r){P0[r]=fsub_s(P0[r],dl);P1[r]=fsub_s(P1[r],dl);} \
      _Pragma("unroll") for(int r=0;r<16;++r)negm[r]=-mhat; asm volatile("":"+v"(negm)); } \
    _Pragma("unroll") for(int r=0;r<16;++r)P0[r]=__builtin_amdgcn_exp2f(P0[r]); }while(0)
  #define RESC() do{ if(resc){ asm volatile("s_waitcnt lgkmcnt(0)":::"memory"); \
      _Pragma("unroll") for(int d_=0;d_<2;++d_) _Pragma("unroll") for(int r=0;r<16;++r)o[d_][r]*=wsf[crow(r,hi)]; } }while(0)
  f32x16 pA0,pA1,pB0,pB1;
  int sl_prev=0,sl_cur=0,sl_next=SLOTB;
  #define ROT() do{sl_prev=sl_cur;sl_cur=sl_next;sl_next=(sl_next==(NSLOT-1)*SLOTB)?0:sl_next+SLOTB;}while(0)
  DMA_K(2,2*SLOTB);
  WAIT_BAR(3);
  qkt(pA0,pA1,Kbase,qr,negm,r32,hi);asm volatile("s_nop 15\n\ts_nop 7":"+v"(pA0),"+v"(pA1));CMASK(pA0,pA1,0);
  START(pA0,pA1);
  _Pragma("unroll") for(int r=0;r<16;++r)pA1[r]=__builtin_amdgcn_exp2f(pA1[r]);
  WAIT_BAR(0);
  DMA_K(3,0);DMA_V(1,SLOTB);
  ROT();
  kload8(kf,kp0+sl_cur);
  WAIT_BAR(2);
  s16x4 vlo[8],vhi[8]; u32x4 pw0,pw1,pw2,pw3;
  #define PKW(P,B) cvtpk_s(P[B],P[B+1])
  #define PAF(k) __builtin_bit_cast(bf16x8,pw##k)
  #define VFR(i) (bf16x8){vlo[i][0],vlo[i][1],vlo[i][2],vlo[i][3],vhi[i][0],vhi[i][1],vhi[i][2],vhi[i][3]}
  #define PIN(x) asm volatile("":"+v"(x))
  #define MX3(a,b,c) __builtin_fmaxf(__builtin_fmaxf((a),(b)),(c))
  #define GAPA(MF,A0,A1,A2,A3,W0,W1,PW) do{ MF; sacc+=A0; sacc+=A1; sacc+=A2; sacc+=A3; PIN(sacc); W0; W1; PIN(PW); SBAR(); }while(0)
  #define EX(v) __builtin_amdgcn_exp2f(v)
  #define GAPB(MF,X,B) do{ MF; X[B]=EX(X[B]); X[B+1]=EX(X[B+1]); X[B+2]=EX(X[B+2]); X[B+3]=EX(X[B+3]); PIN(X); SBAR(); }while(0)
  #define VRD(i) do{ vlo[i]=vtr(vp_+(((i)>>2)*4096+((i)&3)*1024)); vhi[i]=vtr(vp_+(((i)>>2)*4096+((i)&3)*1024+512)); }while(0)
  #define KRD(G,j) do{ if(G){ kload2(kf,kp0+sl_next,j); SBAR(); } }while(0)
  #define STEP(C0,C1,P0,P1,t,GK,GV,GL) do{ SBAR(); \
    const lds_cptr vp_=vp0+sl_prev; \
    VRD(0); SBAR(); float sacc=(P0[0]+P0[1]); \
    GAPA(C0=__builtin_amdgcn_mfma_f32_32x32x16_bf16(kf[0],qr[0],negm,0,0,0), P0[2],P0[3],P0[4],P0[5],     pw0[0]=PKW(P0,0), pw0[1]=PKW(P0,2), pw0); \
    VRD(4); SBAR(); GAPA(C1=__builtin_amdgcn_mfma_f32_32x32x16_bf16(kf[1],qr[0],negm,0,0,0), P0[6],P0[7],P0[8],P0[9],     pw0[2]=PKW(P0,4), pw0[3]=PKW(P0,6), pw0); \
    VRD(1); SBAR(); GAPA(C0=__builtin_amdgcn_mfma_f32_32x32x16_bf16(kf[2],qr[1],C0,0,0,0),   P0[10],P0[11],P0[12],P0[13], pw1[0]=PKW(P0,8), pw1[1]=PKW(P0,10), pw1); \
    VRD(5); SBAR(); GAPA(C1=__builtin_amdgcn_mfma_f32_32x32x16_bf16(kf[3],qr[1],C1,0,0,0),   P0[14],P0[15],P1[0],P1[1],   pw1[2]=PKW(P0,12),pw1[3]=PKW(P0,14), pw1); \
    VRD(2); SBAR(); GAPA(C0=__builtin_amdgcn_mfma_f32_32x32x16_bf16(kf[4],qr[2],C0,0,0,0),   P1[2],P1[3],P1[4],P1[5],     pw2[0]=PKW(P1,0), pw2[1]=PKW(P1,2), pw2); \
    VRD(6); SBAR(); GAPA(C1=__builtin_amdgcn_mfma_f32_32x32x16_bf16(kf[5],qr[2],C1,0,0,0),   P1[6],P1[7],P1[8],P1[9],     pw2[2]=PKW(P1,4), pw2[3]=PKW(P1,6), pw2); \
    VRD(3); SBAR(); GAPA(C0=__builtin_amdgcn_mfma_f32_32x32x16_bf16(kf[6],qr[3],C0,0,0,0),   P1[10],P1[11],P1[12],P1[13], pw3[0]=PKW(P1,8), pw3[1]=PKW(P1,10), pw3); \
    VRD(7); SBAR(); GAPA(C1=__builtin_amdgcn_mfma_f32_32x32x16_bf16(kf[7],qr[3],C1,0,0,0),   P1[14],P1[15],0.f,0.f,       pw3[2]=PKW(P1,12),pw3[3]=PKW(P1,14), pw3); \
    l_reg+=sacc; \
    if(GK){DMA_K((t)+3,sl_cur);} if(GV){DMA_V((t)+1,sl_next);} \
    CMASK(C0,C1,t); \
    { float a=MX3(C0[0],C0[1],C1[0]),b=MX3(C0[2],C0[3],C1[1]); a=MX3(a,C1[2],C1[3]); \
      _Pragma("unroll") for(int r=4;r<16;r+=4){a=MX3(a,C0[r],C0[r+1]);b=MX3(b,C0[r+2],C0[r+3]);a=MX3(a,C1[r],C1[r+1]);b=MX3(b,C1[r+2],C1[r+3]);} \
      float rm=__builtin_fmaxf(a,b); { auto rr=__builtin_amdgcn_permlane32_swap(__float_as_uint(rm),__float_as_uint(rm),false,false); rm=__builtin_fmaxf(__uint_as_float(rr[0]),__uint_as_float(rr[1])); } \
      resc=false; \
      if(__builtin_expect(__any(rm>(float)THRL),0)){ const float dl=__builtin_fmaxf(rm,0.f); mhat+=dl; \
        _Pragma("unroll") for(int r=0;r<16;++r){C0[r]-=dl;C1[r]-=dl;} \
        _Pragma("unroll") for(int r=0;r<16;++r)negm[r]=-mhat; asm volatile("":"+v"(negm)); \
        const float f=__builtin_amdgcn_exp2f(-dl); l_reg*=f; if(hi==0)wsf[r32]=f; resc=true; } } \
    SBAR(); \
    GAPB(o[0]=__builtin_amdgcn_mfma_f32_32x32x16_bf16(PAF(0),VFR(0),o[0],0,0,0), C0,0); \
    GAPB(o[1]=__builtin_amdgcn_mfma_f32_32x32x16_bf16(PAF(0),VFR(4),o[1],0,0,0), C0,4); \
    KRD(GL,0); GAPB(o[0]=__builtin_amdgcn_mfma_f32_32x32x16_bf16(PAF(1),VFR(1),o[0],0,0,0), C0,8); \
    KRD(GL,1); GAPB(o[1]=__builtin_amdgcn_mfma_f32_32x32x16_bf16(PAF(1),VFR(5),o[1],0,0,0), C0,12); \
    KRD(GL,2); GAPB(o[0]=__builtin_amdgcn_mfma_f32_32x32x16_bf16(PAF(2),VFR(2),o[0],0,0,0), C1,0); \
    KRD(GL,3); GAPB(o[1]=__builtin_amdgcn_mfma_f32_32x32x16_bf16(PAF(2),VFR(6),o[1],0,0,0), C1,4); \
    GAPB(o[0]=__builtin_amdgcn_mfma_f32_32x32x16_bf16(PAF(3),VFR(3),o[0],0,0,0), C1,8); \
    GAPB(o[1]=__builtin_amdgcn_mfma_f32_32x32x16_bf16(PAF(3),VFR(7),o[1],0,0,0), C1,12); \
    }while(0)
  int t=1;
  #undef CMASK
  #define CMASK(P0,P1,t) do{}while(0)
  for(;t+5<NT;t+=2){
    STEP(pB0,pB1,pA0,pA1,t,true,true,true);     WAIT_BAR(2); RESC(); ROT();
    STEP(pA0,pA1,pB0,pB1,t+1,true,true,true);   WAIT_BAR(2); RESC(); ROT();
  }
  #undef CMASK
  #define CMASK(P0,P1,t) do{int jb_=(t)-(NT-4); if(MODE==1)smask(P0,P1,(t)+jb0,qrel,hi); else if(jb_>=0)cmask(P0,P1,jb_,qrel,hi);}while(0)
  #define ENDW(tt) do{ if((tt)+3<NT){WAIT_BAR(2);} else if((tt)+2<NT){WAIT_BAR(1);} else {WAIT_BAR(0);} }while(0)
  for(;t+1<NT;t+=2){
    STEP(pB0,pB1,pA0,pA1,t,(t+3<NT),(t+1<NT),(t+1<NT));       ENDW(t);   RESC(); ROT();
    STEP(pA0,pA1,pB0,pB1,t+1,(t+4<NT),(t+2<NT),(t+2<NT));     ENDW(t+1); RESC(); ROT();
  }
  STEP(pB0,pB1,pA0,pA1,NT-1,false,false,false); RESC();
  { float sacc=pB0[0]+pB0[1]; _Pragma("unroll") for(int r=2;r<16;++r)sacc+=pB0[r]; _Pragma("unroll") for(int r=0;r<16;++r)sacc+=pB1[r]; l_reg+=sacc;
    pw0=(u32x4){PKW(pB0,0),PKW(pB0,2),PKW(pB0,4),PKW(pB0,6)};pw1=(u32x4){PKW(pB0,8),PKW(pB0,10),PKW(pB0,12),PKW(pB0,14)};pw2=(u32x4){PKW(pB1,0),PKW(pB1,2),PKW(pB1,4),PKW(pB1,6)};pw3=(u32x4){PKW(pB1,8),PKW(pB1,10),PKW(pB1,12),PKW(pB1,14)};
    SBAR(); pv(o,vb0+sl_cur,PAF(0),PAF(1),PAF(2),PAF(3)); }
  #undef PKW
  #undef PAF
  #undef VFR
  #undef PIN
  #undef MX3
  #undef GAPA
  #undef GAPB
  #undef EX
  #undef VRD
  #undef KRD
  #undef STEP
  #undef ENDW
  {auto rr=__builtin_amdgcn_permlane32_swap(__float_as_uint(l_reg),__float_as_uint(l_reg),false,false);l_reg=__uint_as_float(rr[0])+__uint_as_float(rr[1]);}
  if(MODE==1)l_reg+=__builtin_amdgcn_exp2f(sink2-mhat);
  if(hi==0)wsf[32+r32]=l_reg;asm volatile("s_waitcnt lgkmcnt(0)":::"memory");
  float rli[16];
  #pragma unroll
  for(int r=0;r<16;++r)rli[r]=__builtin_amdgcn_rcpf(wsf[32+crow(r,hi)]);
  bf16*Ow=Oh+whd+(rowbase+q0+wrow)*OP;
  { bf16*stg=(bf16*)(shm+LDS_OST)+wid*2048;
    #pragma unroll
    for(int r=0;r<16;++r){const int orow=crow(r,hi);
      #pragma unroll
      for(int d0=0;d0<2;++d0)stg[orow*64+d0*32+r32]=__float2bfloat16(o[d0][r]*rli[r]);}
    asm volatile("s_waitcnt lgkmcnt(0)":::"memory");
    #pragma unroll
    for(int i=0;i<4;++i){const int row=i*8+(lane>>3),ch=lane&7; const u32x4 v=*(const u32x4*)(stg+row*64+ch*8); ATTN_STORE16(Ow+(long)row*OP+ch*8,v);} }
  asm volatile("s_waitcnt lgkmcnt(0)\n\ts_barrier":::"memory");
  #undef DMA_K
  #undef DMA_V
  #undef CMASK
  #undef START
  #undef RESC
  #undef ROT
}
constexpr int V2SLOT=16384;
constexpr int L2_K=0, L2_V=NSLOT*SLOTB, L2_WS=L2_V+NSLOT*V2SLOT, L2_OST=L2_WS+NW*64*4, L2_BYTES=L2_OST+NW*4096;
template<int THRL> __device__ __forceinline__ void attn_unit128(long rowbase,int q0,const bf16*Qh,const bf16*__restrict__ Kh0,const bf16*__restrict__ Vh0,bf16*Oh,bool cmb,float lam,const float*gsub,char*shm){
  constexpr int KP=512,VP=512;
  int tid=threadIdx.x; asm volatile("":"+v"(tid));
  const int lane=tid&63,r32=lane&31,hi=lane>>5; const int wid=__builtin_amdgcn_readfirstlane(tid>>6);
  const bf16*Qw=Qh+(rowbase+q0+wid*QBLK)*QP;
  const bf16*Kh=Kh0+rowbase*KP,*Vh=Vh0+rowbase*VP;
  const unsigned lds0=(unsigned)(uintptr_t)shm;
  float*wsf=(float*)(shm+L2_WS)+wid*64;
  const bf16*ksrc=Kh+(long)lane*KP+wid*8;
  const bf16*vsrc=Vh+(long)(16*(wid&3)+(lane>>2))*VP+(wid>>2)*32+(lane&3)*8;
  const unsigned kdst=lds0+L2_K+wid*1024, vdst=lds0+L2_V+wid*1024;
  #define DK128(t,slot) glds16(ksrc+(long)(t)*KVBLK*KP,(unsigned)__builtin_amdgcn_readfirstlane(kdst+(slot)))
  #define DV128(t,slot) do{ glds16(vsrc+(long)(t)*KVBLK*VP,(unsigned)__builtin_amdgcn_readfirstlane(vdst+(slot))); glds16(vsrc+(long)(t)*KVBLK*VP+64,(unsigned)__builtin_amdgcn_readfirstlane(vdst+(slot)+8192)); }while(0)
  const lds_cptr shm3=(lds_cptr)shm; const lds_cptr kp0=shm3+L2_K+hi*1024+r32*16; const lds_cptr vp0=shm3+L2_V+((lane>>4)&1)*32+(lane&3)*8+(4*hi+((lane&15)>>2))*64;
  const int NT=(q0+QB)/KVBLK;
  DK128(0,0);DV128(0,0);DK128(1,SLOTB);
  typedef __attribute__((address_space(3))) bf16x8* lds_q8;
  const lds_q8 qst=(lds_q8)(shm3+L2_OST+wid*4096+lane*16);
  { bf16x8 qt[4];
    #pragma unroll
    for(int d0=0;d0<4;++d0)qt[d0]=*reinterpret_cast<const bf16x8*>(&Qw[(long)r32*QP+d0*16+hi*8]);
    #pragma unroll
    for(int d0=0;d0<4;++d0)qst[d0*64]=qt[d0]; }
  float mhat=0.f,l_reg=0.f;f32x16 o[4];o[0]=f32x16{};o[1]=f32x16{};o[2]=f32x16{};o[3]=f32x16{};f32x16 negm=f32x16{};asm volatile("":"+v"(negm));
  const int qrel=wid*QBLK+r32;
  bool resc=false;
  f32x16 C0,C1; u32x4 pw0,pw1,pw2,pw3; bf16x8 kf[8]; s16x4 vfl[16],vfh[16];
  int ip=0,ic=0,in=1;
  #define ROT128() do{ip=ic;ic=in;in=(in==NSLOT-1)?0:in+1;}while(0)
  #define MF32(a,b,c) __builtin_amdgcn_mfma_f32_32x32x16_bf16(a,b,c,0,0,0)
  #define PV32(acc,a,b) do{ const bf16x8 a_=(a), b_=(b); asm volatile("v_mfma_f32_32x32x16_bf16 %0, %1, %2, %0":"+v"(acc):"v"(a_),"v"(b_)); }while(0)
  #define PIN(x) asm volatile("":"+v"(x))
  #define EXP2(CX,B) do{ CX[B]=__builtin_amdgcn_exp2f(CX[B]); CX[(B)+1]=__builtin_amdgcn_exp2f(CX[(B)+1]); sacc+=CX[B]; sacc+=CX[(B)+1]; }while(0)
  #define PACK2(CX,B,PN,W) do{ PN[W]=cvtpk_s(CX[B],CX[(B)+1]); }while(0)
  #define QK128(slotb) do{ kload8(kf,kp0+(slotb)); const bf16x8 q0_=qst[0],q1_=qst[64],q2_=qst[128],q3_=qst[192]; \
    C0=MF32(kf[0],q0_,negm); C1=MF32(kf[1],q0_,negm); C0=MF32(kf[2],q1_,C0); C1=MF32(kf[3],q1_,C1); \
    C0=MF32(kf[4],q2_,C0);   C1=MF32(kf[5],q2_,C1);   C0=MF32(kf[6],q3_,C0); C1=MF32(kf[7],q3_,C1); }while(0)
  #define QK128P(slotb) do{ kload8(kf,kp0+(slotb)); const bf16x8 q0_=qst[0],q1_=qst[64],q2_=qst[128],q3_=qst[192]; float sacc=0.f; SBAR(); \
    C0=MF32(kf[0],q0_,negm); EXP2(C1,0);  EXP2(C1,2);  PIN(sacc); PIN(C1); SBAR(); \
    C0=MF32(kf[2],q1_,C0);   EXP2(C1,4);  EXP2(C1,6);  PIN(sacc); PIN(C1); SBAR(); \
    C0=MF32(kf[4],q2_,C0);   EXP2(C1,8);  EXP2(C1,10); PIN(sacc); PIN(C1); SBAR(); \
    C0=MF32(kf[6],q3_,C0);   EXP2(C1,12); EXP2(C1,14); PIN(sacc); PIN(C1); SBAR(); \
    PACK2(C1,0,pw2,0); PACK2(C1,2,pw2,1); PACK2(C1,4,pw2,2); PACK2(C1,6,pw2,3); PACK2(C1,8,pw3,0); PACK2(C1,10,pw3,1); PACK2(C1,12,pw3,2); PACK2(C1,14,pw3,3); PIN(pw2); PIN(pw3); l_reg+=sacc; SBAR(); \
    C1=MF32(kf[1],q0_,negm); C1=MF32(kf[3],q1_,C1); C1=MF32(kf[5],q2_,C1); C1=MF32(kf[7],q3_,C1); }while(0)
  #define MX3(a,b,c) __builtin_fmaxf(__builtin_fmaxf((a),(b)),(c))
  #define ROWMAX128(rm) do{ float a_=MX3(C0[0],C0[1],C1[0]),b_=MX3(C0[2],C0[3],C1[1]); a_=MX3(a_,C1[2],C1[3]); \
      _Pragma("unroll") for(int r=4;r<16;r+=4){a_=MX3(a_,C0[r],C0[r+1]);b_=MX3(b_,C0[r+2],C0[r+3]);a_=MX3(a_,C1[r],C1[r+1]);b_=MX3(b_,C1[r+2],C1[r+3]);} \
      rm=__builtin_fmaxf(a_,b_); { auto rr=__builtin_amdgcn_permlane32_swap(__float_as_uint(rm),__float_as_uint(rm),false,false); rm=__builtin_fmaxf(__uint_as_float(rr[0]),__uint_as_float(rr[1])); } }while(0)
  #define VRD128(i,vp_) do{ vfl[i]=vtr((vp_)+(((i)>>2)*4096+((i)&3)*1024)); vfh[i]=vtr((vp_)+(((i)>>2)*4096+((i)&3)*1024+512)); }while(0)
  #define VFR128(i) (bf16x8){vfl[i][0],vfl[i][1],vfl[i][2],vfl[i][3],vfh[i][0],vfh[i][1],vfh[i][2],vfh[i][3]}
  #define GAP128(g,PP,vp_) do{ PV32(o[(g)&3],__builtin_bit_cast(bf16x8,PP),VFR128(4*((g)&3)+((g)>>2))); \
      if((g)+2<16){ VRD128(4*(((g)+2)&3)+(((g)+2)>>2),vp_); } if(((g)&1)==0){ EXP2(C0,g); PIN(C0); } \
      if((g)>=8){ if((g)<12){ PACK2(C0,2*((g)-8),pw0,(g)-8); PIN(pw0); } else { PACK2(C0,2*((g)-8),pw1,(g)-12); PIN(pw1); } } PIN(sacc); SBAR(); }while(0)
  #define PHASEB128(vp_) do{ float sacc=0.f; VRD128(0,vp_); VRD128(4,vp_); SBAR(); \
      GAP128(0,pw0,vp_);  GAP128(1,pw0,vp_);  GAP128(2,pw0,vp_);  GAP128(3,pw0,vp_); \
      GAP128(4,pw1,vp_);  GAP128(5,pw1,vp_);  GAP128(6,pw1,vp_);  GAP128(7,pw1,vp_); \
      GAP128(8,pw2,vp_);  GAP128(9,pw2,vp_);  GAP128(10,pw2,vp_); GAP128(11,pw2,vp_); \
      GAP128(12,pw3,vp_); GAP128(13,pw3,vp_); GAP128(14,pw3,vp_); GAP128(15,pw3,vp_); \
      l_reg+=sacc; }while(0)
  #define RESC128() do{ if(resc){ asm volatile("s_waitcnt lgkmcnt(0)\n\ts_nop 15\n\ts_nop 15":::"memory"); \
      _Pragma("unroll") for(int d_=0;d_<4;++d_) _Pragma("unroll") for(int r=0;r<16;++r)o[d_][r]*=wsf[crow(r,hi)]; } }while(0)
  #define STEP128(t,GK,GV,MASKED) do{ SBAR(); \
    QK128P(ic*SLOTB); \
    if(GK){DK128((t)+2,ip*SLOTB);} if(GV){DV128((t)+1,in*V2SLOT);} \
    if(MASKED){ const int jb_=(t)-(NT-4); if(jb_>=0)cmask(C0,C1,jb_,qrel,hi); } \
    { float rm; ROWMAX128(rm); resc=false; \
      if(__builtin_expect(__any(rm>(float)THRL),0)){ const float dl=__builtin_fmaxf(rm,0.f); mhat+=dl; \
        _Pragma("unroll") for(int r=0;r<16;++r){C0[r]-=dl;C1[r]-=dl;} \
        _Pragma("unroll") for(int r=0;r<16;++r)negm[r]=-mhat; asm volatile("":"+v"(negm)); \
        const float f=__builtin_amdgcn_exp2f(-dl); l_reg*=f; if(hi==0)wsf[r32]=f; resc=true; } } \
    SBAR(); \
    { const lds_cptr vpp_=vp0+ip*V2SLOT; PHASEB128(vpp_); } \
    }while(0)
  WAIT_BAR(3);
  QK128(0);
  if(NT==4)cmask(C0,C1,0,qrel,hi);
  { float rm; ROWMAX128(rm); const float dl=__builtin_fmaxf(rm,-64.f); mhat=dl;
    #pragma unroll
    for(int r=0;r<16;++r){C0[r]-=dl;C1[r]-=dl;}
    #pragma unroll
    for(int r=0;r<16;++r)negm[r]=-mhat;
    asm volatile("":"+v"(negm));
    float sacc=0.f;
    #pragma unroll
    for(int w=0;w<4;++w){ EXP2(C0,2*w); PACK2(C0,2*w,pw0,w); EXP2(C0,8+2*w); PACK2(C0,8+2*w,pw1,w); }
    l_reg=sacc; }
  DK128(2,2*SLOTB); DV128(1,V2SLOT);
  WAIT_BAR(3);
  ROT128();
  #pragma unroll 1
  for(int t=1;t<NT;++t){
    const bool gk=t+2<NT,gv=t+1<NT,msk=t>=NT-4;
    STEP128(t,gk,gv,msk);
    if(gk){WAIT_BAR(3);}else if(gv){WAIT_BAR(2);}else{WAIT_BAR(0);}
    RESC128(); if(gv)ROT128();
  }
  { float sacc=0.f;
    #pragma unroll
    for(int w=0;w<4;++w){ EXP2(C1,2*w); PACK2(C1,2*w,pw2,w); EXP2(C1,8+2*w); PACK2(C1,8+2*w,pw3,w); }
    l_reg+=sacc; }
  { const lds_cptr vpp_=vp0+ic*V2SLOT;
    #pragma unroll
    for(int i=0;i<16;++i)VRD128(i,vpp_);
    #pragma unroll
    for(int g=0;g<16;++g){ const int db=g&3,kc=g>>2; const u32x4 pp=kc==0?pw0:kc==1?pw1:kc==2?pw2:pw3; PV32(o[db],__builtin_bit_cast(bf16x8,pp),VFR128(4*db+kc)); }
    asm volatile("s_nop 15\n\ts_nop 15\n\ts_nop 7":"+v"(o[0]),"+v"(o[1]),"+v"(o[2]),"+v"(o[3])); }
  {auto rr=__builtin_amdgcn_permlane32_swap(__float_as_uint(l_reg),__float_as_uint(l_reg),false,false);l_reg=__uint_as_float(rr[0])+__uint_as_float(rr[1]);}
  if(hi==0)wsf[32+r32]=l_reg;asm volatile("s_waitcnt lgkmcnt(0)":::"memory");
  float rli[16];
  #pragma unroll
  for(int r=0;r<16;++r)rli[r]=__builtin_amdgcn_rcpf(wsf[32+crow(r,hi)]);
  bf16*Ow=Oh+(rowbase+q0+wid*QBLK)*OP;
  { bf16*stg=(bf16*)(shm+L2_OST)+wid*2048;
    u32x4 my[2][4];
    #pragma unroll
    for(int rd=0;rd<2;++rd){
      #pragma unroll
      for(int r=0;r<16;++r){const int orow=crow(r,hi);
        #pragma unroll
        for(int d0=0;d0<2;++d0)stg[orow*64+d0*32+r32]=__float2bfloat16(o[2*rd+d0][r]*rli[r]);}
      asm volatile("s_waitcnt lgkmcnt(0)":::"memory");
      #pragma unroll
      for(int i=0;i<4;++i){const int row=i*8+(lane>>3),ch=lane&7; my[rd][i]=*(const u32x4*)(stg+row*64+ch*8);}
      asm volatile("s_waitcnt lgkmcnt(0)":::"memory"); }
    if(!cmb){
      #pragma unroll
      for(int rd=0;rd<2;++rd)
        #pragma unroll
        for(int i=0;i<4;++i){const int row=i*8+(lane>>3),ch=lane&7; ATTN_STORE16(Ow+(long)row*OP+rd*64+ch*8,my[rd][i]);}
    } else {
      u32x4 o1[2][4]; float gv[2][8];
      #pragma unroll
      for(int rd=0;rd<2;++rd){
        #pragma unroll
        for(int i=0;i<4;++i){const int row=i*8+(lane>>3),ch=lane&7; o1[rd][i]=*(const u32x4*)(Ow+(long)row*OP+rd*64+ch*8);}
        #pragma unroll
        for(int j=0;j<8;++j)gv[rd][j]=gsub[rd*64+(lane&7)*8+j]; }
      #define BFLO(w) __uint_as_float((w)<<16)
      #define BFHI(w) __uint_as_float((w)&0xffff0000u)
      float dv[2][4][8]; float ss[4]={0.f,0.f,0.f,0.f};
      #pragma unroll
      for(int rd=0;rd<2;++rd)
        #pragma unroll
        for(int i=0;i<4;++i){ const u32x4 a=o1[rd][i],b2=my[rd][i];
          dv[rd][i][0]=BFLO(a[0])-lam*BFLO(b2[0]); dv[rd][i][1]=BFHI(a[0])-lam*BFHI(b2[0]); dv[rd][i][2]=BFLO(a[1])-lam*BFLO(b2[1]); dv[rd][i][3]=BFHI(a[1])-lam*BFHI(b2[1]);
          dv[rd][i][4]=BFLO(a[2])-lam*BFLO(b2[2]); dv[rd][i][5]=BFHI(a[2])-lam*BFHI(b2[2]); dv[rd][i][6]=BFLO(a[3])-lam*BFLO(b2[3]); dv[rd][i][7]=BFHI(a[3])-lam*BFHI(b2[3]);
          #pragma unroll
          for(int j=0;j<8;++j)ss[i]+=dv[rd][i][j]*dv[rd][i][j]; }
      #pragma unroll
      for(int i=0;i<4;++i){ ss[i]+=__shfl_xor(ss[i],1); ss[i]+=__shfl_xor(ss[i],2); ss[i]+=__shfl_xor(ss[i],4); ss[i]=0.8f/sqrtf(ss[i]*(1.f/128.f)+1e-5f); }
      #pragma unroll
      for(int rd=0;rd<2;++rd)
        #pragma unroll
        for(int i=0;i<4;++i){ const int row=i*8+(lane>>3),ch=lane&7; const float rr_=ss[i]; u32x4 w;
          w[0]=cvtpk_s(dv[rd][i][0]*rr_*gv[rd][0],dv[rd][i][1]*rr_*gv[rd][1]); w[1]=cvtpk_s(dv[rd][i][2]*rr_*gv[rd][2],dv[rd][i][3]*rr_*gv[rd][3]);
          w[2]=cvtpk_s(dv[rd][i][4]*rr_*gv[rd][4],dv[rd][i][5]*rr_*gv[rd][5]); w[3]=cvtpk_s(dv[rd][i][6]*rr_*gv[rd][6],dv[rd][i][7]*rr_*gv[rd][7]);
          ATTN_STORE16(Ow+(long)row*OP+rd*64+ch*8,w); }
      #undef BFLO
      #undef BFHI
    } }
  asm volatile("s_waitcnt lgkmcnt(0)\n\ts_barrier":::"memory");
  #undef DK128
  #undef DV128
  #undef ROT128
  #undef MF32
  #undef PV32
  #undef QK128
  #undef QK128P
  #undef MX3
  #undef ROWMAX128
  #undef PIN
  #undef VRD128
  #undef VFR128
  #undef EXP2
  #undef PACK2
  #undef GAP128
  #undef PHASEB128
  #undef RESC128
  #undef STEP128
}
constexpr int ATTN_LDS_BYTES=(LDS_BYTES>L2_BYTES)?LDS_BYTES:L2_BYTES;
#undef SBAR
#undef WAIT_BAR
}
#define GAS __attribute__((address_space(1)))
#define LAS __attribute__((address_space(3)))
typedef unsigned short bf16;
typedef unsigned v4u __attribute__((ext_vector_type(4)));
typedef float f32x4 __attribute__((ext_vector_type(4)));
typedef short bf16x8 __attribute__((ext_vector_type(8)));
typedef GAS unsigned gu32;
typedef GAS unsigned long long gu64;
#define RLX_AGENT __ATOMIC_RELAXED, __HIP_MEMORY_SCOPE_AGENT
#define LDS_WAIT() asm volatile("s_waitcnt lgkmcnt(0)" ::: "memory")
#define VM_WAIT() asm volatile("s_waitcnt vmcnt(0)" ::: "memory")
__device__ __forceinline__ unsigned long long rt() { return __builtin_amdgcn_s_memrealtime(); }
__device__ __forceinline__ unsigned f2bf(float f) { unsigned u = __builtin_bit_cast(unsigned, f); return (u + 0x7fffu + ((u >> 16) & 1u)) >> 16; }
__device__ __forceinline__ unsigned pk2(float lo, float hi) { return f2bf(lo) | (f2bf(hi) << 16); }

#define XB_TMO      128
#define XB_XCNT(j)  (256  + 64 * (j))
#define XB_XSUB(j)  (1280 + 64 * (j))
#define XB_XGEN(j)  (2304 + 64 * (j))
#define XB_TOP      3328
#define XB_TOPGEN   3392
#define XCD_BAR_WORDS 3456
#define XB_SPIN_CAP (1u << 18)

__device__ __forceinline__ unsigned xb_ld(unsigned* p)              { return __hip_atomic_load(p, __ATOMIC_RELAXED, __HIP_MEMORY_SCOPE_AGENT); }
__device__ __forceinline__ unsigned xb_add(unsigned* p, unsigned v) { return __hip_atomic_fetch_add(p, v, __ATOMIC_RELAXED, __HIP_MEMORY_SCOPE_AGENT); }
__device__ __forceinline__ unsigned xb_xcc_id() { return (unsigned)__builtin_amdgcn_s_getreg((3 << 11) | 20) & 0xFu; }
#define XB_SPIN(cond, bar) do { unsigned _sp = 0; while (cond) { __builtin_amdgcn_s_sleep(1); \
    if ((++_sp & 255u) == 0u) { if (xb_ld(&(bar)[XB_TMO])) break; if (_sp > XB_SPIN_CAP) { atomicAdd(&(bar)[XB_TMO], 1u); break; } } } } while (0)

struct XcdBarrier {
    unsigned* bar; unsigned x;
    volatile LAS unsigned* st;
};

__device__ __forceinline__ XcdBarrier xcd_barrier_post(unsigned* bar, volatile LAS unsigned* st) {
    XcdBarrier b; b.bar = bar; b.x = xb_xcc_id(); b.st = st;
    if (threadIdx.x == 0) (void)xb_add(&bar[XB_XCNT(b.x)], 1u);
    return b;
}
__device__ __forceinline__ void xcd_barrier_complete(unsigned* bar, unsigned x, unsigned& nloc, unsigned& nx) {
    const unsigned G = gridDim.x * gridDim.y * gridDim.z;
    unsigned sum, cnt, mine, sp = 0u;
    for (;;) {
        sum = 0u; cnt = 0u; mine = 0u;
#pragma unroll
        for (unsigned j = 0; j < 16; ++j) { const unsigned c = xb_ld(&bar[XB_XCNT(j)]); sum += c; cnt += (c > 0u) ? 1u : 0u; mine = (j == x) ? c : mine; }
        if (sum == G) break;
        __builtin_amdgcn_s_sleep(1);
        if ((++sp & 255u) == 0u) { if (xb_ld(&bar[XB_TMO])) break; if (sp > XB_SPIN_CAP) { atomicAdd(&bar[XB_TMO], 1u); break; } }
    }
    nloc = mine > 0u ? mine : 1u; nx = cnt > 0u ? cnt : 1u;
}

__device__ __forceinline__ void xcd_barrier(const XcdBarrier& b) {
    asm volatile("s_waitcnt vmcnt(0)" ::: "memory");
    __syncthreads();
    if (threadIdx.x == 0) {
        unsigned* bar = b.bar;
        __builtin_amdgcn_s_waitcnt(0);
        unsigned nloc = b.st[0], nx = b.st[1];
        if (nloc == 0u) { xcd_barrier_complete(bar, b.x, nloc, nx); b.st[0] = nloc; b.st[1] = nx; }
        const unsigned old = xb_add(&bar[XB_XSUB(b.x)], 1u);
        const unsigned gen = old / nloc;
        if (old + 1u == (gen + 1u) * nloc) {
            __builtin_amdgcn_fence(__ATOMIC_RELEASE, "agent");
            asm volatile("s_waitcnt vmcnt(0)" ::: "memory");
            const unsigned og = xb_add(&bar[XB_TOP], 1u);
            const unsigned tg = og / nx;
            if (og + 1u == (tg + 1u) * nx) xb_add(&bar[XB_TOPGEN], 1u);
            else XB_SPIN(xb_ld(&bar[XB_TOPGEN]) == tg, bar);
            __builtin_amdgcn_fence(__ATOMIC_ACQUIRE, "agent");
            xb_add(&bar[XB_XGEN(b.x)], 1u);
            asm volatile("s_waitcnt vmcnt(0)" ::: "memory");
        } else {
            XB_SPIN(xb_ld(&bar[XB_XGEN(b.x)]) == gen, bar);
            __builtin_amdgcn_fence(__ATOMIC_ACQUIRE, "agent");
            asm volatile("s_waitcnt vmcnt(0)" ::: "memory");
        }
    }
    __syncthreads();
}

constexpr int NWAVES = 8;
constexpr int NB = 8, SEQ = 4096, D = 1024, M = NB * SEQ, INW = 4352, NE = 32, FF = 1024;
constexpr float RMS_EPS = 1e-5f;
constexpr float QSCALE = 0.125f * 1.4426950408889634f;
constexpr float LOG2E = 1.4426950408889634f;
constexpr float SX = 16.f, SW = 512.f, SH = 4.f, SY = 64.f, ST = 16.f;
constexpr size_t MiB = 1u << 20;
constexpr size_t WS_CTL = 0, CTL_ZERO_BYTES = 1 * MiB;
constexpr size_t WS_ROPE = 1 * MiB;
constexpr size_t WS_ETOK = 2 * MiB;
constexpr size_t WS_EW = 6 * MiB;
constexpr size_t WS_ERS = 10 * MiB;
constexpr size_t WS_RWF = 14 * MiB;
constexpr size_t WS_WIN = 16 * MiB;
constexpr size_t WS_WA = 25 * MiB, WS_WO = 27 * MiB;
constexpr size_t WS_W1 = 30 * MiB;
constexpr size_t WS_W2 = 158 * MiB;
constexpr size_t WS_XN = 222 * MiB;
constexpr size_t WS_RS0 = 14 * MiB + 512 * 1024;
constexpr size_t WS_X1Q = 494 * MiB;
constexpr size_t WS_QA = 286 * MiB, WS_KA = 318 * MiB, WS_VA = 326 * MiB, WS_QB = 334 * MiB, WS_KB = 366 * MiB, WS_VB = 398 * MiB;
constexpr size_t WS_SGA = 430 * MiB, WS_SGB = 494 * MiB, WS_OSWA = 558 * MiB, WS_OD1 = 590 * MiB, WS_OD2 = 622 * MiB, WS_T = 654 * MiB;
constexpr size_t WS_H = 286 * MiB;
constexpr size_t WS_X1B = 430 * MiB;
constexpr size_t WS_Y = 558 * MiB;
constexpr size_t WS_END = 815 * MiB;
constexpr int CW_TMO = 0, CW_CODE = 1, CW_BAR = 4096, CW_CNT = 8192, CW_Q1 = 10240;
constexpr int NCONV = 64;
static_assert((CW_CNT + 64 * NE) * 4 <= (int)CTL_ZERO_BYTES, "CTL words inside the memset region");
constexpr int RING_OFF = 0, RING_BYTES = 131072;
constexpr int LDSCTL_OFF = RING_BYTES, MISC_OFF = LDSCTL_OFF + 320;
constexpr int SCHED_OFF = LDSCTL_OFF + 512;
constexpr int GTAB_OFF = SCHED_OFF + 1024;
constexpr int LDS_BYTES = 147456;
static_assert(GTAB_OFF + 17 * 512 <= LDS_BYTES, "LDS map");

__device__ const float INV_FREQ[32] = {1.000000000e+00f, 7.498942614e-01f, 5.623413324e-01f, 4.216965139e-01f, 3.162277639e-01f, 2.371373773e-01f, 1.778279394e-01f, 1.333521307e-01f, 1.000000015e-01f, 7.498941571e-02f, 5.623413250e-02f, 4.216965288e-02f, 3.162277490e-02f, 2.371373773e-02f, 1.778279431e-02f, 1.333521493e-02f, 9.999999776e-03f, 7.498941850e-03f, 5.623413250e-03f, 4.216964822e-03f, 3.162277630e-03f, 2.371373586e-03f, 1.778279431e-03f, 1.333521446e-03f, 1.000000047e-03f, 7.498942432e-04f, 5.623413017e-04f, 4.216965172e-04f, 3.162277571e-04f, 2.371373703e-04f, 1.778279402e-04f, 1.333521504e-04f};

struct Frame {
    LAS unsigned char* lds;
    volatile LAS unsigned* MISC;
    gu32* ctl;
    unsigned char* ws;
    int tid, lane, wave;
    int vcu, G;
    const float* in[21]; float* out;
};
__device__ __forceinline__ float wave_sum(float v) {
#pragma unroll
    for (int o = 1; o < 64; o <<= 1) v += __shfl_xor(v, o);
    return v;
}
__device__ __forceinline__ int proj_mode(int hb) { return hb < 4 ? 0 : hb == 4 ? 1 : hb == 5 ? 2 : hb < 10 ? 0 : hb < 14 ? 1 : hb < 18 ? 2 : 3; }
__device__ __forceinline__ void proj_dst(int hb, size_t& off, int& ldc, int& col0) {
    if (hb < 4) { off = WS_QA; ldc = 512; col0 = 128 * hb; }
    else if (hb == 4) { off = WS_KA; ldc = 128; col0 = 0; }
    else if (hb == 5) { off = WS_VA; ldc = 128; col0 = 0; }
    else if (hb < 10) { off = WS_QB; ldc = 512; col0 = 128 * (hb - 6); }
    else if (hb < 14) { off = WS_KB; ldc = 512; col0 = 128 * (hb - 10); }
    else if (hb < 18) { off = WS_VB; ldc = 512; col0 = 128 * (hb - 14); }
    else if (hb < 26) { off = WS_SGA; ldc = 1024; col0 = 128 * (hb - 18); }
    else { off = WS_SGB; ldc = 1024; col0 = 128 * (hb - 26); }
}
__device__ __forceinline__ int proj_rowmap(int n) { const int hb = n >> 7; if (proj_mode(hb) > 1) return n; const int d = n & 63; return (n & ~63) + 8 * ((d & 31) >> 2) + 4 * (d >> 5) + (d & 3); }

template <int RMODE> __device__ __forceinline__ void p0_transpose_item(const float* W, int K, int N, bf16* WT, const float* kscale, LAS float* scr, int item, int lane, int pitch = 0, int koff = 0) {
    if (pitch == 0) pitch = K;
    const int nblk = N / 32, kb = item / nblk, nb = item % nblk, k0 = 64 * kb, n0 = 32 * nb;
#pragma unroll 8
    for (int i = 0; i < 32; ++i) { const int kk = 2 * i + (lane >> 5); float v = W[(size_t)(k0 + kk) * N + n0 + (lane & 31)]; if (kscale) v *= kscale[k0 + kk]; scr[kk * 33 + (lane & 31)] = v; }
    LDS_WAIT(); asm volatile("" ::: "memory");
    const int c = lane & 7;
#pragma unroll
    for (int j = 0; j < 4; ++j) { const int n = (lane >> 3) + 8 * j; const LAS float* s = scr + (8 * c) * 33 + n;
        v4u o; o.x = pk2(s[0 * 33], s[1 * 33]); o.y = pk2(s[2 * 33], s[3 * 33]); o.z = pk2(s[4 * 33], s[5 * 33]); o.w = pk2(s[6 * 33], s[7 * 33]);
        const int drow = RMODE ? proj_rowmap(n0 + n) : (n0 + n);
        *(GAS v4u*)(WT + (size_t)drow * pitch + koff + k0 + 8 * c) = o; }
    LDS_WAIT(); asm volatile("" ::: "memory");
}
struct Fp8Item { const float* W; unsigned char* WT; const float* kscale; int K, N, k0, n0; };
__device__ __forceinline__ Fp8Item fp8_item_make(const float* W, int K, int N, unsigned char* WT, const float* kscale, int item) {
    const int nblk = N / 32, kb = item / nblk, nb = item % nblk; Fp8Item it{W, WT, kscale, K, N, 128 * kb, 32 * nb}; return it; }
__device__ __forceinline__ void fp8_item_load(const Fp8Item& it, f32x4 (&v)[4][4], f32x4 (&ksv)[4], int lane) {
    const int n4 = lane & 7, kq = lane >> 3;
#pragma unroll
    for (int p = 0; p < 4; ++p)
#pragma unroll
        for (int r = 0; r < 4; ++r) v[p][r] = __builtin_nontemporal_load((const GAS f32x4*)(it.W + (size_t)(it.k0 + 32 * p + 4 * kq + r) * it.N + it.n0 + 4 * n4));
#pragma unroll
    for (int p = 0; p < 4; ++p) ksv[p] = it.kscale ? *(const GAS f32x4*)(it.kscale + it.k0 + 32 * p + 4 * kq) : (f32x4){1.f, 1.f, 1.f, 1.f};
}
__device__ __forceinline__ void fp8_item_finish(const Fp8Item& it, const f32x4 (&v)[4][4], const f32x4 (&ksv)[4], float scale, LAS unsigned* scr, int lane) {
    const int n4 = lane & 7, kq = lane >> 3;
#pragma unroll
    for (int p = 0; p < 4; ++p) { float ks[4];
#pragma unroll
        for (int r = 0; r < 4; ++r) ks[r] = ksv[p][r] * scale;
#pragma unroll
        for (int j = 0; j < 4; ++j) { int w = 0; w = __builtin_amdgcn_cvt_pk_fp8_f32(v[p][0][j] * ks[0], v[p][1][j] * ks[1], w, false); w = __builtin_amdgcn_cvt_pk_fp8_f32(v[p][2][j] * ks[2], v[p][3][j] * ks[3], w, true);
            scr[(8 * p + kq) * 33 + 4 * n4 + j] = (unsigned)w; } }
    LDS_WAIT(); asm volatile("" ::: "memory");
    const int c = lane & 7, nn = lane >> 3;
#pragma unroll
    for (int i = 0; i < 4; ++i) { const int n = nn + 8 * i; const LAS unsigned* sp = scr + (4 * c) * 33 + n;
        v4u o; o.x = sp[0]; o.y = sp[33]; o.z = sp[66]; o.w = sp[99];
        __builtin_nontemporal_store(o, (GAS v4u*)(it.WT + (size_t)(it.n0 + n) * it.K + it.k0 + 16 * c)); }
    LDS_WAIT(); asm volatile("" ::: "memory");
}
__device__ __forceinline__ void rms_rows2_to_bf16(const float* xrow, const float* g, bf16* orow, float* invr, int lane) {
    const GAS f32x4* xr = (const GAS f32x4*)xrow + lane;
    f32x4 v[2][4]; float s[2] = {0.f, 0.f};
#pragma unroll
    for (int q = 0; q < 2; ++q)
#pragma unroll
        for (int j = 0; j < 4; ++j) v[q][j] = __builtin_nontemporal_load(xr + q * (D / 4) + 64 * j);
#pragma unroll
    for (int q = 0; q < 2; ++q)
#pragma unroll
        for (int j = 0; j < 4; ++j) s[q] += (v[q][j].x * v[q][j].x + v[q][j].y * v[q][j].y) + (v[q][j].z * v[q][j].z + v[q][j].w * v[q][j].w);
    f32x4 gg[4];
#pragma unroll
    for (int j = 0; j < 4; ++j) gg[j] = ((const GAS f32x4*)g)[lane + 64 * j];
#pragma unroll
    for (int q = 0; q < 2; ++q) { const float rt_ = sqrtf(wave_sum(s[q]) * (1.f / D) + RMS_EPS), rstd = 1.f / rt_; if (lane == 0) invr[q] = rt_;
        GAS unsigned long long* o8 = (GAS unsigned long long*)(orow + (size_t)q * D) + lane;
#pragma unroll
        for (int j = 0; j < 4; ++j) o8[64 * j] = (unsigned long long)pk2(v[q][j].x * rstd * gg[j].x, v[q][j].y * rstd * gg[j].y) | ((unsigned long long)pk2(v[q][j].z * rstd * gg[j].z, v[q][j].w * rstd * gg[j].w) << 32); }
}
__device__ __forceinline__ void p0_prologue(Frame& F) {
    LAS float* scr = (LAS float*)(F.lds + RING_OFF + F.wave * 16384);
    const int gw = F.vcu * NWAVES + F.wave, NGW = F.G * NWAVES;
    const float* w_in = F.in[2]; const float* wa = F.in[10]; const float* wb = F.in[11];
    bf16* WIN = (bf16*)(F.ws + WS_WIN); bf16* WA = (bf16*)(F.ws + WS_WA);
    constexpr int I_IN = (D / 64) * (INW / 32), I_A = (512 / 64) * (D / 32);
    constexpr int NITEMS = I_IN + 2 * I_A;
    for (int it = gw; it < NITEMS; it += NGW) {
        int r = it;
        if (r < I_IN) { p0_transpose_item<1>(w_in, D, INW, WIN, nullptr, scr, r, F.lane); continue; } r -= I_IN;
        if (r < I_A) { p0_transpose_item<0>(wa, 512, D, WA, nullptr, scr, r, F.lane, 1024, 0); continue; } r -= I_A;
        p0_transpose_item<0>(wb, 512, D, WA, nullptr, scr, r, F.lane, 1024, 512);
    }
    bf16* XN = (bf16*)(F.ws + WS_XN);
    for (int m = 2 * gw; m < M; m += 2 * NGW) rms_rows2_to_bf16(F.in[0] + (size_t)m * D, F.in[1], XN + (size_t)m * D, (float*)(F.ws + WS_RS0) + m, F.lane);
    const int gt = F.vcu * (NWAVES * 64) + F.tid, NGT = F.G * NWAVES * 64;
    unsigned* rope = (unsigned*)(F.ws + WS_ROPE);
    for (int idx = gt; idx < SEQ * 32; idx += NGT) { const int s = idx >> 5, i = idx & 31; const float ang = (float)s * INV_FREQ[i];
        const double rev = (double)ang * 0.15915494309189535; const double fr = rev - rint(rev);
        rope[idx] = pk2(__builtin_amdgcn_cosf((float)fr), __builtin_amdgcn_sinf((float)fr)); }
    v4u* rwf = (v4u*)(F.ws + WS_RWF);
    for (int idx = gt; idx < 64 * 64; idx += NGT) { const int ks = idx >> 6, ln = idx & 63, e = ln & 31, kb = 16 * ks + 8 * (ln >> 5);
        float v[8]; unsigned h[8], l[8];
#pragma unroll
        for (int j = 0; j < 8; ++j) { v[j] = F.in[13][kb + j] * F.in[14][(size_t)(kb + j) * NE + e]; h[j] = f2bf(v[j]); l[j] = f2bf(v[j] - __uint_as_float(h[j] << 16)); }
        v4u oh, ol; oh.x = h[0] | (h[1] << 16); oh.y = h[2] | (h[3] << 16); oh.z = h[4] | (h[5] << 16); oh.w = h[6] | (h[7] << 16);
        ol.x = l[0] | (l[1] << 16); ol.y = l[2] | (l[3] << 16); ol.z = l[4] | (l[5] << 16); ol.w = l[6] | (l[7] << 16);
        rwf[idx] = oh; rwf[4096 + idx] = ol; }
}

__device__ __forceinline__ Fp8Item moe_item(const float* w1, const float* w2, const float* wo, unsigned char* W1, unsigned char* W2, unsigned char* WO, const float* g, int r) {
    constexpr int I_1 = (D / 128) * (2 * FF / 32), I_2 = (FF / 128) * (D / 32);
    if (r < NE * I_1) { const int e = r / I_1; return fp8_item_make(w1 + (size_t)e * D * 2 * FF, D, 2 * FF, W1 + (size_t)e * 2 * FF * D, g, r % I_1); }
    const int r2 = r - NE * I_1, e = r2 / I_2;
    return fp8_item_make(e < NE ? w2 + (size_t)e * FF * D : wo, FF, D, e < NE ? W2 + (size_t)e * D * FF : WO, nullptr, r2 % I_2);
}
__device__ __forceinline__ void moe_weight_convert(Frame& F, int gw, int NGW, LAS unsigned* scr) {
    constexpr int NIT = NE * ((D / 128) * (2 * FF / 32) + (FF / 128) * (D / 32)) + (FF / 128) * (D / 32);
    const float* w1 = F.in[16]; const float* w2 = F.in[18]; const float* wo = F.in[12]; unsigned char* W1 = F.ws + WS_W1; unsigned char* W2 = F.ws + WS_W2; unsigned char* WO = F.ws + WS_WO; const float* g = F.in[13];
    int ra = gw, rb = gw + NGW;
    if (ra >= NIT) return;
    Fp8Item a = moe_item(w1, w2, wo, W1, W2, WO, g, ra), b = moe_item(w1, w2, wo, W1, W2, WO, g, rb < NIT ? rb : NIT - 1);
    f32x4 va[4][4], vb[4][4], ka[4], kb[4];
    fp8_item_load(a, va, ka, F.lane); fp8_item_load(b, vb, kb, F.lane);
#pragma unroll 1
    for (;;) {
        fp8_item_finish(a, va, ka, SW, scr, F.lane);
        ra += 2 * NGW; const bool more_a = ra < NIT;
        a = moe_item(w1, w2, wo, W1, W2, WO, g, more_a ? ra : NIT - 1); fp8_item_load(a, va, ka, F.lane);
        if (rb < NIT) fp8_item_finish(b, vb, kb, SW, scr, F.lane);
        rb += 2 * NGW; const bool more_b = rb < NIT;
        b = moe_item(w1, w2, wo, W1, W2, WO, g, more_b ? rb : NIT - 1); fp8_item_load(b, vb, kb, F.lane);
        if (!more_a) break;
    }
    asm volatile("s_waitcnt vmcnt(0)" ::: "memory");
}
struct EpiProj {
    static constexpr bool MID = false;
    unsigned char* ws; const float* bias; const unsigned* rope; int noepi;
    __device__ __forceinline__ void operator()(const pg8::f32x4 (&acc)[2][2][4][2], const pg8::Unit& u, int, int wr, int wc, int fr, int fq) const {
        using namespace pg8;
        if (noepi) { asm volatile("s_waitcnt vmcnt(0)" ::: "memory"); return; }
        const int hb0 = 2 * u.pn, m0 = proj_mode(hb0), m1 = proj_mode(hb0 + 1);
        const int dlo = 4 * (4 * (wc & 1) + fq);
        u32x4 cs[2][4];
        if (m0 <= 1 || m1 <= 1) {
#pragma unroll
            for (int ai = 0; ai < 2; ++ai)
#pragma unroll
                for (int m = 0; m < 4; ++m) { const int s = (u.pm * BM + ai * HALF + wr * 64 + m * 16 + fr) & (SEQ - 1);
                    cs[ai][m] = *(const u32x4*)(rope + (size_t)(s * 32 + dlo)); }
        }
        f32x4 bv[2][2];
#pragma unroll
        for (int bj = 0; bj < 2; ++bj) { const int hb = hb0 + bj, mode = bj ? m1 : m0; const float* bp = bias + 128 * hb + (mode <= 1 ? 64 * (wc >> 1) + dlo : wc * 32 + 8 * fq);
            bv[bj][0] = *(const f32x4*)bp; bv[bj][1] = *(const f32x4*)(bp + (mode <= 1 ? 32 : 4)); }
#pragma unroll
        for (int bj = 0; bj < 2; ++bj) {
            const int hb = hb0 + bj, mode = bj ? m1 : m0; size_t off; int ldc, col0; proj_dst(hb, off, ldc, col0);
            bf16_t* dst = (bf16_t*)(ws + off);
            if (mode <= 1) {
                const int hcol = col0 + 64 * (wc >> 1);
                const float sc = mode == 0 ? QSCALE : 1.f;
#pragma unroll
                for (int ai = 0; ai < 2; ++ai)
#pragma unroll
                    for (int m = 0; m < 4; ++m) { const int row = u.pm * BM + ai * HALF + wr * 64 + m * 16 + fr;
                        const u32x4 cw = cs[ai][m];
                        const f32x4 x1 = acc[ai][bj][m][0] + bv[bj][0], x2 = acc[ai][bj][m][1] + bv[bj][1];
                        const f32x4 c = {bf_lo(cw.x), bf_lo(cw.y), bf_lo(cw.z), bf_lo(cw.w)}, sn = {bf_hi(cw.x), bf_hi(cw.y), bf_hi(cw.z), bf_hi(cw.w)};
                        const f32x4 o1 = (x1 * c - x2 * sn) * sc, o2 = (x2 * c + x1 * sn) * sc;
                        bf16_t* rp = dst + (size_t)row * ldc + hcol + dlo;
                        u32x2 w1, w2; w1.x = cvt_pk_bf16(o1[0], o1[1]); w1.y = cvt_pk_bf16(o1[2], o1[3]); w2.x = cvt_pk_bf16(o2[0], o2[1]); w2.y = cvt_pk_bf16(o2[2], o2[3]);
                        *(u32x2*)rp = w1; *(u32x2*)(rp + 32) = w2; }
            } else {
                const int c8 = wc * 32 + 8 * fq;
#pragma unroll
                for (int ai = 0; ai < 2; ++ai)
#pragma unroll
                    for (int m = 0; m < 4; ++m) { const int row = u.pm * BM + ai * HALF + wr * 64 + m * 16 + fr;
                        f32x4 v0 = acc[ai][bj][m][0] + bv[bj][0], v1 = acc[ai][bj][m][1] + bv[bj][1];
                        if (mode == 3) {
                            unsigned w0 = 0u, w1 = 0u;
#pragma unroll
                            for (int j = 0; j < 4; ++j) { w0 |= (unsigned)(int)(sigm(v0[j]) * 255.f + 0.5f) << (8 * j); w1 |= (unsigned)(int)(sigm(v1[j]) * 255.f + 0.5f) << (8 * j); }
                            u32x2 w; w.x = w0; w.y = w1; *(u32x2*)((unsigned char*)dst + (size_t)row * ldc + col0 + c8) = w;
                        } else {
                        u32x4 w; w.x = cvt_pk_bf16(v0[0], v0[1]); w.y = cvt_pk_bf16(v0[2], v0[3]); w.z = cvt_pk_bf16(v1[0], v1[1]); w.w = cvt_pk_bf16(v1[2], v1[3]);
                        *(u32x4*)(dst + (size_t)row * ldc + col0 + c8) = w; } }
            }
        }
    }
};
__device__ __forceinline__ unsigned pk4_fp8(float a, float b, float c, float d) { int w = 0; w = __builtin_amdgcn_cvt_pk_fp8_f32(a, b, w, false); w = __builtin_amdgcn_cvt_pk_fp8_f32(c, d, w, true); return (unsigned)w; }
__device__ __forceinline__ float clamp8(float v) { return __builtin_amdgcn_fmed3f(v, -448.f, 448.f); }
struct EpiGateFused {
    static constexpr bool MID = true;
    unsigned char* T; const unsigned char* sga; const unsigned char* sgb;
    __device__ __forceinline__ void mid(pg8::f32x4 (&acc)[2][2][4][2], const pg8::Unit& u, int wr, int wc, int fr, int fq) const {
        using namespace pg8;
        u32x2 ga[2][4][2], gb[2][4][2];
#pragma unroll
        for (int ai = 0; ai < 2; ++ai)
#pragma unroll
            for (int m = 0; m < 4; ++m)
#pragma unroll
                for (int bj = 0; bj < 2; ++bj) { const size_t o = (size_t)(u.pm * BM + ai * HALF + wr * 64 + m * 16 + fr) * D + u.pn * BM + wc * 32 + 8 * fq + bj * HALF;
                    ga[ai][m][bj] = *(const u32x2*)(sga + o); gb[ai][m][bj] = *(const u32x2*)(sgb + o); }
#pragma unroll
        for (int ai = 0; ai < 2; ++ai)
#pragma unroll
            for (int m = 0; m < 4; ++m)
#pragma unroll
                for (int bj = 0; bj < 2; ++bj)
#pragma unroll
                    for (int n = 0; n < 2; ++n) { const unsigned a = n ? ga[ai][m][bj].y : ga[ai][m][bj].x, b = n ? gb[ai][m][bj].y : gb[ai][m][bj].x; f32x4 r;
#pragma unroll
                        for (int j = 0; j < 4; ++j) { const unsigned bb = (b >> (8 * j)) & 0xffu; r[j] = (float)((a >> (8 * j)) & 0xffu) * __builtin_amdgcn_rcpf((float)(bb ? bb : 1u)); }
                        acc[ai][bj][m][n] = acc[ai][bj][m][n] * r; }
    }
    __device__ __forceinline__ void operator()(const pg8::f32x4 (&acc)[2][2][4][2], const pg8::Unit& u, int, int wr, int wc, int fr, int fq) const {
        using namespace pg8;
        u32x2 gb[2][4][2];
#pragma unroll
        for (int ai = 0; ai < 2; ++ai)
#pragma unroll
            for (int m = 0; m < 4; ++m)
#pragma unroll
                for (int bj = 0; bj < 2; ++bj) gb[ai][m][bj] = *(const u32x2*)(sgb + (size_t)(u.pm * BM + ai * HALF + wr * 64 + m * 16 + fr) * D + u.pn * BM + wc * 32 + 8 * fq + bj * HALF);
#pragma unroll
        for (int ai = 0; ai < 2; ++ai)
#pragma unroll
            for (int m = 0; m < 4; ++m)
#pragma unroll
                for (int bj = 0; bj < 2; ++bj) { const size_t o = (size_t)(u.pm * BM + ai * HALF + wr * 64 + m * 16 + fr) * D + u.pn * BM + wc * 32 + 8 * fq + bj * HALF;
                    const u32x2 g2 = gb[ai][m][bj]; const f32x4 a0 = acc[ai][bj][m][0] * (ST / 255.f), a1 = acc[ai][bj][m][1] * (ST / 255.f);
                    float g[8];
#pragma unroll
                    for (int j = 0; j < 4; ++j) { const unsigned b0 = (g2.x >> (8 * j)) & 0xffu, b1 = (g2.y >> (8 * j)) & 0xffu; g[j] = (float)(b0 ? b0 : 1u); g[4 + j] = (float)(b1 ? b1 : 1u); }
                    u32x2 w; w.x = pk4_fp8(clamp8(a0[0] * g[0]), clamp8(a0[1] * g[1]), clamp8(a0[2] * g[2]), clamp8(a0[3] * g[3])); w.y = pk4_fp8(clamp8(a1[0] * g[4]), clamp8(a1[1] * g[5]), clamp8(a1[2] * g[6]), clamp8(a1[3] * g[7]));
                    *(u32x2*)(T + o) = w; }
    }
};
struct EpiX1 {
    static constexpr bool MID = false;
    const pg8::bf16_t* xn; const float* invr; const float* g0; pg8::bf16_t* x1; unsigned char* x1q;
    __device__ __forceinline__ void operator()(const pg8::f32x4 (&acc)[2][2][4][2], const pg8::Unit& u, int, int wr, int wc, int fr, int fq) const {
        using namespace pg8;
        f32x4 gi[2][2];
#pragma unroll
        for (int bj = 0; bj < 2; ++bj) { const float* gp = g0 + u.pn * BM + wc * 32 + 8 * fq + bj * HALF; gi[bj][0] = *(const f32x4*)gp; gi[bj][1] = *(const f32x4*)(gp + 4); }
#pragma unroll
        for (int ai = 0; ai < 2; ++ai) {
            u32x4 xv[4][2]; float ir[4];
#pragma unroll
            for (int m = 0; m < 4; ++m) { const int row = u.pm * BM + ai * HALF + wr * 64 + m * 16 + fr; ir[m] = invr[row];
#pragma unroll
                for (int bj = 0; bj < 2; ++bj) xv[m][bj] = *(const u32x4*)(xn + (size_t)row * D + u.pn * BM + wc * 32 + 8 * fq + bj * HALF); }
            if (ai == 0) {
#pragma unroll
                for (int bj = 0; bj < 2; ++bj)
#pragma unroll
                    for (int q = 0; q < 2; ++q)
#pragma unroll
                        for (int j = 0; j < 4; ++j) gi[bj][q][j] = __builtin_amdgcn_rcpf(gi[bj][q][j]); }
#pragma unroll
            for (int m = 0; m < 4; ++m)
#pragma unroll
                for (int bj = 0; bj < 2; ++bj) { const size_t o = (size_t)(u.pm * BM + ai * HALF + wr * 64 + m * 16 + fr) * D + u.pn * BM + wc * 32 + 8 * fq + bj * HALF;
                    const u32x4 xw = xv[m][bj]; const float r_ = ir[m];
                    const f32x4 x0 = (f32x4){bf_lo(xw.x), bf_hi(xw.x), bf_lo(xw.y), bf_hi(xw.y)} * gi[bj][0] * r_, x1v = (f32x4){bf_lo(xw.z), bf_hi(xw.z), bf_lo(xw.w), bf_hi(xw.w)} * gi[bj][1] * r_;
                    const f32x4 v0 = x0 + acc[ai][bj][m][0] * (1.f / (ST * SW)), v1 = x1v + acc[ai][bj][m][1] * (1.f / (ST * SW));
                    u32x4 wb; wb.x = cvt_pk_bf16(v0[0], v0[1]); wb.y = cvt_pk_bf16(v0[2], v0[3]); wb.z = cvt_pk_bf16(v1[0], v1[1]); wb.w = cvt_pk_bf16(v1[2], v1[3]);
                    *(u32x4*)(x1 + o) = wb;
                    u32x2 w; w.x = pk4_fp8(clamp8(v0[0] * SX), clamp8(v0[1] * SX), clamp8(v0[2] * SX), clamp8(v0[3] * SX)); w.y = pk4_fp8(clamp8(v1[0] * SX), clamp8(v1[1] * SX), clamp8(v1[2] * SX), clamp8(v1[3] * SX));
                    *(u32x2*)(x1q + o) = w; }
        }
    }
};
template <int NCT, bool GATHER> struct GroupSched {
    const LAS int* sch; const LAS unsigned short* gtab; int G, c;
    __device__ __forceinline__ bool next(int i, pg8::Unit& u) const {
        const int L = i * G + c; if (L >= sch[32] * NCT) return false;
        int e = 0;
#pragma unroll 1
        for (int j = 16; j >= 1; j >>= 1) if (sch[e + j] * NCT <= L) e += j;
        const int local = L - sch[e] * NCT; u.e = e; u.pm = local / NCT; u.pn = local % NCT; u.cnt = sch[64 + e]; return true;
    }
    __device__ __forceinline__ int arow(int ui, const pg8::Unit& u, int r) const { if (GATHER) return (int)gtab[ui * 256 + r]; return (sch[u.e] + u.pm) * 256 + r; }
    __device__ __forceinline__ size_t boff(const pg8::Unit& u, int RB) const {
        if (GATHER) return ((size_t)u.e * 2 * FF + (size_t)u.pn * 128) * RB;
        return ((size_t)u.e * D + (size_t)u.pn * 256) * RB; }
    __device__ __forceinline__ int fetch(int) const { return 0; }
    __device__ __forceinline__ void post(int, int) const {}
};
struct EpiMoe1 {
    static constexpr bool MID = false;
    unsigned char* H; const float* b1; const float* ers; const LAS int* sch; int noepi;
    __device__ __forceinline__ void operator()(const pg8::f32x4 (&acc)[2][2][4][2], const pg8::Unit& u, int, int wr, int wc, int fr, int fq) const {
        using namespace pg8;
        if (noepi) { asm volatile("s_waitcnt vmcnt(0)" ::: "memory"); return; }
        const int j0 = u.pn * 128 + wc * 32 + 8 * fq; const float* bb = b1 + (size_t)u.e * 2 * FF + j0;
        const f32x4 bg0 = *(const f32x4*)bb, bg1 = *(const f32x4*)(bb + 4), bu0 = *(const f32x4*)(bb + FF), bu1 = *(const f32x4*)(bb + FF + 4);
        const int hrow0 = (sch[u.e] + u.pm) * 256;
        float rsv[2][4];
#pragma unroll
        for (int ai = 0; ai < 2; ++ai)
#pragma unroll
            for (int m = 0; m < 4; ++m) { const int slot = u.pm * 256 + ai * HALF + wr * 64 + m * 16 + fr; rsv[ai][m] = ers[(size_t)u.e * M + (slot < u.cnt ? slot : u.cnt - 1)]; }
#pragma unroll
        for (int ai = 0; ai < 2; ++ai)
#pragma unroll
            for (int m = 0; m < 4; ++m) { const int rl = ai * HALF + wr * 64 + m * 16 + fr, slot = u.pm * 256 + rl;
                const float rs = rsv[ai][m] * (1.f / (SX * SW));
                const f32x4 g0 = acc[ai][0][m][0] * rs + bg0, g1 = acc[ai][0][m][1] * rs + bg1, u0 = acc[ai][1][m][0] * rs + bu0, u1 = acc[ai][1][m][1] * rs + bu1;
                f32x4 gg[2] = {g0, g1}, uu[2] = {u0, u1}, rr[2];
#pragma unroll
                for (int q = 0; q < 2; ++q) { f32x4 g = gg[q], t;
#pragma unroll
                    for (int j = 0; j < 4; ++j) { g[j] = fminf(g[j], 7.f); uu[q][j] = __builtin_amdgcn_fmed3f(uu[q][j], -7.f, 7.f); }
                    t = g * (-1.702f * LOG2E);
#pragma unroll
                    for (int j = 0; j < 4; ++j) t[j] = __builtin_amdgcn_exp2f(t[j]);
                    t = t + 1.f;
#pragma unroll
                    for (int j = 0; j < 4; ++j) t[j] = __builtin_amdgcn_rcpf(t[j]);
                    rr[q] = (g * t) * (uu[q] * SH + SH); }
                u32x2 w; w.x = pk4_fp8(rr[0][0], rr[0][1], rr[0][2], rr[0][3]); w.y = pk4_fp8(rr[1][0], rr[1][1], rr[1][2], rr[1][3]);
                *(u32x2*)(H + (size_t)(hrow0 + rl) * FF + j0) = w; }
    }
};
struct EpiMoe2 {
    static constexpr bool MID = false;
    unsigned char* Y; const float* b2; const int* etok; const float* ew; int noepi;
    __device__ __forceinline__ void operator()(const pg8::f32x4 (&acc)[2][2][4][2], const pg8::Unit& u, int, int wr, int wc, int fr, int fq) const {
        using namespace pg8;
        if (noepi) { asm volatile("s_waitcnt vmcnt(0)" ::: "memory"); return; }
        const int c0 = u.pn * 256 + wc * 32 + 8 * fq; const float* bb = b2 + (size_t)u.e * D + c0;
        f32x4 bv[2][2];
#pragma unroll
        for (int bj = 0; bj < 2; ++bj) { bv[bj][0] = *(const f32x4*)(bb + bj * HALF); bv[bj][1] = *(const f32x4*)(bb + bj * HALF + 4); }
        int tkv[2][4]; float wv[2][4];
#pragma unroll
        for (int ai = 0; ai < 2; ++ai)
#pragma unroll
            for (int m = 0; m < 4; ++m) { const int slot = u.pm * 256 + ai * HALF + wr * 64 + m * 16 + fr; const size_t o = (size_t)u.e * M + (slot < u.cnt ? slot : u.cnt - 1);
                const int t_ = etok[o]; tkv[ai][m] = slot < u.cnt ? t_ : M * 4; wv[ai][m] = ew[o]; }
#pragma unroll
        for (int ai = 0; ai < 2; ++ai)
#pragma unroll
            for (int m = 0; m < 4; ++m) { const int slot = u.pm * 256 + ai * HALF + wr * 64 + m * 16 + fr;
                const int tk = tkv[ai][m]; const float w8 = wv[ai][m]; (void)slot;
                {
#pragma unroll
                    for (int bj = 0; bj < 2; ++bj) { const f32x4 v0 = (acc[ai][bj][m][0] * (1.f / (SH * SW)) + bv[bj][0]) * (w8 * SY), v1 = (acc[ai][bj][m][1] * (1.f / (SH * SW)) + bv[bj][1]) * (w8 * SY);
                        u32x2 w; w.x = pk4_fp8(clamp8(v0[0]), clamp8(v0[1]), clamp8(v0[2]), clamp8(v0[3])); w.y = pk4_fp8(clamp8(v1[0]), clamp8(v1[1]), clamp8(v1[2]), clamp8(v1[3]));
                        *(u32x2*)(Y + (size_t)tk * D + c0 + bj * HALF) = w; } } }
    }
};

__device__ __forceinline__ void attn_phase_all(Frame& F, char* lds) {
    typedef attn_body::bf16 abf; using attn_body::attn_unit; using attn_body::attn_unit128;
    const int v = F.vcu;
    const abf* QA = (const abf*)(F.ws + WS_QA); const abf* KA = (const abf*)(F.ws + WS_KA); const abf* VA = (const abf*)(F.ws + WS_VA); abf* OS = (abf*)(F.ws + WS_OSWA);
    const abf* QB_ = (const abf*)(F.ws + WS_QB); const abf* KB = (const abf*)(F.ws + WS_KB); const abf* VB = (const abf*)(F.ws + WS_VB); abf* OD = (abf*)(F.ws + WS_OSWA) + 512;
    float lam; { const float p1 = F.in[5][F.lane] * F.in[6][F.lane], p2 = F.in[7][F.lane] * F.in[8][F.lane]; lam = __expf(wave_sum(p1)) - __expf(wave_sum(p2)) + 0.2f; }
    { const int vv = v;
        { const int bh = vv >> 3, h = bh & 3, b = bh >> 2, s = vv & 7;
#pragma unroll 1
          for (int i = 0; i < 4; ++i) { const int qb = (i >> 1) ? 15 - s : s, c = i & 1;
              attn_unit128<8>((long)b * SEQ, qb * 256, QB_ + (2 * h + c) * 64, KB + (2 * h + c) * 64, VB + h * 128, OD + h * 128, c != 0, lam, F.in[9], lds); } }
        {
#pragma unroll 1
          for (int i = 0; i < 4; ++i) { const int un = 4 * vv + i, qb = un & 31, pj = (un >> 5) & 3, b = un >> 7, hq = 2 * pj;
              attn_unit<1, 128, 128, 8>((long)b * SEQ, qb * 128, QA + hq * 64, KA + (hq >> 2) * 64, VA + (hq >> 2) * 64, OS + hq * 64, F.in[4][hq] * LOG2E, F.in[4][hq + 1] * LOG2E, lds); } }
    }
}

struct Args { const float* in[21]; float* out; unsigned char* ws; int ph_lo, ph_hi, noepi, pad; };
constexpr int N_PHASES = 10;
__global__ void __launch_bounds__(NWAVES * 64, 2) mk_fwd(Args args) {
    extern __shared__ __attribute__((aligned(16))) unsigned char lds[];
    Frame F;
    F.lds = (LAS unsigned char*)lds;
    F.MISC = (volatile LAS unsigned*)(F.lds + MISC_OFF);
    F.tid = threadIdx.x; F.lane = F.tid & 63; F.wave = __builtin_amdgcn_readfirstlane(F.tid >> 6);
    F.G = gridDim.x; { const int bx = blockIdx.x; F.vcu = (F.G % 8 == 0) ? (bx % 8) * (F.G / 8) + bx / 8 : bx; }
    F.ws = args.ws; F.ctl = (gu32*)(args.ws + WS_CTL); F.out = args.out;
#pragma unroll
    for (int i = 0; i < 21; ++i) F.in[i] = args.in[i];
    for (int u = F.tid; u < (LDS_BYTES - LDSCTL_OFF) / 4; u += NWAVES * 64) ((LAS unsigned*)(F.lds + LDSCTL_OFF))[u] = 0u;
    __syncthreads();
    const bool one = (args.ph_hi - args.ph_lo) > 1;
    XcdBarrier bar; bar.bar = (unsigned*)(F.ctl + CW_BAR); bar.x = 0; bar.st = nullptr;
    if (one) bar = xcd_barrier_post((unsigned*)(F.ctl + CW_BAR), F.MISC + 8);
    const int lo = args.ph_lo, hi = args.ph_hi;
#define IN(k) (lo <= (k) && (k) < hi)
#define SEAM(k) do { if (IN(k) && IN((k) + 1)) xcd_barrier(bar); } while (0)
    unsigned char* ws = F.ws;
    const LAS int* sch = (const LAS int*)(F.lds + SCHED_OFF);

    if (IN(0)) { p0_prologue(F); }
    SEAM(0);
    if (IN(1)) {
        pg8::Gemm g{ws + WS_XN, ws + WS_WIN, D * 2, (size_t)pg8::HALF * D * 2};
        if ((int)blockIdx.x < NCONV) { moe_weight_convert(F, (int)blockIdx.x * NWAVES + F.wave, NCONV * NWAVES, (LAS unsigned*)(F.lds + RING_OFF + F.wave * 16384)); __syncthreads(); }
        pg8::QueueOrder S; S.init(M, INW, (unsigned*)(F.ctl + CW_Q1), (volatile LAS int*)(F.MISC + 16), (int)(blockIdx.x & 7)); S.prime();
        EpiProj E{ws, F.in[3], (const unsigned*)(ws + WS_ROPE), args.noepi};
        pg8::gemm_phase<false>(F.lds + RING_OFF, g, S, E);
    }
    SEAM(1);
    if (IN(2)) { attn_phase_all(F, (char*)lds + RING_OFF); }
    SEAM(2);
    if (IN(4)) {
        pg8::StaticOrder S; S.init(M, D, F.G, (int)blockIdx.x);
        pg8::Gemm g{ws + WS_OSWA, ws + WS_WA, D * 2, (size_t)pg8::HALF * D * 2};
        EpiGateFused E{ws + WS_T, ws + WS_SGA, ws + WS_SGB};
        pg8::gemm_phase<false>(F.lds + RING_OFF, g, S, E);
    }
    SEAM(4);
    if (IN(5)) {
        pg8::Gemm g{ws + WS_T, ws + WS_WO, D, (size_t)pg8::HALF * D};
        pg8::StaticOrder S; S.init(M, D, F.G, (int)blockIdx.x);
        EpiX1 E{(const pg8::bf16_t*)(ws + WS_XN), (const float*)(ws + WS_RS0), F.in[1], (pg8::bf16_t*)(ws + WS_X1B), ws + WS_X1Q};
        pg8::gemm_phase<true>(F.lds + RING_OFF, g, S, E);
    }
    SEAM(5);
    if (IN(6)) {
        typedef float f32x16 __attribute__((ext_vector_type(16)));
        const int lane = F.lane, r32 = lane & 31, hi = lane >> 5;
        LAS int* wcnt = (LAS int*)(F.lds + RING_OFF);
        const int n_it = (M / 32) / (F.G * 4);
        for (int it = 0; it < n_it; ++it) {
            const int tile = (it * F.G + F.vcu) * 4 + (F.wave & 3), tok = tile * 32 + r32;
            int ti[4] = {0, 0, 0, 0}; float ex[4] = {0.f, 0.f, 0.f, 0.f}; float isum = 0.f, rstd = 0.f; int run0 = 0, run1 = 0, run2 = 0, run3 = 0;
            if (F.wave < 4) {
                const v4u* rwf = (const v4u*)(ws + WS_RWF);
                const pg8::bf16_t* xr = (const pg8::bf16_t*)(ws + WS_X1B) + (size_t)tok * D + 8 * hi;
                f32x16 acc = {}; float ss = 0.f;
#pragma unroll 8
                for (int ks = 0; ks < 64; ++ks) {
                    const v4u bh = *(const v4u*)(xr + 16 * ks);
                    ss += pg8::bf_lo(bh.x) * pg8::bf_lo(bh.x) + pg8::bf_hi(bh.x) * pg8::bf_hi(bh.x) + pg8::bf_lo(bh.y) * pg8::bf_lo(bh.y) + pg8::bf_hi(bh.y) * pg8::bf_hi(bh.y)
                        + pg8::bf_lo(bh.z) * pg8::bf_lo(bh.z) + pg8::bf_hi(bh.z) * pg8::bf_hi(bh.z) + pg8::bf_lo(bh.w) * pg8::bf_lo(bh.w) + pg8::bf_hi(bh.w) * pg8::bf_hi(bh.w);
                    const v4u ah = rwf[ks * 64 + lane], al = rwf[4096 + ks * 64 + lane];
                    acc = __builtin_amdgcn_mfma_f32_32x32x16_bf16(__builtin_bit_cast(bf16x8, ah), __builtin_bit_cast(bf16x8, bh), acc, 0, 0, 0);
                    acc = __builtin_amdgcn_mfma_f32_32x32x16_bf16(__builtin_bit_cast(bf16x8, al), __builtin_bit_cast(bf16x8, bh), acc, 0, 0, 0);
                }
                ss += __shfl_xor(ss, 32);
                rstd = 1.f / sqrtf(ss * (1.f / D) + RMS_EPS);
                float lg[32];
#pragma unroll
                for (int e = 0; e < 32; ++e) { const int he = (e >> 2) & 1, r = (e & 3) + 4 * (e >> 3); const float own = acc[r], oth = __shfl_xor(own, 32);
                    lg[e] = ((he == hi) ? own : oth) * rstd + F.in[15][e]; }
                float tv[4];
#pragma unroll
                for (int k = 0; k < 4; ++k) { float best = -3.0e38f; int bi = 0;
#pragma unroll
                    for (int e = 0; e < 32; ++e) { if (lg[e] > best) { best = lg[e]; bi = e; } }
                    tv[k] = best; ti[k] = bi;
#pragma unroll
                    for (int e = 0; e < 32; ++e) if (e == bi) lg[e] = -3.0e38f; }
                float sum = 0.f;
#pragma unroll
                for (int k = 0; k < 4; ++k) { ex[k] = __builtin_amdgcn_exp2f((tv[k] - tv[0]) * LOG2E); sum += ex[k]; }
                isum = 1.f / sum;
                const unsigned long long lt = (1ull << lane) - 1ull;
                int myc = 0;
#pragma unroll 1
                for (int e = 0; e < 32; ++e) {
                    const unsigned long long m0 = __ballot(hi == 0 && ti[0] == e), m1 = __ballot(hi == 0 && ti[1] == e), m2 = __ballot(hi == 0 && ti[2] == e), m3 = __ballot(hi == 0 && ti[3] == e);
                    const int c0 = __popcll(m0), c1 = __popcll(m1), c2 = __popcll(m2), c3 = __popcll(m3);
                    if (lane == e) myc = c0 + c1 + c2 + c3;
                    if (ti[0] == e) run0 = __popcll(m0 & lt);
                    if (ti[1] == e) run1 = c0 + __popcll(m1 & lt);
                    if (ti[2] == e) run2 = c0 + c1 + __popcll(m2 & lt);
                    if (ti[3] == e) run3 = c0 + c1 + c2 + __popcll(m3 & lt);
                }
                if (lane < 32) wcnt[F.wave * 32 + lane] = myc;
            }
            __syncthreads();
            if (F.wave == 0 && lane < 32) {
                const int c0 = wcnt[lane], c1 = wcnt[32 + lane], c2 = wcnt[64 + lane], c3 = wcnt[96 + lane], tot = c0 + c1 + c2 + c3;
                int base = 0; if (tot > 0) base = (int)__hip_atomic_fetch_add((unsigned*)(F.ctl + CW_CNT + 64 * lane), (unsigned)tot, RLX_AGENT);
                wcnt[128 + lane] = base; wcnt[160 + lane] = base + c0; wcnt[192 + lane] = base + c0 + c1; wcnt[224 + lane] = base + c0 + c1 + c2;
            }
            __syncthreads();
            if (F.wave < 4 && hi == 0) {
                int* etok = (int*)(ws + WS_ETOK); float* ew = (float*)(ws + WS_EW); float* ers = (float*)(ws + WS_ERS);
                const int pos[4] = {wcnt[128 + F.wave * 32 + ti[0]] + run0, wcnt[128 + F.wave * 32 + ti[1]] + run1, wcnt[128 + F.wave * 32 + ti[2]] + run2, wcnt[128 + F.wave * 32 + ti[3]] + run3};
#pragma unroll
                for (int k = 0; k < 4; ++k) { const size_t o = (size_t)ti[k] * M + pos[k];
                    etok[o] = tok * 4 + k; ew[o] = ex[k] * isum; ers[o] = rstd; }
            }
            __syncthreads();
        }
    }
    SEAM(6);
    if (IN(7) || IN(8)) {
        if (F.tid < 32) { ((LAS int*)sch)[64 + F.tid] = (int)__hip_atomic_load((unsigned*)(F.ctl + CW_CNT + 64 * F.tid), RLX_AGENT); }
        __syncthreads();
        if (F.tid == 0) { int a = 0; for (int e = 0; e < 32; ++e) { ((LAS int*)sch)[e] = a; a += (sch[64 + e] + 255) >> 8; } ((LAS int*)sch)[32] = a; }
        __syncthreads();
    }
    if (IN(7)) {
        const LAS unsigned short* gtab = (const LAS unsigned short*)(F.lds + GTAB_OFF);
        GroupSched<8, true> S{sch, gtab, F.G, F.vcu};
        { const int* etok = (const int*)(ws + WS_ETOK);
          int idx[17];
#pragma unroll
          for (int i = 0; i < 17; ++i) { pg8::Unit u; idx[i] = 0;
              if (S.next(i, u) && F.tid < 256) { const int slot = u.pm * 256 + F.tid; if (slot < u.cnt) idx[i] = etok[(size_t)u.e * M + slot] >> 2; } }
          if (F.tid < 256) {
#pragma unroll
              for (int i = 0; i < 17; ++i) ((LAS unsigned short*)gtab)[i * 256 + F.tid] = (unsigned short)idx[i]; } }
        VM_WAIT(); __syncthreads();
        pg8::Gemm g{ws + WS_X1Q, ws + WS_W1, D, (size_t)FF * D};
        EpiMoe1 E{ws + WS_H, F.in[17], (const float*)(ws + WS_ERS), sch, args.noepi};
        pg8::gemm_phase<true>(F.lds + RING_OFF, g, S, E);
    }
    SEAM(7);
    if (IN(8)) {
        GroupSched<4, false> S{sch, nullptr, F.G, F.vcu};
        pg8::Gemm g{ws + WS_H, ws + WS_W2, FF, (size_t)pg8::HALF * FF};
        EpiMoe2 E{ws + WS_Y, F.in[19], (const int*)(ws + WS_ETOK), (const float*)(ws + WS_EW), args.noepi};
        pg8::gemm_phase<true>(F.lds + RING_OFF, g, S, E);
    }
    SEAM(8);
    if (IN(9)) {
        unsigned poison = (__hip_atomic_load(F.ctl + CW_TMO, RLX_AGENT) != 0u) | (__hip_atomic_load((gu32*)((const unsigned*)(F.ctl + CW_BAR) + XB_TMO), RLX_AGENT) != 0u);
        const unsigned char* Y = ws + WS_Y; typedef float f32x2_ __attribute__((ext_vector_type(2)));
        const int gw = F.vcu * NWAVES + F.wave, NGW = F.G * NWAVES;
        f32x4 gfin[2][2];
#pragma unroll
        for (int j = 0; j < 2; ++j) { gfin[j][0] = *(const f32x4*)(F.in[20] + 8 * F.lane + 512 * j); gfin[j][1] = *(const f32x4*)(F.in[20] + 8 * F.lane + 512 * j + 4); }
        for (int m0 = 2 * gw; m0 < M; m0 += 2 * NGW) {
            v4u xa[2][2]; pg8::u32x2 yv[2][2][4];
#pragma unroll
            for (int q = 0; q < 2; ++q)
#pragma unroll
                for (int j = 0; j < 2; ++j) { const size_t c0 = 8 * F.lane + 512 * j; xa[q][j] = __builtin_nontemporal_load((const v4u*)((const pg8::bf16_t*)(ws + WS_X1B) + (size_t)(m0 + q) * D + c0));
#pragma unroll
                    for (int k = 0; k < 4; ++k) yv[q][j][k] = __builtin_nontemporal_load((const pg8::u32x2*)(Y + ((size_t)(m0 + q) * 4 + k) * D + c0)); }
#pragma unroll
            for (int q = 0; q < 2; ++q) { const int m = m0 + q;
                float v[2][8]; float ss = 0.f;
#pragma unroll
                for (int j = 0; j < 2; ++j) { const v4u a = xa[q][j];
                    v[j][0] = pg8::bf_lo(a.x); v[j][1] = pg8::bf_hi(a.x); v[j][2] = pg8::bf_lo(a.y); v[j][3] = pg8::bf_hi(a.y); v[j][4] = pg8::bf_lo(a.z); v[j][5] = pg8::bf_hi(a.z); v[j][6] = pg8::bf_lo(a.w); v[j][7] = pg8::bf_hi(a.w);
#pragma unroll
                    for (int k = 0; k < 4; ++k) { const pg8::u32x2 y = yv[q][j][k]; const f32x2_ a0 = __builtin_amdgcn_cvt_pk_f32_fp8((int)y.x, false), a1 = __builtin_amdgcn_cvt_pk_f32_fp8((int)y.x, true), a2 = __builtin_amdgcn_cvt_pk_f32_fp8((int)y.y, false), a3 = __builtin_amdgcn_cvt_pk_f32_fp8((int)y.y, true);
                        v[j][0] += a0.x * (1.f / SY); v[j][1] += a0.y * (1.f / SY); v[j][2] += a1.x * (1.f / SY); v[j][3] += a1.y * (1.f / SY); v[j][4] += a2.x * (1.f / SY); v[j][5] += a2.y * (1.f / SY); v[j][6] += a3.x * (1.f / SY); v[j][7] += a3.y * (1.f / SY); }
#pragma unroll
                    for (int t = 0; t < 8; ++t) ss += v[j][t] * v[j][t]; }
                float rstd = 1.f / sqrtf(wave_sum(ss) * (1.f / D) + RMS_EPS);
                if (poison) rstd = __builtin_nanf("");
#pragma unroll
                for (int j = 0; j < 2; ++j) { const size_t c0 = 8 * F.lane + 512 * j; const f32x4 g0 = gfin[j][0], g1 = gfin[j][1];
                    *(f32x4*)(F.out + (size_t)m * D + c0) = (f32x4){v[j][0] * rstd * g0[0], v[j][1] * rstd * g0[1], v[j][2] * rstd * g0[2], v[j][3] * rstd * g0[3]};
                    *(f32x4*)(F.out + (size_t)m * D + c0 + 4) = (f32x4){v[j][4] * rstd * g1[0], v[j][5] * rstd * g1[1], v[j][6] * rstd * g1[2], v[j][7] * rstd * g1[3]}; } }
        }
    }
#undef IN
#undef SEAM
}

#ifndef MK_REP
#define MK_REP -1
#endif
#ifndef MK_NOEPI
#define MK_NOEPI 0
#endif
#ifndef MK_CUTS
#define MK_CUTS 1
#endif
extern "C" void kernel_launch(void* const* d_in, const int* in_sizes, int n_in, void* d_out, int out_size, void* d_ws, size_t ws_size, hipStream_t stream) {
    static int grid = 0;
    if (grid == 0) {
        if (n_in != 21 || in_sizes[0] != M * D || out_size != M * D || ws_size < WS_END) { fprintf(stderr, "kernel_launch: unexpected shapes / workspace (n_in %d, ws %zu)\n", n_in, ws_size); grid = -1; return; }
        int dev = 0, cus = 0, per_cu = 0;
        if (hipGetDevice(&dev) != hipSuccess || hipDeviceGetAttribute(&cus, hipDeviceAttributeMultiprocessorCount, dev) != hipSuccess) { grid = -1; return; }
        if (hipFuncSetAttribute((const void*)mk_fwd, hipFuncAttributeMaxDynamicSharedMemorySize, LDS_BYTES) != hipSuccess) { fprintf(stderr, "kernel_launch: hipFuncSetAttribute failed\n"); grid = -1; return; }
        if (hipOccupancyMaxActiveBlocksPerMultiprocessor(&per_cu, (const void*)mk_fwd, NWAVES * 64, LDS_BYTES) != hipSuccess || per_cu < 1) { fprintf(stderr, "kernel_launch: occupancy query says %d\n", per_cu); }
        (void)hipGetLastError();
        grid = cus;
    }
    if (grid < 0) return;
    if (hipMemsetAsync((char*)d_ws + WS_CTL, 0, CTL_ZERO_BYTES, stream) != hipSuccess) return;
    Args a{};
    for (int i = 0; i < 21; ++i) a.in[i] = (const float*)d_in[i];
    a.out = (float*)d_out; a.ws = (unsigned char*)d_ws;
    if (MK_CUTS == 1) { a.ph_lo = 0; a.ph_hi = N_PHASES; hipLaunchKernelGGL(mk_fwd, dim3(grid), dim3(NWAVES * 64), LDS_BYTES, stream, a); }
    else for (int p = 0; p < N_PHASES; ++p) { a.ph_lo = p; a.ph_hi = p + 1; hipLaunchKernelGGL(mk_fwd, dim3(grid), dim3(NWAVES * 64), LDS_BYTES, stream, a);
        if (p == MK_REP) { if (p == 6) (void)hipMemsetAsync((char*)d_ws + WS_CTL, 0, CTL_ZERO_BYTES, stream); a.noepi = MK_NOEPI; hipLaunchKernelGGL(mk_fwd, dim3(grid), dim3(NWAVES * 64), LDS_BYTES, stream, a); a.noepi = 0; } }
}
```

```cpp
#include <hip/hip_runtime.h>
#include <hip/hip_bf16.h>
#include <cstdio>
#include <cstdint>
#include <cmath>
namespace pg8 {
#define PG8_LAS __attribute__((address_space(3)))
typedef unsigned short bf16_t;
typedef short bf16x8 __attribute__((ext_vector_type(8)));
typedef float f32x4 __attribute__((ext_vector_type(4)));
typedef float f32x2 __attribute__((ext_vector_type(2)));
typedef unsigned u32x4 __attribute__((ext_vector_type(4)));
typedef unsigned u32x2 __attribute__((ext_vector_type(2)));
typedef int v8i __attribute__((ext_vector_type(8)));
typedef int v4i __attribute__((ext_vector_type(4)));
constexpr int BM = 256, BK = 64, HALF = 128, HTB = HALF * BK * 2  , STAGE_BYTES = 8 * HTB, NXCD = 8, WGM = 8;

__host__ __device__ __forceinline__ int lds_byte(int r, int c) { const int st = (r >> 4) * 2 + (c >> 5), rr = r & 15, cc = c & 31, ob = rr * 64 + cc * 2; return st * 1024 + (ob ^ (((ob >> 9) & 1) << 5)); }
__host__ __device__ __forceinline__ void stage_rc(int b, int& R, int& C) { const int st = b / 1024, sb = b % 1024, swz = sb ^ (((sb >> 9) & 1) << 5); R = (st >> 1) * 16 + swz / 64; C = (st & 1) * 32 + (swz % 64) / 2; }
__host__ __device__ __forceinline__ int perm32(int rho) { const int n = rho >> 4, i = rho & 15; return 8 * (i >> 2) + 4 * n + (i & 3); }

struct Unit { int pm, pn, e, cnt; };
struct Gemm { const void* A; const void* Bt; int RB; size_t hstepB; };

struct StaticOrder {
    int nM, nN, nwg, G, c;
    __device__ void init(int M, int N, int G_, int c_) { nM = M / BM; nN = N / BM; nwg = nM * nN; G = G_; c = c_; }
    __device__ bool next(int i, Unit& u) const {
        const long L = (long)i * G + c; if (L >= nwg) return false;
        int wgid = (int)L; { const int q = nwg / NXCD, r = nwg % NXCD, xcd = wgid % NXCD, off = wgid / NXCD; wgid = (xcd < r ? xcd * (q + 1) : r * (q + 1) + (xcd - r) * q) + off; }
        const int nig = WGM * nN, gid = wgid / nig, fm = gid * WGM, gsz = (nM - fm) < WGM ? (nM - fm) : WGM;
        u.pm = fm + ((wgid % nig) % gsz); u.pn = (wgid % nig) / gsz; u.e = 0; u.cnt = 0; return true;
    }
    __device__ __forceinline__ int arow(int, const Unit& u, int r) const { return u.pm * BM + r; }
    __device__ __forceinline__ size_t boff(const Unit& u, int RB) const { return (size_t)u.pn * BM * RB; }
    __device__ __forceinline__ int fetch(int) const { return 0; }
    __device__ __forceinline__ void post(int, int) const {}
};
struct QueueOrder {
    int nM, nN, nwg; unsigned* ctr; volatile PG8_LAS int* mail;
    __device__ void init(int M, int N, unsigned* ctr_, volatile PG8_LAS int* mail_, int x_) { nM = M / BM; nN = N / BM; nwg = nM * nN; ctr = ctr_ + 64 * x_; mail = mail_; }
    __device__ void prime() const {
        if (threadIdx.x == 0) { const int t0_ = (int)__hip_atomic_fetch_add(ctr, 3u, __ATOMIC_RELAXED, __HIP_MEMORY_SCOPE_AGENT);
            for (int k = 0; k < 3; ++k) mail[k] = (int)(blockIdx.x & 7) + NXCD * (t0_ + k); }
        __syncthreads();
    }
    __device__ bool next(int i, Unit& u) const {
        const int L = __builtin_amdgcn_readfirstlane(mail[i & 3]); if (L >= nwg) return false;
        int wgid = L; { const int q = nwg / NXCD, r = nwg % NXCD, xcd = wgid % NXCD, off = wgid / NXCD; wgid = (xcd < r ? xcd * (q + 1) : r * (q + 1) + (xcd - r) * q) + off; }
        const int nig = WGM * nN, gid = wgid / nig, fm = gid * WGM, gsz = (nM - fm) < WGM ? (nM - fm) : WGM;
        u.pm = fm + ((wgid % nig) % gsz); u.pn = (wgid % nig) / gsz; u.e = 0; u.cnt = 0; return true;
    }
    __device__ __forceinline__ int arow(int, const Unit& u, int r) const { return u.pm * BM + r; }
    __device__ __forceinline__ size_t boff(const Unit& u, int RB) const { return (size_t)u.pn * BM * RB; }
    __device__ __forceinline__ int fetch(int) const { int v = 0; if (threadIdx.x == 0) v = (int)(blockIdx.x & 7) + NXCD * (int)__hip_atomic_fetch_add(ctr, 1u, __ATOMIC_RELAXED, __HIP_MEMORY_SCOPE_AGENT); return v; }
    __device__ __forceinline__ void post(int ui, int v) const { if (threadIdx.x == 0) mail[(ui + 3) & 3] = v; }
};

__device__ __forceinline__ unsigned cvt_pk_bf16(float lo, float hi) { unsigned r; asm volatile("v_cvt_pk_bf16_f32 %0, %1, %2" : "=v"(r) : "v"(lo), "v"(hi)); return r; }
__device__ __forceinline__ float bf_lo(unsigned w) { return __uint_as_float(w << 16); }
__device__ __forceinline__ float bf_hi(unsigned w) { return __uint_as_float(w & 0xffff0000u); }
__device__ __forceinline__ float sigm(float x) { return __builtin_amdgcn_rcpf(1.f + __builtin_amdgcn_exp2f(-1.4426950408889634f * x)); }

template <bool FP8, class Epi, class Sched>
__device__ __forceinline__ void gemm_phase(PG8_LAS unsigned char* lds, const Gemm g, const Sched& S, const Epi& E) {
    int tid = threadIdx.x; asm volatile("" : "+v"(tid));
    const int wid = __builtin_amdgcn_readfirstlane(tid >> 6), lane = tid & 63, wr = wid >> 2, wc = wid & 3, fr = lane & 15, fq = lane >> 4;
    const int RB = g.RB, nt = RB / (BK * 2);
    unsigned voffB[2];
#pragma unroll
    for (int i = 0; i < 2; ++i) { int R, C; stage_rc(tid * 16 + i * 8192, R, C); const int Rb = (R & ~31) + perm32(R & 31); voffB[i] = (unsigned)(Rb * RB + C * 2); }
    const size_t kstep = (size_t)(BK * 2);
    const size_t hstepB = g.hstepB;
    const unsigned ldsw = (unsigned)wid * 1024u;
    const int aoff = lds_byte(wr * 64 + fr, fq * 8), boff = lds_byte(wc * 32 + fr, fq * 8);
    constexpr int POFF = 1024;
#define PG8_SA(b, h) (((b) * 2 + (h)) * HTB)
#define PG8_SB(b, h) ((4 + (b) * 2 + (h)) * HTB)
#define PG8_STAGE(bufoff, gbase, voff) do { const char* gb_ = (const char*)(gbase); asm volatile("" : "+s"(gb_));     \
        _Pragma("unroll") for (int _i = 0; _i < 2; ++_i) { unsigned vo_ = (voff)[_i]; asm volatile("" : "+v"(vo_)); \
        __builtin_amdgcn_global_load_lds((const unsigned*)(gb_ + vo_), (PG8_LAS unsigned*)(lds + (bufoff) + ldsw + _i * 8192), 16, 0, 0); } } while (0)
#define PG8_LDA(dst, b, h) do { _Pragma("unroll") for (int m = 0; m < 4; ++m) { const v4i lo_ = *(const PG8_LAS v4i*)(lds + PG8_SA(b, h) + aoff + m * 2048), hi_ = *(const PG8_LAS v4i*)(lds + PG8_SA(b, h) + aoff + m * 2048 + POFF); \
        dst[m] = __builtin_shufflevector(lo_, hi_, 0, 1, 2, 3, 4, 5, 6, 7); } } while (0)
#define PG8_LDB(dst, b, h) do { _Pragma("unroll") for (int n = 0; n < 2; ++n) { const v4i lo_ = *(const PG8_LAS v4i*)(lds + PG8_SB(b, h) + boff + n * 2048), hi_ = *(const PG8_LAS v4i*)(lds + PG8_SB(b, h) + boff + n * 2048 + POFF); \
        dst[n] = __builtin_shufflevector(lo_, hi_, 0, 1, 2, 3, 4, 5, 6, 7); } } while (0)
#define PG8_MMA(ai, bj, At, Bt) do { __builtin_amdgcn_s_setprio(1); _Pragma("unroll") for (int m = 0; m < 4; ++m) _Pragma("unroll") for (int n = 0; n < 2; ++n) { \
        if constexpr (FP8) asm volatile("v_mfma_f32_16x16x128_f8f6f4 %0, %1, %2, %0" : "+v"(acc[ai][bj][m][n]) : "v"(Bt[n]), "v"(At[m]));     \
        else { acc[ai][bj][m][n] = __builtin_amdgcn_mfma_f32_16x16x32_bf16(__builtin_bit_cast(bf16x8, __builtin_shufflevector(Bt[n], Bt[n], 0, 1, 2, 3)), __builtin_bit_cast(bf16x8, __builtin_shufflevector(At[m], At[m], 0, 1, 2, 3)), acc[ai][bj][m][n], 0, 0, 0); \
               acc[ai][bj][m][n] = __builtin_amdgcn_mfma_f32_16x16x32_bf16(__builtin_bit_cast(bf16x8, __builtin_shufflevector(Bt[n], Bt[n], 4, 5, 6, 7)), __builtin_bit_cast(bf16x8, __builtin_shufflevector(At[m], At[m], 4, 5, 6, 7)), acc[ai][bj][m][n], 0, 0, 0); } } \
        __builtin_amdgcn_s_setprio(0); } while (0)
#define PG8_WAIT_V(n) asm volatile("s_waitcnt vmcnt(" #n ")" ::: "memory")
#define PG8_WAIT_L(n) asm volatile("s_waitcnt lgkmcnt(" #n ")" ::: "memory")
#define PG8_BAR __builtin_amdgcn_s_barrier()
#define PG8_SCHED __builtin_amdgcn_sched_barrier(0)
#define PG8_OA(dst, ui_, u_) do { int t_ = threadIdx.x; asm volatile("" : "+v"(t_)); _Pragma("unroll") for (int _i = 0; _i < 2; ++_i) { int R_, C_; stage_rc(t_ * 16 + _i * 8192, R_, C_); \
        _Pragma("unroll") for (int _h = 0; _h < 2; ++_h) dst[_h][_i] = (unsigned)S.arow(ui_, u_, _h * HALF + R_) * (unsigned)RB + (unsigned)C_ * 2u; } } while (0)
    Unit cur, nxt; int ui = 0;
    if (!S.next(0, cur)) return;
    f32x4 acc[2][2][4][2];
#pragma unroll
    for (int a = 0; a < 2; ++a)
#pragma unroll
        for (int b = 0; b < 2; ++b)
#pragma unroll
            for (int m = 0; m < 4; ++m)
#pragma unroll
                for (int n = 0; n < 2; ++n) acc[a][b][m][n] = (f32x4){0.f, 0.f, 0.f, 0.f};
    v8i At[4], B0[2], B1[2];
    unsigned oaC[2][2];
    PG8_OA(oaC, 0, cur);
    const char* const gA = (const char*)g.A;
    const char* cB = (const char*)g.Bt + S.boff(cur, RB);
    PG8_STAGE(PG8_SB(0, 0), cB, voffB); PG8_STAGE(PG8_SB(0, 1), cB + hstepB, voffB); PG8_STAGE(PG8_SA(0, 0), gA, oaC[0]); PG8_STAGE(PG8_SA(0, 1), gA, oaC[1]);
    if (wr == 1) PG8_BAR;
    PG8_WAIT_V(2); PG8_BAR;
    PG8_STAGE(PG8_SB(1, 0), cB + kstep, voffB); PG8_STAGE(PG8_SA(1, 0), gA + kstep, oaC[0]); PG8_STAGE(PG8_SB(1, 1), cB + hstepB + kstep, voffB);
    PG8_WAIT_V(6); PG8_BAR;
    for (;;) {
        const bool has_next = S.next(ui + 1, nxt);
        const char* nB = has_next ? (const char*)g.Bt + S.boff(nxt, RB) : cB;
        for (int t = 0; t < nt; t += 2) {
            const bool last = (t == nt - 2);
            const bool first = (t == 0) && (ui > 0);
            if constexpr (Epi::MID) { if (t == nt / 2) { int fr_ = fr, fq_ = fq; asm volatile("" : "+v"(fr_), "+v"(fq_)); E.mid(acc, cur, wr, wc, fr_, fq_); } }
            const char* a1 = gA + (size_t)(t + 1) * kstep;
            const char* a2 = last ? gA : gA + (size_t)(t + 2) * kstep; const char* b2 = last ? nB : cB + (size_t)(t + 2) * kstep;
            const char* a3 = a2 + kstep; const char* b3 = b2 + kstep;
            unsigned o2[2][2];
#pragma unroll
            for (int h = 0; h < 2; ++h)
#pragma unroll
                for (int i = 0; i < 2; ++i) o2[h][i] = oaC[h][i];
            if (last && has_next) { PG8_OA(o2, ui + 1, nxt); }
            PG8_LDB(B0, 0, 0); PG8_LDB(B1, 0, 1); PG8_SCHED; PG8_LDA(At, 0, 0); if (!first) { PG8_STAGE(PG8_SA(1, 1), a1, oaC[1]); }
            if (!first) { PG8_WAIT_V(8); } PG8_WAIT_L(0); PG8_BAR; PG8_MMA(0, 0, At, B0); PG8_MMA(0, 1, At, B1); PG8_BAR; PG8_SCHED;
            PG8_LDA(At, 0, 1); PG8_STAGE(PG8_SB(0, 0), b2, voffB); PG8_STAGE(PG8_SB(0, 1), b2 + hstepB, voffB); PG8_STAGE(PG8_SA(0, 0), a2, o2[0]);
            if (!first) { PG8_WAIT_V(8); } PG8_WAIT_L(0); PG8_BAR; PG8_MMA(1, 0, At, B0); PG8_MMA(1, 1, At, B1); PG8_BAR; PG8_SCHED;
            PG8_LDB(B0, 1, 0); PG8_LDB(B1, 1, 1); PG8_SCHED; PG8_LDA(At, 1, 0); PG8_STAGE(PG8_SA(0, 1), a2, o2[1]);
            if (!first) { PG8_WAIT_V(8); } PG8_WAIT_L(0); PG8_BAR; PG8_MMA(0, 0, At, B0); PG8_MMA(0, 1, At, B1); PG8_BAR; PG8_SCHED;
            PG8_LDA(At, 1, 1); PG8_STAGE(PG8_SB(1, 0), b3, voffB); PG8_STAGE(PG8_SB(1, 1), b3 + hstepB, voffB); PG8_STAGE(PG8_SA(1, 0), a3, o2[0]);
            PG8_WAIT_V(8); PG8_WAIT_L(0); PG8_BAR; PG8_MMA(1, 0, At, B0); PG8_MMA(1, 1, At, B1); PG8_BAR; PG8_SCHED;
            if (last && has_next) { PG8_STAGE(PG8_SA(1, 1), a3, o2[1]); }
        }
        if (wr == 0) PG8_BAR;
        if constexpr (FP8) asm volatile("s_nop 15\n\ts_nop 15\n\ts_nop 15" ::: "memory");
        { int fr_ = fr, fq_ = fq; asm volatile("" : "+v"(fr_), "+v"(fq_));
          const int qv_ = S.fetch(ui); E(acc, cur, ui, wr, wc, fr_, fq_); S.post(ui, qv_); }
        if (!has_next) break;
#pragma unroll
        for (int a = 0; a < 2; ++a)
#pragma unroll
            for (int b = 0; b < 2; ++b)
#pragma unroll
                for (int m = 0; m < 4; ++m)
#pragma unroll
                    for (int n = 0; n < 2; ++n) acc[a][b][m][n] = (f32x4){0.f, 0.f, 0.f, 0.f};
        cur = nxt; cB = nB; ++ui;
        PG8_OA(oaC, ui, cur);
        if (wr == 1) PG8_BAR;
    }
    PG8_WAIT_V(0);
    PG8_BAR;
#undef PG8_SA
#undef PG8_SB
#undef PG8_STAGE
#undef PG8_LDA
#undef PG8_LDB
#undef PG8_MMA
#undef PG8_WAIT_V
#undef PG8_WAIT_L
#undef PG8_BAR
#undef PG8_SCHED
#undef PG8_OA
}
}
#include <hip/hip_bf16.h>
#include <cmath>
namespace attn_body {
using bf16=__hip_bfloat16;
using bf16x8=__attribute__((ext_vector_type(8)))short;
using s16x4=__attribute__((ext_vector_type(4)))short;
using f32x16=__attribute__((ext_vector_type(16)))float;
using u32x4=__attribute__((ext_vector_type(4)))unsigned;
using u32x2=__attribute__((ext_vector_type(2)))unsigned;
constexpr int SEQ=4096,D=64,QP=512,OP=1024;
constexpr int NW=8,QBLK=32,QB=QBLK*NW,KVBLK=64,NQB=SEQ/QB;
constexpr int ATTN_UNIT_ROWS=QB;
__device__ __forceinline__ int crow(int r,int hi){return (r&3)+8*(r>>2)+4*hi;}
#define SBAR() __builtin_amdgcn_sched_barrier(0)
__device__ __forceinline__ void cmask(f32x16&p0,f32x16&p1,int jb,int qrel,int hi){
  const float NEG=-INFINITY; int kb=64*jb+4*hi;
  #pragma unroll
  for(int r=0;r<16;++r){int kv=kb+(r&3)+8*(r>>2); if(kv>qrel)p0[r]=NEG; if(kv+32>qrel)p1[r]=NEG;}
}

__device__ __forceinline__ void smask(f32x16&p0,f32x16&p1,int jb,int qrel,int hi){
  const float NEG=-INFINITY; int kb=64*jb+4*hi;
  #pragma unroll
  for(int r=0;r<16;++r){int kv=kb+(r&3)+8*(r>>2); if(kv>qrel||kv<=qrel-128)p0[r]=NEG; if(kv+32>qrel||kv+32<=qrel-128)p1[r]=NEG;}
}
constexpr int NSLOT=3, SLOTB=8192;
constexpr int LDS_K=0, LDS_V=NSLOT*SLOTB, LDS_WS=2*NSLOT*SLOTB, LDS_OST=LDS_WS+NW*64*4, LDS_BYTES=LDS_OST+NW*4096;
constexpr float C2=0.125f*1.4426950408889634f;
__device__ __forceinline__ void glds16(const void*gsrc,unsigned lds_dst){unsigned keep;
  asm volatile("s_mov_b32 %0, m0\n\ts_mov_b32 m0, %2\n\ts_nop 0\n\tglobal_load_lds_dwordx4 %1, off\n\ts_mov_b32 m0, %0":"=&s"(keep):"v"(gsrc),"s"(lds_dst):"memory");}
__device__ __forceinline__ float max3f(float a,float b,float c){float r;asm("v_max3_f32 %0, %1, %2, %3":"=v"(r):"v"(a),"v"(b),"v"(c));return r;}
__device__ __forceinline__ float max2f(float a,float b){float r;asm("v_max_f32_e32 %0, %1, %2":"=v"(r):"v"(a),"v"(b));return r;}
__device__ __forceinline__ float fadd_s(float a,float b){float r;asm("v_add_f32_e32 %0, %1, %2":"=v"(r):"v"(a),"v"(b));return r;}
__device__ __forceinline__ float fsub_s(float a,float b){float r;asm("v_sub_f32_e32 %0, %1, %2":"=v"(r):"v"(a),"v"(b));return r;}
typedef float f32x2_t __attribute__((ext_vector_type(2))); typedef __bf16 bf16x2_t __attribute__((ext_vector_type(2)));
constexpr float SO8=16.f;
__device__ __forceinline__ unsigned o8pk(float a,float b,float c,float d){int w=0;w=__builtin_amdgcn_cvt_pk_fp8_f32(__builtin_amdgcn_fmed3f(a,-448.f,448.f),__builtin_amdgcn_fmed3f(b,-448.f,448.f),w,false);w=__builtin_amdgcn_cvt_pk_fp8_f32(__builtin_amdgcn_fmed3f(c,-448.f,448.f),__builtin_amdgcn_fmed3f(d,-448.f,448.f),w,true);return (unsigned)w;}
__device__ __forceinline__ unsigned cvtpk_s(float lo,float hi){f32x2_t v={lo,hi};bf16x2_t b=__builtin_convertvector(v,bf16x2_t);return __builtin_bit_cast(unsigned,b);}
#define WAIT_BAR(N) asm volatile("s_waitcnt vmcnt(" #N ") lgkmcnt(0)\n\ts_barrier":::"memory")

__device__ __forceinline__ void qkt(f32x16&p0,f32x16&p1,const char*Kslot,const bf16x8*qr,const f32x16&negm,int r32,int hi){
  const char*kb=Kslot+hi*1024+r32*16;
  #pragma unroll
  for(int d0=0;d0<4;++d0){
    const bf16x8 b0=*reinterpret_cast<const bf16x8*>(kb+d0*2048);
    const bf16x8 b1=*reinterpret_cast<const bf16x8*>(kb+d0*2048+512);
    if(d0==0){p0=__builtin_amdgcn_mfma_f32_32x32x16_bf16(b0,qr[0],negm,0,0,0);p1=__builtin_amdgcn_mfma_f32_32x32x16_bf16(b1,qr[0],negm,0,0,0);}
    else{p0=__builtin_amdgcn_mfma_f32_32x32x16_bf16(b0,qr[d0],p0,0,0,0);p1=__builtin_amdgcn_mfma_f32_32x32x16_bf16(b1,qr[d0],p1,0,0,0);}}
}
typedef __attribute__((address_space(3))) const char* lds_cptr;
typedef short v4i16_t __attribute__((ext_vector_type(4)));
__device__ __forceinline__ void kload8(bf16x8*kf,lds_cptr kp){
  kf[0]=*(const __attribute__((address_space(3))) bf16x8*)(kp);      kf[1]=*(const __attribute__((address_space(3))) bf16x8*)(kp+512);
  kf[2]=*(const __attribute__((address_space(3))) bf16x8*)(kp+2048); kf[3]=*(const __attribute__((address_space(3))) bf16x8*)(kp+2560);
  kf[4]=*(const __attribute__((address_space(3))) bf16x8*)(kp+4096); kf[5]=*(const __attribute__((address_space(3))) bf16x8*)(kp+4608);
  kf[6]=*(const __attribute__((address_space(3))) bf16x8*)(kp+6144); kf[7]=*(const __attribute__((address_space(3))) bf16x8*)(kp+6656);
}
__device__ __forceinline__ void kload2(bf16x8*kf,lds_cptr kp,int j){ kf[2*j]=*(const __attribute__((address_space(3))) bf16x8*)(kp+j*2048); kf[2*j+1]=*(const __attribute__((address_space(3))) bf16x8*)(kp+j*2048+512); }
__device__ __forceinline__ s16x4 vtr(lds_cptr p){ return __builtin_bit_cast(s16x4,__builtin_amdgcn_ds_read_tr16_b64_v4i16((__attribute__((address_space(3))) v4i16_t*)p)); }
__device__ __forceinline__ float rowmax(const f32x16&p0,const f32x16&p1){
  float a=max3f(p0[0],p0[1],p1[0]),b=max3f(p0[2],p0[3],p1[1]);a=max3f(a,p1[2],p1[3]);
  #pragma unroll
  for(int r=4;r<16;r+=4){a=max3f(a,p0[r],p0[r+1]);b=max3f(b,p0[r+2],p0[r+3]);a=max3f(a,p1[r],p1[r+1]);b=max3f(b,p1[r+2],p1[r+3]);}
  const float m=max2f(a,b);
  auto rr=__builtin_amdgcn_permlane32_swap(__float_as_uint(m),__float_as_uint(m),false,false);
  return max2f(__uint_as_float(rr[0]),__uint_as_float(rr[1]));
}
__device__ __forceinline__ void pv(f32x16*o,int vb,bf16x8 pa0,bf16x8 pa1,bf16x8 pa2,bf16x8 pa3){
  #pragma unroll
  for(int d0=0;d0<2;++d0){s16x4 lo[4],hi[4];
    #pragma unroll
    for(int ks=0;ks<4;++ks){
      asm volatile("ds_read_b64_tr_b16 %0,%1 offset:%c2":"=&v"(lo[ks]):"v"(vb),"i"(d0*4096+ks*1024):"memory");
      asm volatile("ds_read_b64_tr_b16 %0,%1 offset:%c2":"=&v"(hi[ks]):"v"(vb),"i"(d0*4096+ks*1024+512):"memory");}
    asm volatile("s_waitcnt lgkmcnt(0)":::"memory");SBAR();
    #define PK(k) (bf16x8){lo[k][0],lo[k][1],lo[k][2],lo[k][3],hi[k][0],hi[k][1],hi[k][2],hi[k][3]}
    o[d0]=__builtin_amdgcn_mfma_f32_32x32x16_bf16(pa0,PK(0),o[d0],0,0,0);
    o[d0]=__builtin_amdgcn_mfma_f32_32x32x16_bf16(pa1,PK(1),o[d0],0,0,0);
    o[d0]=__builtin_amdgcn_mfma_f32_32x32x16_bf16(pa2,PK(2),o[d0],0,0,0);
    o[d0]=__builtin_amdgcn_mfma_f32_32x32x16_bf16(pa3,PK(3),o[d0],0,0,0);
    #undef PK
  }
}

#ifndef ATTN_STORE16
#define ATTN_STORE16(p,v) (*(u32x4*)(p)=(v))
#endif
template<int MODE,int KP,int VP,int THRL> __device__ __forceinline__ void attn_unit(long rowbase,int q0,const bf16*Qh,const bf16*__restrict__ Kh0,const bf16*__restrict__ Vh0,unsigned char*Oh,float sink2a,float sink2b,char*shm){
  int tid=threadIdx.x; asm volatile("":"+v"(tid));
  const int lane=tid&63,r32=lane&31,hi=lane>>5; const int wid=__builtin_amdgcn_readfirstlane(tid>>6);
  const int t0=(MODE==1&&q0>=128)?(q0/KVBLK-2):0;
  const int wrow=(MODE==1)?(wid&3)*QBLK:wid*QBLK, whd=(MODE==1)?(wid>>2)*D:0;
  const float sink2=(MODE==1&&(wid>>2))?sink2b:sink2a;
  const bf16*Qw=Qh+whd+(rowbase+q0+wrow)*QP;
  const bf16*Kh=Kh0+(rowbase+(long)t0*KVBLK)*KP,*Vh=Vh0+(rowbase+(long)t0*KVBLK)*VP;
  const unsigned lds0=(unsigned)(uintptr_t)shm;
  float*wsf=(float*)(shm+LDS_WS)+wid*64;
  const bf16*ksrc=Kh+(long)lane*KP+wid*8;
  const bf16*vsrc=Vh+(long)(16*(wid&3)+(lane>>2))*VP+(wid>>2)*32+(lane&3)*8;
  const unsigned kdst=lds0+LDS_K+wid*1024, vdst=lds0+LDS_V+wid*1024;
  #define DMA_K(t,slot) glds16(ksrc+(long)(t)*KVBLK*KP,(unsigned)__builtin_amdgcn_readfirstlane(kdst+(slot)))
  #define DMA_V(t,slot) glds16(vsrc+(long)(t)*KVBLK*VP,(unsigned)__builtin_amdgcn_readfirstlane(vdst+(slot)))
  const int vb0=(int)(lds0+LDS_V)+((lane>>4)&1)*32+(lane&3)*8+(4*hi+((lane&15)>>2))*64;
  const char*Kbase=shm+LDS_K; bf16x8 kf[8];
  const lds_cptr shm3=(lds_cptr)shm; const lds_cptr kp0=shm3+LDS_K+hi*1024+r32*16; const lds_cptr vp0=shm3+LDS_V+((lane>>4)&1)*32+(lane&3)*8+(4*hi+((lane&15)>>2))*64;
  const int NT=(MODE==1)?4:(q0+QB)/KVBLK;
  const int jb0=(MODE==1)?(t0-q0/KVBLK):0;
  DMA_K(0,0);DMA_V(0,0);DMA_K(1,SLOTB);
  bf16x8 qr[4];
  #pragma unroll
  for(int d0=0;d0<4;++d0)qr[d0]=*reinterpret_cast<const bf16x8*>(&Qw[(long)r32*QP+d0*16+hi*8]);
  float mhat=0.f,l_reg=0.f;f32x16 o[2];o[0]=f32x16{};o[1]=f32x16{};f32x16 negm=f32x16{};asm volatile("":"+v"(negm));
  const int qrel=wrow+r32;
  #define CMASK(P0,P1,t) do{int jb_=(t)-(NT-4); if(MODE==1)smask(P0,P1,(t)+jb0,qrel,hi); else if(jb_>=0)cmask(P0,P1,jb_,qrel,hi);}while(0)
  bool resc=false;
  #define START(P0,P1) do{ const float rm=rowmax(P0,P1); resc=false; \
    { const float dl=max2f(rm,-64.f); mhat=fadd_s(mhat,dl); \
      _Pragma("unroll") for(int r=0;r<16;++r){P0[r]=fsub_s(P0[r],dl);P1[r]=fsub_s(P1[r],dl);} \
      _Pragma("unroll") for(int r=0;r<16;++r)negm[r]=-mhat; asm volatile("":"+v"(negm)); } \
    _Pragma("unroll") for(int r=0;r<16;++r)P0[r]=__builtin_amdgcn_exp2f(P0[r]); }while(0)
  #define RESC() do{ if(resc){ asm volatile("s_waitcnt lgkmcnt(0)":::"memory"); \
      _Pragma("unroll") for(int d_=0;d_<2;++d_) _Pragma("unroll") for(int r=0;r<16;++r)o[d_][r]*=wsf[crow(r,hi)]; } }while(0)
  f32x16 pA0,pA1,pB0,pB1;
  int sl_prev=0,sl_cur=0,sl_next=SLOTB;
  #define ROT() do{sl_prev=sl_cur;sl_cur=sl_next;sl_next=(sl_next==(NSLOT-1)*SLOTB)?0:sl_next+SLOTB;}while(0)
  DMA_K(2,2*SLOTB);
  WAIT_BAR(3);
  qkt(pA0,pA1,Kbase,qr,negm,r32,hi);asm volatile("s_nop 15\n\ts_nop 7":"+v"(pA0),"+v"(pA1));CMASK(pA0,pA1,0);
  START(pA0,pA1);
  _Pragma("unroll") for(int r=0;r<16;++r)pA1[r]=__builtin_amdgcn_exp2f(pA1[r]);
  WAIT_BAR(0);
  DMA_K(3,0);DMA_V(1,SLOTB);
  ROT();
  kload8(kf,kp0+sl_cur);
  WAIT_BAR(2);
  s16x4 vlo[8],vhi[8]; u32x4 pw0,pw1,pw2,pw3;
  #define PKW(P,B) cvtpk_s(P[B],P[B+1])
  #define PAF(k) __builtin_bit_cast(bf16x8,pw##k)
  #define VFR(i) (bf16x8){vlo[i][0],vlo[i][1],vlo[i][2],vlo[i][3],vhi[i][0],vhi[i][1],vhi[i][2],vhi[i][3]}
  #define PIN(x) asm volatile("":"+v"(x))
  #define MX3(a,b,c) __builtin_fmaxf(__builtin_fmaxf((a),(b)),(c))
  #define GAPA(MF,A0,A1,A2,A3,W0,W1,PW) do{ MF; sacc+=A0; sacc+=A1; sacc+=A2; sacc+=A3; PIN(sacc); W0; W1; PIN(PW); SBAR(); }while(0)
  #define EX(v) __builtin_amdgcn_exp2f(v)
  #define GAPB(MF,X,B) do{ MF; X[B]=EX(X[B]); X[B+1]=EX(X[B+1]); X[B+2]=EX(X[B+2]); X[B+3]=EX(X[B+3]); PIN(X); SBAR(); }while(0)
  #define VRD(i) do{ vlo[i]=vtr(vp_+(((i)>>2)*4096+((i)&3)*1024)); vhi[i]=vtr(vp_+(((i)>>2)*4096+((i)&3)*1024+512)); }while(0)
  #define KRD(G,j) do{ if(G){ kload2(kf,kp0+sl_next,j); SBAR(); } }while(0)
  #define STEP(C0,C1,P0,P1,t,GK,GV,GL) do{ SBAR(); \
    const lds_cptr vp_=vp0+sl_prev; \
    VRD(0); SBAR(); float sacc=(P0[0]+P0[1]); \
    GAPA(C0=__builtin_amdgcn_mfma_f32_32x32x16_bf16(kf[0],qr[0],negm,0,0,0), P0[2],P0[3],P0[4],P0[5],     pw0[0]=PKW(P0,0), pw0[1]=PKW(P0,2), pw0); \
    VRD(4); SBAR(); GAPA(C1=__builtin_amdgcn_mfma_f32_32x32x16_bf16(kf[1],qr[0],negm,0,0,0), P0[6],P0[7],P0[8],P0[9],     pw0[2]=PKW(P0,4), pw0[3]=PKW(P0,6), pw0); \
    VRD(1); SBAR(); GAPA(C0=__builtin_amdgcn_mfma_f32_32x32x16_bf16(kf[2],qr[1],C0,0,0,0),   P0[10],P0[11],P0[12],P0[13], pw1[0]=PKW(P0,8), pw1[1]=PKW(P0,10), pw1); \
    VRD(5); SBAR(); GAPA(C1=__builtin_amdgcn_mfma_f32_32x32x16_bf16(kf[3],qr[1],C1,0,0,0),   P0[14],P0[15],P1[0],P1[1],   pw1[2]=PKW(P0,12),pw1[3]=PKW(P0,14), pw1); \
    VRD(2); SBAR(); GAPA(C0=__builtin_amdgcn_mfma_f32_32x32x16_bf16(kf[4],qr[2],C0,0,0,0),   P1[2],P1[3],P1[4],P1[5],     pw2[0]=PKW(P1,0), pw2[1]=PKW(P1,2), pw2); \
    VRD(6); SBAR(); GAPA(C1=__builtin_amdgcn_mfma_f32_32x32x16_bf16(kf[5],qr[2],C1,0,0,0),   P1[6],P1[7],P1[8],P1[9],     pw2[2]=PKW(P1,4), pw2[3]=PKW(P1,6), pw2); \
    VRD(3); SBAR(); GAPA(C0=__builtin_amdgcn_mfma_f32_32x32x16_bf16(kf[6],qr[3],C0,0,0,0),   P1[10],P1[11],P1[12],P1[13], pw3[0]=PKW(P1,8), pw3[1]=PKW(P1,10), pw3); \
    VRD(7); SBAR(); GAPA(C1=__builtin_amdgcn_mfma_f32_32x32x16_bf16(kf[7],qr[3],C1,0,0,0),   P1[14],P1[15],0.f,0.f,       pw3[2]=PKW(P1,12),pw3[3]=PKW(P1,14), pw3); \
    l_reg+=sacc; \
    if(GK){DMA_K((t)+3,sl_cur);} if(GV){DMA_V((t)+1,sl_next);} \
    CMASK(C0,C1,t); \
    { float a=MX3(C0[0],C0[1],C1[0]),b=MX3(C0[2],C0[3],C1[1]); a=MX3(a,C1[2],C1[3]); \
      _Pragma("unroll") for(int r=4;r<16;r+=4){a=MX3(a,C0[r],C0[r+1]);b=MX3(b,C0[r+2],C0[r+3]);a=MX3(a,C1[r],C1[r+1]);b=MX3(b,C1[r+2],C1[r+3]);} \
      float rm=__builtin_fmaxf(a,b); { auto rr=__builtin_amdgcn_permlane32_swap(__float_as_uint(rm),__float_as_uint(rm),false,false); rm=__builtin_fmaxf(__uint_as_float(rr[0]),__uint_as_float(rr[1])); } \
      resc=false; \
      if(__builtin_expect(__any(rm>(float)THRL),0)){ const float dl=__builtin_fmaxf(rm,0.f); mhat+=dl; \
        _Pragma("unroll") for(int r=0;r<16;++r){C0[r]-=dl;C1[r]-=dl;} \
        _Pragma("unroll") for(int r=0;r<16;++r)negm[r]=-mhat; asm volatile("":"+v"(negm)); \
        const float f=__builtin_amdgcn_exp2f(-dl); l_reg*=f; if(hi==0)wsf[r32]=f; resc=true; } } \
    SBAR(); \
    GAPB(o[0]=__builtin_amdgcn_mfma_f32_32x32x16_bf16(PAF(0),VFR(0),o[0],0,0,0), C0,0); \
    GAPB(o[1]=__builtin_amdgcn_mfma_f32_32x32x16_bf16(PAF(0),VFR(4),o[1],0,0,0), C0,4); \
    KRD(GL,0); GAPB(o[0]=__builtin_amdgcn_mfma_f32_32x32x16_bf16(PAF(1),VFR(1),o[0],0,0,0), C0,8); \
    KRD(GL,1); GAPB(o[1]=__builtin_amdgcn_mfma_f32_32x32x16_bf16(PAF(1),VFR(5),o[1],0,0,0), C0,12); \
    KRD(GL,2); GAPB(o[0]=__builtin_amdgcn_mfma_f32_32x32x16_bf16(PAF(2),VFR(2),o[0],0,0,0), C1,0); \
    KRD(GL,3); GAPB(o[1]=__builtin_amdgcn_mfma_f32_32x32x16_bf16(PAF(2),VFR(6),o[1],0,0,0), C1,4); \
    GAPB(o[0]=__builtin_amdgcn_mfma_f32_32x32x16_bf16(PAF(3),VFR(3),o[0],0,0,0), C1,8); \
    GAPB(o[1]=__builtin_amdgcn_mfma_f32_32x32x16_bf16(PAF(3),VFR(7),o[1],0,0,0), C1,12); \
    }while(0)
  int t=1;
  #undef CMASK
  #define CMASK(P0,P1,t) do{}while(0)
  for(;t+5<NT;t+=2){
    STEP(pB0,pB1,pA0,pA1,t,true,true,true);     WAIT_BAR(2); RESC(); ROT();
    STEP(pA0,pA1,pB0,pB1,t+1,true,true,true);   WAIT_BAR(2); RESC(); ROT();
  }
  #undef CMASK
  #define CMASK(P0,P1,t) do{int jb_=(t)-(NT-4); if(MODE==1)smask(P0,P1,(t)+jb0,qrel,hi); else if(jb_>=0)cmask(P0,P1,jb_,qrel,hi);}while(0)
  #define ENDW(tt) do{ if((tt)+3<NT){WAIT_BAR(2);} else if((tt)+2<NT){WAIT_BAR(1);} else {WAIT_BAR(0);} }while(0)
  for(;t+1<NT;t+=2){
    STEP(pB0,pB1,pA0,pA1,t,(t+3<NT),(t+1<NT),(t+1<NT));       ENDW(t);   RESC(); ROT();
    STEP(pA0,pA1,pB0,pB1,t+1,(t+4<NT),(t+2<NT),(t+2<NT));     ENDW(t+1); RESC(); ROT();
  }
  STEP(pB0,pB1,pA0,pA1,NT-1,false,false,false); RESC();
  { float sacc=pB0[0]+pB0[1]; _Pragma("unroll") for(int r=2;r<16;++r)sacc+=pB0[r]; _Pragma("unroll") for(int r=0;r<16;++r)sacc+=pB1[r]; l_reg+=sacc;
    pw0=(u32x4){PKW(pB0,0),PKW(pB0,2),PKW(pB0,4),PKW(pB0,6)};pw1=(u32x4){PKW(pB0,8),PKW(pB0,10),PKW(pB0,12),PKW(pB0,14)};pw2=(u32x4){PKW(pB1,0),PKW(pB1,2),PKW(pB1,4),PKW(pB1,6)};pw3=(u32x4){PKW(pB1,8),PKW(pB1,10),PKW(pB1,12),PKW(pB1,14)};
    SBAR(); pv(o,vb0+sl_cur,PAF(0),PAF(1),PAF(2),PAF(3)); }
  #undef PKW
  #undef PAF
  #undef VFR
  #undef PIN
  #undef MX3
  #undef GAPA
  #undef GAPB
  #undef EX
  #undef VRD
  #undef KRD
  #undef STEP
  #undef ENDW
  {auto rr=__builtin_amdgcn_permlane32_swap(__float_as_uint(l_reg),__float_as_uint(l_reg),false,false);l_reg=__uint_as_float(rr[0])+__uint_as_float(rr[1]);}
  if(MODE==1)l_reg+=__builtin_amdgcn_exp2f(sink2-mhat);
  if(hi==0)wsf[32+r32]=l_reg;asm volatile("s_waitcnt lgkmcnt(0)":::"memory");
  float rli[16];
  #pragma unroll
  for(int r=0;r<16;++r)rli[r]=__builtin_amdgcn_rcpf(wsf[32+crow(r,hi)]);
  unsigned char*Ow=Oh+whd+(rowbase+q0+wrow)*OP;
  { bf16*stg=(bf16*)(shm+LDS_OST)+wid*2048;
    #pragma unroll
    for(int r=0;r<16;++r){const int orow=crow(r,hi);
      #pragma unroll
      for(int d0=0;d0<2;++d0)stg[orow*64+d0*32+r32]=__float2bfloat16(o[d0][r]*rli[r]);}
    asm volatile("s_waitcnt lgkmcnt(0)":::"memory");
    #pragma unroll
    for(int i=0;i<4;++i){const int row=i*8+(lane>>3),ch=lane&7; const u32x4 v=*(const u32x4*)(stg+row*64+ch*8);
      u32x2 w8; w8[0]=o8pk(__uint_as_float(v[0]<<16)*SO8,__uint_as_float(v[0]&0xffff0000u)*SO8,__uint_as_float(v[1]<<16)*SO8,__uint_as_float(v[1]&0xffff0000u)*SO8);
      w8[1]=o8pk(__uint_as_float(v[2]<<16)*SO8,__uint_as_float(v[2]&0xffff0000u)*SO8,__uint_as_float(v[3]<<16)*SO8,__uint_as_float(v[3]&0xffff0000u)*SO8);
      *(u32x2*)(Ow+(long)row*OP+ch*8)=w8;} }
  asm volatile("s_waitcnt lgkmcnt(0)\n\ts_barrier":::"memory");
  #undef DMA_K
  #undef DMA_V
  #undef CMASK
  #undef START
  #undef RESC
  #undef ROT
}
constexpr int V2SLOT=16384;
constexpr int L2_K=0, L2_V=NSLOT*SLOTB, L2_WS=L2_V+NSLOT*V2SLOT, L2_OST=L2_WS+NW*64*4, L2_BYTES=L2_OST+NW*4096;
template<int THRL> __device__ __forceinline__ void attn_unit128(long rowbase,int q0,const bf16*Qh,const bf16*__restrict__ Kh0,const bf16*__restrict__ Vh0,bf16*Oh,unsigned char*O8h,bool cmb,float lam,const float*gsub,char*shm){
  constexpr int KP=512,VP=512;
  int tid=threadIdx.x; asm volatile("":"+v"(tid));
  const int lane=tid&63,r32=lane&31,hi=lane>>5; const int wid=__builtin_amdgcn_readfirstlane(tid>>6);
  const bf16*Qw=Qh+(rowbase+q0+wid*QBLK)*QP;
  const bf16*Kh=Kh0+rowbase*KP,*Vh=Vh0+rowbase*VP;
  const unsigned lds0=(unsigned)(uintptr_t)shm;
  float*wsf=(float*)(shm+L2_WS)+wid*64;
  const bf16*ksrc=Kh+(long)lane*KP+wid*8;
  const bf16*vsrc=Vh+(long)(16*(wid&3)+(lane>>2))*VP+(wid>>2)*32+(lane&3)*8;
  const unsigned kdst=lds0+L2_K+wid*1024, vdst=lds0+L2_V+wid*1024;
  #define DK128(t,slot) glds16(ksrc+(long)(t)*KVBLK*KP,(unsigned)__builtin_amdgcn_readfirstlane(kdst+(slot)))
  #define DV128(t,slot) do{ glds16(vsrc+(long)(t)*KVBLK*VP,(unsigned)__builtin_amdgcn_readfirstlane(vdst+(slot))); glds16(vsrc+(long)(t)*KVBLK*VP+64,(unsigned)__builtin_amdgcn_readfirstlane(vdst+(slot)+8192)); }while(0)
  const lds_cptr shm3=(lds_cptr)shm; const lds_cptr kp0=shm3+L2_K+hi*1024+r32*16; const lds_cptr vp0=shm3+L2_V+((lane>>4)&1)*32+(lane&3)*8+(4*hi+((lane&15)>>2))*64;
  const int NT=(q0+QB)/KVBLK;
  DK128(0,0);DV128(0,0);DK128(1,SLOTB);
  typedef __attribute__((address_space(3))) bf16x8* lds_q8;
  const lds_q8 qst=(lds_q8)(shm3+L2_OST+wid*4096+lane*16);
  { bf16x8 qt[4];
    #pragma unroll
    for(int d0=0;d0<4;++d0)qt[d0]=*reinterpret_cast<const bf16x8*>(&Qw[(long)r32*QP+d0*16+hi*8]);
    #pragma unroll
    for(int d0=0;d0<4;++d0)qst[d0*64]=qt[d0]; }
  float mhat=0.f,l_reg=0.f;f32x16 o[4];o[0]=f32x16{};o[1]=f32x16{};o[2]=f32x16{};o[3]=f32x16{};f32x16 negm=f32x16{};asm volatile("":"+v"(negm));
  const int qrel=wid*QBLK+r32;
  bool resc=false;
  f32x16 C0,C1; u32x4 pw0,pw1,pw2,pw3; bf16x8 kf[8]; s16x4 vfl[16],vfh[16];
  int ip=0,ic=0,in=1;
  #define ROT128() do{ip=ic;ic=in;in=(in==NSLOT-1)?0:in+1;}while(0)
  #define MF32(a,b,c) __builtin_amdgcn_mfma_f32_32x32x16_bf16(a,b,c,0,0,0)
  #define PV32(acc,a,b) do{ const bf16x8 a_=(a), b_=(b); asm volatile("v_mfma_f32_32x32x16_bf16 %0, %1, %2, %0":"+v"(acc):"v"(a_),"v"(b_)); }while(0)
  #define PIN(x) asm volatile("":"+v"(x))
  #define EXP2(CX,B) do{ CX[B]=__builtin_amdgcn_exp2f(CX[B]); CX[(B)+1]=__builtin_amdgcn_exp2f(CX[(B)+1]); sacc+=CX[B]; sacc+=CX[(B)+1]; }while(0)
  #define PACK2(CX,B,PN,W) do{ PN[W]=cvtpk_s(CX[B],CX[(B)+1]); }while(0)
  #define QK128(slotb) do{ kload8(kf,kp0+(slotb)); const bf16x8 q0_=qst[0],q1_=qst[64],q2_=qst[128],q3_=qst[192]; \
    C0=MF32(kf[0],q0_,negm); C1=MF32(kf[1],q0_,negm); C0=MF32(kf[2],q1_,C0); C1=MF32(kf[3],q1_,C1); \
    C0=MF32(kf[4],q2_,C0);   C1=MF32(kf[5],q2_,C1);   C0=MF32(kf[6],q3_,C0); C1=MF32(kf[7],q3_,C1); }while(0)
  #define QK128P(slotb) do{ kload8(kf,kp0+(slotb)); const bf16x8 q0_=qst[0],q1_=qst[64],q2_=qst[128],q3_=qst[192]; float sacc=0.f; SBAR(); \
    C0=MF32(kf[0],q0_,negm); EXP2(C1,0);  EXP2(C1,2);  PIN(sacc); PIN(C1); SBAR(); \
    C0=MF32(kf[2],q1_,C0);   EXP2(C1,4);  EXP2(C1,6);  PIN(sacc); PIN(C1); SBAR(); \
    C0=MF32(kf[4],q2_,C0);   EXP2(C1,8);  EXP2(C1,10); PIN(sacc); PIN(C1); SBAR(); \
    C0=MF32(kf[6],q3_,C0);   EXP2(C1,12); EXP2(C1,14); PIN(sacc); PIN(C1); SBAR(); \
    PACK2(C1,0,pw2,0); PACK2(C1,2,pw2,1); PACK2(C1,4,pw2,2); PACK2(C1,6,pw2,3); PACK2(C1,8,pw3,0); PACK2(C1,10,pw3,1); PACK2(C1,12,pw3,2); PACK2(C1,14,pw3,3); PIN(pw2); PIN(pw3); l_reg+=sacc; SBAR(); \
    C1=MF32(kf[1],q0_,negm); C1=MF32(kf[3],q1_,C1); C1=MF32(kf[5],q2_,C1); C1=MF32(kf[7],q3_,C1); }while(0)
  #define MX3(a,b,c) __builtin_fmaxf(__builtin_fmaxf((a),(b)),(c))
  #define ROWMAX128(rm) do{ float a_=MX3(C0[0],C0[1],C1[0]),b_=MX3(C0[2],C0[3],C1[1]); a_=MX3(a_,C1[2],C1[3]); \
      _Pragma("unroll") for(int r=4;r<16;r+=4){a_=MX3(a_,C0[r],C0[r+1]);b_=MX3(b_,C0[r+2],C0[r+3]);a_=MX3(a_,C1[r],C1[r+1]);b_=MX3(b_,C1[r+2],C1[r+3]);} \
      rm=__builtin_fmaxf(a_,b_); { auto rr=__builtin_amdgcn_permlane32_swap(__float_as_uint(rm),__float_as_uint(rm),false,false); rm=__builtin_fmaxf(__uint_as_float(rr[0]),__uint_as_float(rr[1])); } }while(0)
  #define VRD128(i,vp_) do{ vfl[i]=vtr((vp_)+(((i)>>2)*4096+((i)&3)*1024)); vfh[i]=vtr((vp_)+(((i)>>2)*4096+((i)&3)*1024+512)); }while(0)
  #define VFR128(i) (bf16x8){vfl[i][0],vfl[i][1],vfl[i][2],vfl[i][3],vfh[i][0],vfh[i][1],vfh[i][2],vfh[i][3]}
  #define GAP128(g,PP,vp_) do{ PV32(o[(g)&3],__builtin_bit_cast(bf16x8,PP),VFR128(4*((g)&3)+((g)>>2))); \
      if((g)+2<16){ VRD128(4*(((g)+2)&3)+(((g)+2)>>2),vp_); } if(((g)&1)==0){ EXP2(C0,g); PIN(C0); } \
      if((g)>=8){ if((g)<12){ PACK2(C0,2*((g)-8),pw0,(g)-8); PIN(pw0); } else { PACK2(C0,2*((g)-8),pw1,(g)-12); PIN(pw1); } } PIN(sacc); SBAR(); }while(0)
  #define PHASEB128(vp_) do{ float sacc=0.f; VRD128(0,vp_); VRD128(4,vp_); SBAR(); \
      GAP128(0,pw0,vp_);  GAP128(1,pw0,vp_);  GAP128(2,pw0,vp_);  GAP128(3,pw0,vp_); \
      GAP128(4,pw1,vp_);  GAP128(5,pw1,vp_);  GAP128(6,pw1,vp_);  GAP128(7,pw1,vp_); \
      GAP128(8,pw2,vp_);  GAP128(9,pw2,vp_);  GAP128(10,pw2,vp_); GAP128(11,pw2,vp_); \
      GAP128(12,pw3,vp_); GAP128(13,pw3,vp_); GAP128(14,pw3,vp_); GAP128(15,pw3,vp_); \
      l_reg+=sacc; }while(0)
  #define RESC128() do{ if(resc){ asm volatile("s_waitcnt lgkmcnt(0)\n\ts_nop 15\n\ts_nop 15":::"memory"); \
      _Pragma("unroll") for(int d_=0;d_<4;++d_) _Pragma("unroll") for(int r=0;r<16;++r)o[d_][r]*=wsf[crow(r,hi)]; } }while(0)
  #define STEP128(t,GK,GV,MASKED) do{ SBAR(); \
    QK128P(ic*SLOTB); \
    if(GK){DK128((t)+2,ip*SLOTB);} if(GV){DV128((t)+1,in*V2SLOT);} \
    if(MASKED){ const int jb_=(t)-(NT-4); if(jb_>=0)cmask(C0,C1,jb_,qrel,hi); } \
    { float rm; ROWMAX128(rm); resc=false; \
      if(__builtin_expect(__any(rm>(float)THRL),0)){ const float dl=__builtin_fmaxf(rm,0.f); mhat+=dl; \
        _Pragma("unroll") for(int r=0;r<16;++r){C0[r]-=dl;C1[r]-=dl;} \
        _Pragma("unroll") for(int r=0;r<16;++r)negm[r]=-mhat; asm volatile("":"+v"(negm)); \
        const float f=__builtin_amdgcn_exp2f(-dl); l_reg*=f; if(hi==0)wsf[r32]=f; resc=true; } } \
    SBAR(); \
    { const lds_cptr vpp_=vp0+ip*V2SLOT; PHASEB128(vpp_); } \
    }while(0)
  WAIT_BAR(3);
  QK128(0);
  if(NT==4)cmask(C0,C1,0,qrel,hi);
  { float rm; ROWMAX128(rm); const float dl=__builtin_fmaxf(rm,-64.f); mhat=dl;
    #pragma unroll
    for(int r=0;r<16;++r){C0[r]-=dl;C1[r]-=dl;}
    #pragma unroll
    for(int r=0;r<16;++r)negm[r]=-mhat;
    asm volatile("":"+v"(negm));
    float sacc=0.f;
    #pragma unroll
    for(int w=0;w<4;++w){ EXP2(C0,2*w); PACK2(C0,2*w,pw0,w); EXP2(C0,8+2*w); PACK2(C0,8+2*w,pw1,w); }
    l_reg=sacc; }
  DK128(2,2*SLOTB); DV128(1,V2SLOT);
  WAIT_BAR(3);
  ROT128();
  #pragma unroll 1
  for(int t=1;t<NT;++t){
    const bool gk=t+2<NT,gv=t+1<NT,msk=t>=NT-4;
    STEP128(t,gk,gv,msk);
    if(gk){WAIT_BAR(3);}else if(gv){WAIT_BAR(2);}else{WAIT_BAR(0);}
    RESC128(); if(gv)ROT128();
  }
  { float sacc=0.f;
    #pragma unroll
    for(int w=0;w<4;++w){ EXP2(C1,2*w); PACK2(C1,2*w,pw2,w); EXP2(C1,8+2*w); PACK2(C1,8+2*w,pw3,w); }
    l_reg+=sacc; }
  { const lds_cptr vpp_=vp0+ic*V2SLOT;
    #pragma unroll
    for(int i=0;i<16;++i)VRD128(i,vpp_);
    #pragma unroll
    for(int g=0;g<16;++g){ const int db=g&3,kc=g>>2; const u32x4 pp=kc==0?pw0:kc==1?pw1:kc==2?pw2:pw3; PV32(o[db],__builtin_bit_cast(bf16x8,pp),VFR128(4*db+kc)); }
    asm volatile("s_nop 15\n\ts_nop 15\n\ts_nop 7":"+v"(o[0]),"+v"(o[1]),"+v"(o[2]),"+v"(o[3])); }
  {auto rr=__builtin_amdgcn_permlane32_swap(__float_as_uint(l_reg),__float_as_uint(l_reg),false,false);l_reg=__uint_as_float(rr[0])+__uint_as_float(rr[1]);}
  if(hi==0)wsf[32+r32]=l_reg;asm volatile("s_waitcnt lgkmcnt(0)":::"memory");
  float rli[16];
  #pragma unroll
  for(int r=0;r<16;++r)rli[r]=__builtin_amdgcn_rcpf(wsf[32+crow(r,hi)]);
  bf16*Ow=Oh+(rowbase+q0+wid*QBLK)*OP;
  { bf16*stg=(bf16*)(shm+L2_OST)+wid*2048;
    u32x4 my[2][4];
    #pragma unroll
    for(int rd=0;rd<2;++rd){
      #pragma unroll
      for(int r=0;r<16;++r){const int orow=crow(r,hi);
        #pragma unroll
        for(int d0=0;d0<2;++d0)stg[orow*64+d0*32+r32]=__float2bfloat16(o[2*rd+d0][r]*rli[r]);}
      asm volatile("s_waitcnt lgkmcnt(0)":::"memory");
      #pragma unroll
      for(int i=0;i<4;++i){const int row=i*8+(lane>>3),ch=lane&7; my[rd][i]=*(const u32x4*)(stg+row*64+ch*8);}
      asm volatile("s_waitcnt lgkmcnt(0)":::"memory"); }
    if(!cmb){
      #pragma unroll
      for(int rd=0;rd<2;++rd)
        #pragma unroll
        for(int i=0;i<4;++i){const int row=i*8+(lane>>3),ch=lane&7; ATTN_STORE16(Ow+(long)row*OP+rd*64+ch*8,my[rd][i]);}
    } else {
      u32x4 o1[2][4]; float gv[2][8];
      #pragma unroll
      for(int rd=0;rd<2;++rd){
        #pragma unroll
        for(int i=0;i<4;++i){const int row=i*8+(lane>>3),ch=lane&7; o1[rd][i]=*(const u32x4*)(Ow+(long)row*OP+rd*64+ch*8);}
        #pragma unroll
        for(int j=0;j<8;++j)gv[rd][j]=gsub[rd*64+(lane&7)*8+j]; }
      #define BFLO(w) __uint_as_float((w)<<16)
      #define BFHI(w) __uint_as_float((w)&0xffff0000u)
      float dv[2][4][8]; float ss[4]={0.f,0.f,0.f,0.f};
      #pragma unroll
      for(int rd=0;rd<2;++rd)
        #pragma unroll
        for(int i=0;i<4;++i){ const u32x4 a=o1[rd][i],b2=my[rd][i];
          dv[rd][i][0]=BFLO(a[0])-lam*BFLO(b2[0]); dv[rd][i][1]=BFHI(a[0])-lam*BFHI(b2[0]); dv[rd][i][2]=BFLO(a[1])-lam*BFLO(b2[1]); dv[rd][i][3]=BFHI(a[1])-lam*BFHI(b2[1]);
          dv[rd][i][4]=BFLO(a[2])-lam*BFLO(b2[2]); dv[rd][i][5]=BFHI(a[2])-lam*BFHI(b2[2]); dv[rd][i][6]=BFLO(a[3])-lam*BFLO(b2[3]); dv[rd][i][7]=BFHI(a[3])-lam*BFHI(b2[3]);
          #pragma unroll
          for(int j=0;j<8;++j)ss[i]+=dv[rd][i][j]*dv[rd][i][j]; }
      #pragma unroll
      for(int i=0;i<4;++i){ ss[i]+=__shfl_xor(ss[i],1); ss[i]+=__shfl_xor(ss[i],2); ss[i]+=__shfl_xor(ss[i],4); ss[i]=(0.8f*SO8)/sqrtf(ss[i]*(1.f/128.f)+1e-5f); }
      unsigned char*O8w=O8h+(rowbase+q0+wid*QBLK)*OP;
      #pragma unroll
      for(int rd=0;rd<2;++rd)
        #pragma unroll
        for(int i=0;i<4;++i){ const int row=i*8+(lane>>3),ch=lane&7; const float rr_=ss[i]; u32x2 w;
          w[0]=o8pk(dv[rd][i][0]*rr_*gv[rd][0],dv[rd][i][1]*rr_*gv[rd][1],dv[rd][i][2]*rr_*gv[rd][2],dv[rd][i][3]*rr_*gv[rd][3]);
          w[1]=o8pk(dv[rd][i][4]*rr_*gv[rd][4],dv[rd][i][5]*rr_*gv[rd][5],dv[rd][i][6]*rr_*gv[rd][6],dv[rd][i][7]*rr_*gv[rd][7]);
          *(u32x2*)(O8w+(long)row*OP+rd*64+ch*8)=w; }
      #undef BFLO
      #undef BFHI
    } }
  asm volatile("s_waitcnt lgkmcnt(0)\n\ts_barrier":::"memory");
  #undef DK128
  #undef DV128
  #undef ROT128
  #undef MF32
  #undef PV32
  #undef QK128
  #undef QK128P
  #undef MX3
  #undef ROWMAX128
  #undef PIN
  #undef VRD128
  #undef VFR128
  #undef EXP2
  #undef PACK2
  #undef GAP128
  #undef PHASEB128
  #undef RESC128
  #undef STEP128
}
constexpr int ATTN_LDS_BYTES=(LDS_BYTES>L2_BYTES)?LDS_BYTES:L2_BYTES;
#undef SBAR
#undef WAIT_BAR
}
#define GAS __attribute__((address_space(1)))
#define LAS __attribute__((address_space(3)))
typedef unsigned short bf16;
typedef unsigned v4u __attribute__((ext_vector_type(4)));
typedef float f32x4 __attribute__((ext_vector_type(4)));
typedef short bf16x8 __attribute__((ext_vector_type(8)));
typedef GAS unsigned gu32;
typedef GAS unsigned long long gu64;
#define RLX_AGENT __ATOMIC_RELAXED, __HIP_MEMORY_SCOPE_AGENT
#define LDS_WAIT() asm volatile("s_waitcnt lgkmcnt(0)" ::: "memory")
#define VM_WAIT() asm volatile("s_waitcnt vmcnt(0)" ::: "memory")
__device__ __forceinline__ unsigned long long rt() { return __builtin_amdgcn_s_memrealtime(); }
__device__ __forceinline__ unsigned f2bf(float f) { unsigned u = __builtin_bit_cast(unsigned, f); return (u + 0x7fffu + ((u >> 16) & 1u)) >> 16; }
__device__ __forceinline__ unsigned pk2(float lo, float hi) { return f2bf(lo) | (f2bf(hi) << 16); }

#define XB_TMO      128
#define XB_XCNT(j)  (256  + 64 * (j))
#define XB_XSUB(j)  (1280 + 64 * (j))
#define XB_XGEN(j)  (2304 + 64 * (j))
#define XB_TOP      3328
#define XB_TOPGEN   3392
#define XCD_BAR_WORDS 3456
#define XB_SPIN_CAP (1u << 18)

__device__ __forceinline__ unsigned xb_ld(unsigned* p)              { return __hip_atomic_load(p, __ATOMIC_RELAXED, __HIP_MEMORY_SCOPE_AGENT); }
__device__ __forceinline__ unsigned xb_add(unsigned* p, unsigned v) { return __hip_atomic_fetch_add(p, v, __ATOMIC_RELAXED, __HIP_MEMORY_SCOPE_AGENT); }
__device__ __forceinline__ unsigned xb_xcc_id() { return (unsigned)__builtin_amdgcn_s_getreg((3 << 11) | 20) & 0xFu; }
#define XB_SPIN(cond, bar) do { unsigned _sp = 0; while (cond) { __builtin_amdgcn_s_sleep(1); \
    if ((++_sp & 255u) == 0u) { if (xb_ld(&(bar)[XB_TMO])) break; if (_sp > XB_SPIN_CAP) { atomicAdd(&(bar)[XB_TMO], 1u); break; } } } } while (0)

struct XcdBarrier {
    unsigned* bar; unsigned x;
    volatile LAS unsigned* st;
};

__device__ __forceinline__ XcdBarrier xcd_barrier_post(unsigned* bar, volatile LAS unsigned* st) {
    XcdBarrier b; b.bar = bar; b.x = xb_xcc_id(); b.st = st;
    if (threadIdx.x == 0) (void)xb_add(&bar[XB_XCNT(b.x)], 1u);
    return b;
}
__device__ __forceinline__ void xcd_barrier_complete(unsigned* bar, unsigned x, unsigned& nloc, unsigned& nx) {
    const unsigned G = gridDim.x * gridDim.y * gridDim.z;
    unsigned sum, cnt, mine, sp = 0u;
    for (;;) {
        sum = 0u; cnt = 0u; mine = 0u;
#pragma unroll
        for (unsigned j = 0; j < 16; ++j) { const unsigned c = xb_ld(&bar[XB_XCNT(j)]); sum += c; cnt += (c > 0u) ? 1u : 0u; mine = (j == x) ? c : mine; }
        if (sum == G) break;
        __builtin_amdgcn_s_sleep(1);
        if ((++sp & 255u) == 0u) { if (xb_ld(&bar[XB_TMO])) break; if (sp > XB_SPIN_CAP) { atomicAdd(&bar[XB_TMO], 1u); break; } }
    }
    nloc = mine > 0u ? mine : 1u; nx = cnt > 0u ? cnt : 1u;
}

__device__ __forceinline__ void xcd_barrier(const XcdBarrier& b) {
    asm volatile("s_waitcnt vmcnt(0)" ::: "memory");
    __syncthreads();
    if (threadIdx.x == 0) {
        unsigned* bar = b.bar;
        __builtin_amdgcn_s_waitcnt(0);
        unsigned nloc = b.st[0], nx = b.st[1];
        if (nloc == 0u) { xcd_barrier_complete(bar, b.x, nloc, nx); b.st[0] = nloc; b.st[1] = nx; }
        const unsigned old = xb_add(&bar[XB_XSUB(b.x)], 1u);
        const unsigned gen = old / nloc;
        if (old + 1u == (gen + 1u) * nloc) {
            __builtin_amdgcn_fence(__ATOMIC_RELEASE, "agent");
            asm volatile("s_waitcnt vmcnt(0)" ::: "memory");
            const unsigned og = xb_add(&bar[XB_TOP], 1u);
            const unsigned tg = og / nx;
            if (og + 1u == (tg + 1u) * nx) xb_add(&bar[XB_TOPGEN], 1u);
            else XB_SPIN(xb_ld(&bar[XB_TOPGEN]) == tg, bar);
            __builtin_amdgcn_fence(__ATOMIC_ACQUIRE, "agent");
            xb_add(&bar[XB_XGEN(b.x)], 1u);
            asm volatile("s_waitcnt vmcnt(0)" ::: "memory");
        } else {
            XB_SPIN(xb_ld(&bar[XB_XGEN(b.x)]) == gen, bar);
            __builtin_amdgcn_fence(__ATOMIC_ACQUIRE, "agent");
            asm volatile("s_waitcnt vmcnt(0)" ::: "memory");
        }
    }
    __syncthreads();
}

constexpr int NWAVES = 8;
constexpr int NB = 8, SEQ = 4096, D = 1024, M = NB * SEQ, INW = 4352, NE = 32, FF = 1024;
constexpr float RMS_EPS = 1e-5f;
constexpr float QSCALE = 0.125f * 1.4426950408889634f;
constexpr float LOG2E = 1.4426950408889634f;
constexpr float SX = 16.f, SW = 512.f, SH = 4.f, SY = 64.f, ST = 16.f, SO = 16.f;
constexpr size_t MiB = 1u << 20;
constexpr size_t WS_CTL = 0, CTL_ZERO_BYTES = 1 * MiB;
constexpr size_t WS_ROPE = 1 * MiB;
constexpr size_t WS_ETOK = 2 * MiB;
constexpr size_t WS_EW = 6 * MiB;
constexpr size_t WS_ERS = 10 * MiB;
constexpr size_t WS_RWF = 14 * MiB;
constexpr size_t WS_WIN = 16 * MiB;
constexpr size_t WS_WA = 25 * MiB, WS_WO = 27 * MiB;
constexpr size_t WS_W1 = 30 * MiB;
constexpr size_t WS_W2 = 158 * MiB;
constexpr size_t WS_XN = 222 * MiB;
constexpr size_t WS_RS0 = 14 * MiB + 512 * 1024;
constexpr size_t WS_X1Q = 494 * MiB;
constexpr size_t WS_QA = 286 * MiB, WS_KA = 318 * MiB, WS_VA = 326 * MiB, WS_QB = 334 * MiB, WS_KB = 366 * MiB, WS_VB = 398 * MiB;
constexpr size_t WS_SGA = 430 * MiB, WS_SGB = 494 * MiB, WS_OSWA = 558 * MiB, WS_OD1 = 590 * MiB, WS_OD2 = 622 * MiB, WS_T = 654 * MiB;
constexpr size_t WS_H = 286 * MiB;
constexpr size_t WS_X1B = 430 * MiB;
constexpr size_t WS_Y = 558 * MiB;
constexpr size_t WS_O8 = 687 * MiB;
constexpr size_t WS_END = 815 * MiB;
constexpr int CW_TMO = 0, CW_CODE = 1, CW_BAR = 4096, CW_CNT = 8192, CW_Q1 = 10240;
constexpr int NCONV = 64;
static_assert((CW_CNT + 64 * NE) * 4 <= (int)CTL_ZERO_BYTES, "CTL words inside the memset region");
constexpr int RING_OFF = 0, RING_BYTES = 131072;
constexpr int LDSCTL_OFF = RING_BYTES, MISC_OFF = LDSCTL_OFF + 320;
constexpr int SCHED_OFF = LDSCTL_OFF + 512;
constexpr int GTAB_OFF = SCHED_OFF + 1024;
constexpr int LDS_BYTES = 147456;
static_assert(GTAB_OFF + 17 * 512 <= LDS_BYTES, "LDS map");

__device__ const float INV_FREQ[32] = {1.000000000e+00f, 7.498942614e-01f, 5.623413324e-01f, 4.216965139e-01f, 3.162277639e-01f, 2.371373773e-01f, 1.778279394e-01f, 1.333521307e-01f, 1.000000015e-01f, 7.498941571e-02f, 5.623413250e-02f, 4.216965288e-02f, 3.162277490e-02f, 2.371373773e-02f, 1.778279431e-02f, 1.333521493e-02f, 9.999999776e-03f, 7.498941850e-03f, 5.623413250e-03f, 4.216964822e-03f, 3.162277630e-03f, 2.371373586e-03f, 1.778279431e-03f, 1.333521446e-03f, 1.000000047e-03f, 7.498942432e-04f, 5.623413017e-04f, 4.216965172e-04f, 3.162277571e-04f, 2.371373703e-04f, 1.778279402e-04f, 1.333521504e-04f};

struct Frame {
    LAS unsigned char* lds;
    volatile LAS unsigned* MISC;
    gu32* ctl;
    unsigned char* ws;
    int tid, lane, wave;
    int vcu, G;
    const float* in[21]; float* out;
};
__device__ __forceinline__ float wave_sum(float v) {
#pragma unroll
    for (int o = 1; o < 64; o <<= 1) v += __shfl_xor(v, o);
    return v;
}
__device__ __forceinline__ int proj_mode(int hb) { return hb < 4 ? 0 : hb == 4 ? 1 : hb == 5 ? 2 : hb < 10 ? 0 : hb < 14 ? 1 : hb < 18 ? 2 : 3; }
__device__ __forceinline__ void proj_dst(int hb, size_t& off, int& ldc, int& col0) {
    if (hb < 4) { off = WS_QA; ldc = 512; col0 = 128 * hb; }
    else if (hb == 4) { off = WS_KA; ldc = 128; col0 = 0; }
    else if (hb == 5) { off = WS_VA; ldc = 128; col0 = 0; }
    else if (hb < 10) { off = WS_QB; ldc = 512; col0 = 128 * (hb - 6); }
    else if (hb < 14) { off = WS_KB; ldc = 512; col0 = 128 * (hb - 10); }
    else if (hb < 18) { off = WS_VB; ldc = 512; col0 = 128 * (hb - 14); }
    else if (hb < 26) { off = WS_SGA; ldc = 1024; col0 = 128 * (hb - 18); }
    else { off = WS_SGB; ldc = 1024; col0 = 128 * (hb - 26); }
}
__device__ __forceinline__ int proj_rowmap(int n) { const int hb = n >> 7; if (proj_mode(hb) > 1) return n; const int d = n & 63; return (n & ~63) + 8 * ((d & 31) >> 2) + 4 * (d >> 5) + (d & 3); }

template <int RMODE> __device__ __forceinline__ void p0_transpose_item(const float* W, int K, int N, bf16* WT, const float* kscale, LAS float* scr, int item, int lane, int pitch = 0, int koff = 0) {
    if (pitch == 0) pitch = K;
    const int nblk = N / 32, kb = item / nblk, nb = item % nblk, k0 = 64 * kb, n0 = 32 * nb;
#pragma unroll 8
    for (int i = 0; i < 32; ++i) { const int kk = 2 * i + (lane >> 5); float v = W[(size_t)(k0 + kk) * N + n0 + (lane & 31)]; if (kscale) v *= kscale[k0 + kk]; scr[kk * 33 + (lane & 31)] = v; }
    LDS_WAIT(); asm volatile("" ::: "memory");
    const int c = lane & 7;
#pragma unroll
    for (int j = 0; j < 4; ++j) { const int n = (lane >> 3) + 8 * j; const LAS float* s = scr + (8 * c) * 33 + n;
        v4u o; o.x = pk2(s[0 * 33], s[1 * 33]); o.y = pk2(s[2 * 33], s[3 * 33]); o.z = pk2(s[4 * 33], s[5 * 33]); o.w = pk2(s[6 * 33], s[7 * 33]);
        const int drow = RMODE ? proj_rowmap(n0 + n) : (n0 + n);
        *(GAS v4u*)(WT + (size_t)drow * pitch + koff + k0 + 8 * c) = o; }
    LDS_WAIT(); asm volatile("" ::: "memory");
}
struct Fp8Item { const float* W; unsigned char* WT; const float* kscale; int K, N, k0, n0; };
__device__ __forceinline__ Fp8Item fp8_item_make(const float* W, int K, int N, unsigned char* WT, const float* kscale, int item) {
    const int nblk = N / 32, kb = item / nblk, nb = item % nblk; Fp8Item it{W, WT, kscale, K, N, 128 * kb, 32 * nb}; return it; }
__device__ __forceinline__ void fp8_item_load(const Fp8Item& it, f32x4 (&v)[4][4], f32x4 (&ksv)[4], int lane) {
    const int n4 = lane & 7, kq = lane >> 3;
#pragma unroll
    for (int p = 0; p < 4; ++p)
#pragma unroll
        for (int r = 0; r < 4; ++r) v[p][r] = __builtin_nontemporal_load((const GAS f32x4*)(it.W + (size_t)(it.k0 + 32 * p + 4 * kq + r) * it.N + it.n0 + 4 * n4));
#pragma unroll
    for (int p = 0; p < 4; ++p) ksv[p] = it.kscale ? *(const GAS f32x4*)(it.kscale + it.k0 + 32 * p + 4 * kq) : (f32x4){1.f, 1.f, 1.f, 1.f};
}
__device__ __forceinline__ void fp8_item_finish(const Fp8Item& it, const f32x4 (&v)[4][4], const f32x4 (&ksv)[4], float scale, LAS unsigned* scr, int lane) {
    const int n4 = lane & 7, kq = lane >> 3;
#pragma unroll
    for (int p = 0; p < 4; ++p) { float ks[4];
#pragma unroll
        for (int r = 0; r < 4; ++r) ks[r] = ksv[p][r] * scale;
#pragma unroll
        for (int j = 0; j < 4; ++j) { int w = 0; w = __builtin_amdgcn_cvt_pk_fp8_f32(v[p][0][j] * ks[0], v[p][1][j] * ks[1], w, false); w = __builtin_amdgcn_cvt_pk_fp8_f32(v[p][2][j] * ks[2], v[p][3][j] * ks[3], w, true);
            scr[(8 * p + kq) * 33 + 4 * n4 + j] = (unsigned)w; } }
    LDS_WAIT(); asm volatile("" ::: "memory");
    const int c = lane & 7, nn = lane >> 3;
#pragma unroll
    for (int i = 0; i < 4; ++i) { const int n = nn + 8 * i; const LAS unsigned* sp = scr + (4 * c) * 33 + n;
        v4u o; o.x = sp[0]; o.y = sp[33]; o.z = sp[66]; o.w = sp[99];
        __builtin_nontemporal_store(o, (GAS v4u*)(it.WT + (size_t)(it.n0 + n) * it.K + it.k0 + 16 * c)); }
    LDS_WAIT(); asm volatile("" ::: "memory");
}
__device__ __forceinline__ void rms_rows2_to_bf16(const float* xrow, const float* g, bf16* orow, float* invr, int lane) {
    const GAS f32x4* xr = (const GAS f32x4*)xrow + lane;
    f32x4 v[2][4]; float s[2] = {0.f, 0.f};
#pragma unroll
    for (int q = 0; q < 2; ++q)
#pragma unroll
        for (int j = 0; j < 4; ++j) v[q][j] = __builtin_nontemporal_load(xr + q * (D / 4) + 64 * j);
#pragma unroll
    for (int q = 0; q < 2; ++q)
#pragma unroll
        for (int j = 0; j < 4; ++j) s[q] += (v[q][j].x * v[q][j].x + v[q][j].y * v[q][j].y) + (v[q][j].z * v[q][j].z + v[q][j].w * v[q][j].w);
    f32x4 gg[4];
#pragma unroll
    for (int j = 0; j < 4; ++j) gg[j] = ((const GAS f32x4*)g)[lane + 64 * j];
#pragma unroll
    for (int q = 0; q < 2; ++q) { const float rt_ = sqrtf(wave_sum(s[q]) * (1.f / D) + RMS_EPS), rstd = 1.f / rt_; if (lane == 0) invr[q] = rt_;
        GAS unsigned long long* o8 = (GAS unsigned long long*)(orow + (size_t)q * D) + lane;
#pragma unroll
        for (int j = 0; j < 4; ++j) o8[64 * j] = (unsigned long long)pk2(v[q][j].x * rstd * gg[j].x, v[q][j].y * rstd * gg[j].y) | ((unsigned long long)pk2(v[q][j].z * rstd * gg[j].z, v[q][j].w * rstd * gg[j].w) << 32); }
}
__device__ __forceinline__ void p0_prologue(Frame& F) {
    LAS float* scr = (LAS float*)(F.lds + RING_OFF + F.wave * 16384);
    const int gw = F.vcu * NWAVES + F.wave, NGW = F.G * NWAVES;
    const float* w_in = F.in[2];
    bf16* WIN = (bf16*)(F.ws + WS_WIN);
    constexpr int I_IN = (D / 64) * (INW / 32);
    constexpr int NITEMS = I_IN;
    for (int it = gw; it < NITEMS; it += NGW) {
        p0_transpose_item<1>(w_in, D, INW, WIN, nullptr, scr, it, F.lane);
    }
    bf16* XN = (bf16*)(F.ws + WS_XN);
    for (int m = 2 * gw; m < M; m += 2 * NGW) rms_rows2_to_bf16(F.in[0] + (size_t)m * D, F.in[1], XN + (size_t)m * D, (float*)(F.ws + WS_RS0) + m, F.lane);
    const int gt = F.vcu * (NWAVES * 64) + F.tid, NGT = F.G * NWAVES * 64;
    unsigned* rope = (unsigned*)(F.ws + WS_ROPE);
    for (int idx = gt; idx < SEQ * 32; idx += NGT) { const int s = idx >> 5, i = idx & 31; const float ang = (float)s * INV_FREQ[i];
        const double rev = (double)ang * 0.15915494309189535; const double fr = rev - rint(rev);
        rope[idx] = pk2(__builtin_amdgcn_cosf((float)fr), __builtin_amdgcn_sinf((float)fr)); }
    v4u* rwf = (v4u*)(F.ws + WS_RWF);
    for (int idx = gt; idx < 64 * 64; idx += NGT) { const int ks = idx >> 6, ln = idx & 63, e = ln & 31, kb = 16 * ks + 8 * (ln >> 5);
        float v[8]; unsigned h[8], l[8];
#pragma unroll
        for (int j = 0; j < 8; ++j) { v[j] = F.in[13][kb + j] * F.in[14][(size_t)(kb + j) * NE + e]; h[j] = f2bf(v[j]); l[j] = f2bf(v[j] - __uint_as_float(h[j] << 16)); }
        v4u oh, ol; oh.x = h[0] | (h[1] << 16); oh.y = h[2] | (h[3] << 16); oh.z = h[4] | (h[5] << 16); oh.w = h[6] | (h[7] << 16);
        ol.x = l[0] | (l[1] << 16); ol.y = l[2] | (l[3] << 16); ol.z = l[4] | (l[5] << 16); ol.w = l[6] | (l[7] << 16);
        rwf[idx] = oh; rwf[4096 + idx] = ol; }
}

__device__ __forceinline__ Fp8Item moe_item(const float* w1, const float* w2, const float* wo, const float* waa, const float* wab, unsigned char* W1, unsigned char* W2, unsigned char* WO, unsigned char* WA, const float* g, int r) {
    constexpr int I_1 = (D / 128) * (2 * FF / 32), I_2 = (FF / 128) * (D / 32);
    if (r < NE * I_1) { const int e = r / I_1; return fp8_item_make(w1 + (size_t)e * D * 2 * FF, D, 2 * FF, W1 + (size_t)e * 2 * FF * D, g, r % I_1); }
    const int r2 = r - NE * I_1, e = r2 / I_2;
    if (e <= NE) return fp8_item_make(e < NE ? w2 + (size_t)e * FF * D : wo, FF, D, e < NE ? W2 + (size_t)e * D * FF : WO, nullptr, r2 % I_2);
    const int r3 = r2 - (NE + 1) * I_2, hb = r3 >> 7;
    return fp8_item_make(hb ? wab : waa, D, D, WA + 512 * hb, nullptr, r3 & 127);
}
__device__ __forceinline__ void moe_weight_convert(Frame& F, int gw, int NGW, LAS unsigned* scr) {
    constexpr int NIT = NE * ((D / 128) * (2 * FF / 32) + (FF / 128) * (D / 32)) + 2 * (FF / 128) * (D / 32);
    const float* w1 = F.in[16]; const float* w2 = F.in[18]; const float* wo = F.in[12]; unsigned char* W1 = F.ws + WS_W1; unsigned char* W2 = F.ws + WS_W2; unsigned char* WO = F.ws + WS_WO; unsigned char* WA = F.ws + WS_WA; const float* waa = F.in[10]; const float* wab = F.in[11]; const float* g = F.in[13];
    int ra = gw, rb = gw + NGW;
    if (ra >= NIT) return;
    Fp8Item a = moe_item(w1, w2, wo, waa, wab, W1, W2, WO, WA, g, ra), b = moe_item(w1, w2, wo, waa, wab, W1, W2, WO, WA, g, rb < NIT ? rb : NIT - 1);
    f32x4 va[4][4], vb[4][4], ka[4], kb[4];
    fp8_item_load(a, va, ka, F.lane); fp8_item_load(b, vb, kb, F.lane);
#pragma unroll 1
    for (;;) {
        fp8_item_finish(a, va, ka, SW, scr, F.lane);
        ra += 2 * NGW; const bool more_a = ra < NIT;
        a = moe_item(w1, w2, wo, waa, wab, W1, W2, WO, WA, g, more_a ? ra : NIT - 1); fp8_item_load(a, va, ka, F.lane);
        if (rb < NIT) fp8_item_finish(b, vb, kb, SW, scr, F.lane);
        rb += 2 * NGW; const bool more_b = rb < NIT;
        b = moe_item(w1, w2, wo, waa, wab, W1, W2, WO, WA, g, more_b ? rb : NIT - 1); fp8_item_load(b, vb, kb, F.lane);
        if (!more_a) break;
    }
    asm volatile("s_waitcnt vmcnt(0)" ::: "memory");
}
struct EpiProj {
    static constexpr bool MID = false;
    unsigned char* ws; const float* bias; const unsigned* rope; int noepi;
    __device__ __forceinline__ void operator()(const pg8::f32x4 (&acc)[2][2][4][2], const pg8::Unit& u, int, int wr, int wc, int fr, int fq) const {
        using namespace pg8;
        if (noepi) { asm volatile("s_waitcnt vmcnt(0)" ::: "memory"); return; }
        const int hb0 = 2 * u.pn, m0 = proj_mode(hb0), m1 = proj_mode(hb0 + 1);
        const int dlo = 4 * (4 * (wc & 1) + fq);
        u32x4 cs[2][4];
        if (m0 <= 1 || m1 <= 1) {
#pragma unroll
            for (int ai = 0; ai < 2; ++ai)
#pragma unroll
                for (int m = 0; m < 4; ++m) { const int s = (u.pm * BM + ai * HALF + wr * 64 + m * 16 + fr) & (SEQ - 1);
                    cs[ai][m] = *(const u32x4*)(rope + (size_t)(s * 32 + dlo)); }
        }
        f32x4 bv[2][2];
#pragma unroll
        for (int bj = 0; bj < 2; ++bj) { const int hb = hb0 + bj, mode = bj ? m1 : m0; const float* bp = bias + 128 * hb + (mode <= 1 ? 64 * (wc >> 1) + dlo : wc * 32 + 8 * fq);
            bv[bj][0] = *(const f32x4*)bp; bv[bj][1] = *(const f32x4*)(bp + (mode <= 1 ? 32 : 4)); }
#pragma unroll
        for (int bj = 0; bj < 2; ++bj) {
            const int hb = hb0 + bj, mode = bj ? m1 : m0; size_t off; int ldc, col0; proj_dst(hb, off, ldc, col0);
            bf16_t* dst = (bf16_t*)(ws + off);
            if (mode <= 1) {
                const int hcol = col0 + 64 * (wc >> 1);
                const float sc = mode == 0 ? QSCALE : 1.f;
#pragma unroll
                for (int ai = 0; ai < 2; ++ai)
#pragma unroll
                    for (int m = 0; m < 4; ++m) { const int row = u.pm * BM + ai * HALF + wr * 64 + m * 16 + fr;
                        const u32x4 cw = cs[ai][m];
                        const f32x4 x1 = acc[ai][bj][m][0] + bv[bj][0], x2 = acc[ai][bj][m][1] + bv[bj][1];
                        const f32x4 c = {bf_lo(cw.x), bf_lo(cw.y), bf_lo(cw.z), bf_lo(cw.w)}, sn = {bf_hi(cw.x), bf_hi(cw.y), bf_hi(cw.z), bf_hi(cw.w)};
                        const f32x4 o1 = (x1 * c - x2 * sn) * sc, o2 = (x2 * c + x1 * sn) * sc;
                        bf16_t* rp = dst + (size_t)row * ldc + hcol + dlo;
                        u32x2 w1, w2; w1.x = cvt_pk_bf16(o1[0], o1[1]); w1.y = cvt_pk_bf16(o1[2], o1[3]); w2.x = cvt_pk_bf16(o2[0], o2[1]); w2.y = cvt_pk_bf16(o2[2], o2[3]);
                        *(u32x2*)rp = w1; *(u32x2*)(rp + 32) = w2; }
            } else {
                const int c8 = wc * 32 + 8 * fq;
#pragma unroll
                for (int ai = 0; ai < 2; ++ai)
#pragma unroll
                    for (int m = 0; m < 4; ++m) { const int row = u.pm * BM + ai * HALF + wr * 64 + m * 16 + fr;
                        f32x4 v0 = acc[ai][bj][m][0] + bv[bj][0], v1 = acc[ai][bj][m][1] + bv[bj][1];
                        if (mode == 3) {
                            unsigned w0 = 0u, w1 = 0u;
#pragma unroll
                            for (int j = 0; j < 4; ++j) { w0 |= (unsigned)(int)(sigm(v0[j]) * 255.f + 0.5f) << (8 * j); w1 |= (unsigned)(int)(sigm(v1[j]) * 255.f + 0.5f) << (8 * j); }
                            u32x2 w; w.x = w0; w.y = w1; *(u32x2*)((unsigned char*)dst + (size_t)row * ldc + col0 + c8) = w;
                        } else {
                        u32x4 w; w.x = cvt_pk_bf16(v0[0], v0[1]); w.y = cvt_pk_bf16(v0[2], v0[3]); w.z = cvt_pk_bf16(v1[0], v1[1]); w.w = cvt_pk_bf16(v1[2], v1[3]);
                        *(u32x4*)(dst + (size_t)row * ldc + col0 + c8) = w; } }
            }
        }
    }
};
__device__ __forceinline__ unsigned pk4_fp8(float a, float b, float c, float d) { int w = 0; w = __builtin_amdgcn_cvt_pk_fp8_f32(a, b, w, false); w = __builtin_amdgcn_cvt_pk_fp8_f32(c, d, w, true); return (unsigned)w; }
__device__ __forceinline__ float clamp8(float v) { return __builtin_amdgcn_fmed3f(v, -448.f, 448.f); }
struct EpiGateFused {
    static constexpr bool MID = true;
    unsigned char* T; const unsigned char* sga; const unsigned char* sgb;
    __device__ __forceinline__ void mid(pg8::f32x4 (&acc)[2][2][4][2], const pg8::Unit& u, int wr, int wc, int fr, int fq) const {
        using namespace pg8;
        u32x2 ga[2][4][2], gb[2][4][2];
#pragma unroll
        for (int ai = 0; ai < 2; ++ai)
#pragma unroll
            for (int m = 0; m < 4; ++m)
#pragma unroll
                for (int bj = 0; bj < 2; ++bj) { const size_t o = (size_t)(u.pm * BM + ai * HALF + wr * 64 + m * 16 + fr) * D + u.pn * BM + wc * 32 + 8 * fq + bj * HALF;
                    ga[ai][m][bj] = *(const u32x2*)(sga + o); gb[ai][m][bj] = *(const u32x2*)(sgb + o); }
#pragma unroll
        for (int ai = 0; ai < 2; ++ai)
#pragma unroll
            for (int m = 0; m < 4; ++m)
#pragma unroll
                for (int bj = 0; bj < 2; ++bj)
#pragma unroll
                    for (int n = 0; n < 2; ++n) { const unsigned a = n ? ga[ai][m][bj].y : ga[ai][m][bj].x, b = n ? gb[ai][m][bj].y : gb[ai][m][bj].x; f32x4 r;
#pragma unroll
                        for (int j = 0; j < 4; ++j) { const unsigned bb = (b >> (8 * j)) & 0xffu; r[j] = (float)((a >> (8 * j)) & 0xffu) * __builtin_amdgcn_rcpf((float)(bb ? bb : 1u)); }
                        acc[ai][bj][m][n] = acc[ai][bj][m][n] * r; }
    }
    __device__ __forceinline__ void operator()(const pg8::f32x4 (&acc)[2][2][4][2], const pg8::Unit& u, int, int wr, int wc, int fr, int fq) const {
        using namespace pg8;
        u32x2 gb[2][4][2];
#pragma unroll
        for (int ai = 0; ai < 2; ++ai)
#pragma unroll
            for (int m = 0; m < 4; ++m)
#pragma unroll
                for (int bj = 0; bj < 2; ++bj) gb[ai][m][bj] = *(const u32x2*)(sgb + (size_t)(u.pm * BM + ai * HALF + wr * 64 + m * 16 + fr) * D + u.pn * BM + wc * 32 + 8 * fq + bj * HALF);
#pragma unroll
        for (int ai = 0; ai < 2; ++ai)
#pragma unroll
            for (int m = 0; m < 4; ++m)
#pragma unroll
                for (int bj = 0; bj < 2; ++bj) { const size_t o = (size_t)(u.pm * BM + ai * HALF + wr * 64 + m * 16 + fr) * D + u.pn * BM + wc * 32 + 8 * fq + bj * HALF;
                    const u32x2 g2 = gb[ai][m][bj]; const f32x4 a0 = acc[ai][bj][m][0] * (ST / (255.f * SO * SW)), a1 = acc[ai][bj][m][1] * (ST / (255.f * SO * SW));
                    float g[8];
#pragma unroll
                    for (int j = 0; j < 4; ++j) { const unsigned b0 = (g2.x >> (8 * j)) & 0xffu, b1 = (g2.y >> (8 * j)) & 0xffu; g[j] = (float)(b0 ? b0 : 1u); g[4 + j] = (float)(b1 ? b1 : 1u); }
                    u32x2 w; w.x = pk4_fp8(clamp8(a0[0] * g[0]), clamp8(a0[1] * g[1]), clamp8(a0[2] * g[2]), clamp8(a0[3] * g[3])); w.y = pk4_fp8(clamp8(a1[0] * g[4]), clamp8(a1[1] * g[5]), clamp8(a1[2] * g[6]), clamp8(a1[3] * g[7]));
                    *(u32x2*)(T + o) = w; }
    }
};
struct EpiX1 {
    static constexpr bool MID = false;
    const pg8::bf16_t* xn; const float* invr; const float* g0; pg8::bf16_t* x1; unsigned char* x1q;
    __device__ __forceinline__ void operator()(const pg8::f32x4 (&acc)[2][2][4][2], const pg8::Unit& u, int, int wr, int wc, int fr, int fq) const {
        using namespace pg8;
        f32x4 gi[2][2];
#pragma unroll
        for (int bj = 0; bj < 2; ++bj) { const float* gp = g0 + u.pn * BM + wc * 32 + 8 * fq + bj * HALF; gi[bj][0] = *(const f32x4*)gp; gi[bj][1] = *(const f32x4*)(gp + 4); }
#pragma unroll
        for (int ai = 0; ai < 2; ++ai) {
            u32x4 xv[4][2]; float ir[4];
#pragma unroll
            for (int m = 0; m < 4; ++m) { const int row = u.pm * BM + ai * HALF + wr * 64 + m * 16 + fr; ir[m] = invr[row];
#pragma unroll
                for (int bj = 0; bj < 2; ++bj) xv[m][bj] = *(const u32x4*)(xn + (size_t)row * D + u.pn * BM + wc * 32 + 8 * fq + bj * HALF); }
            if (ai == 0) {
#pragma unroll
                for (int bj = 0; bj < 2; ++bj)
#pragma unroll
                    for (int q = 0; q < 2; ++q)
#pragma unroll
                        for (int j = 0; j < 4; ++j) gi[bj][q][j] = __builtin_amdgcn_rcpf(gi[bj][q][j]); }
#pragma unroll
            for (int m = 0; m < 4; ++m)
#pragma unroll
                for (int bj = 0; bj < 2; ++bj) { const size_t o = (size_t)(u.pm * BM + ai * HALF + wr * 64 + m * 16 + fr) * D + u.pn * BM + wc * 32 + 8 * fq + bj * HALF;
                    const u32x4 xw = xv[m][bj]; const float r_ = ir[m];
                    const f32x4 x0 = (f32x4){bf_lo(xw.x), bf_hi(xw.x), bf_lo(xw.y), bf_hi(xw.y)} * gi[bj][0] * r_, x1v = (f32x4){bf_lo(xw.z), bf_hi(xw.z), bf_lo(xw.w), bf_hi(xw.w)} * gi[bj][1] * r_;
                    const f32x4 v0 = x0 + acc[ai][bj][m][0] * (1.f / (ST * SW)), v1 = x1v + acc[ai][bj][m][1] * (1.f / (ST * SW));
                    u32x4 wb; wb.x = cvt_pk_bf16(v0[0], v0[1]); wb.y = cvt_pk_bf16(v0[2], v0[3]); wb.z = cvt_pk_bf16(v1[0], v1[1]); wb.w = cvt_pk_bf16(v1[2], v1[3]);
                    *(u32x4*)(x1 + o) = wb;
                    u32x2 w; w.x = pk4_fp8(clamp8(v0[0] * SX), clamp8(v0[1] * SX), clamp8(v0[2] * SX), clamp8(v0[3] * SX)); w.y = pk4_fp8(clamp8(v1[0] * SX), clamp8(v1[1] * SX), clamp8(v1[2] * SX), clamp8(v1[3] * SX));
                    *(u32x2*)(x1q + o) = w; }
        }
    }
};
template <int NCT, bool GATHER> struct GroupSched {
    const LAS int* sch; const LAS unsigned short* gtab; int G, c;
    __device__ __forceinline__ bool next(int i, pg8::Unit& u) const {
        const int L = i * G + c; if (L >= sch[32] * NCT) return false;
        int e = 0;
#pragma unroll 1
        for (int j = 16; j >= 1; j >>= 1) if (sch[e + j] * NCT <= L) e += j;
        const int local = L - sch[e] * NCT; u.e = e; u.pm = local / NCT; u.pn = local % NCT; u.cnt = sch[64 + e]; return true;
    }
    __device__ __forceinline__ int arow(int ui, const pg8::Unit& u, int r) const { if (GATHER) return (int)gtab[ui * 256 + r]; return (sch[u.e] + u.pm) * 256 + r; }
    __device__ __forceinline__ size_t boff(const pg8::Unit& u, int RB) const {
        if (GATHER) return ((size_t)u.e * 2 * FF + (size_t)u.pn * 128) * RB;
        return ((size_t)u.e * D + (size_t)u.pn * 256) * RB; }
    __device__ __forceinline__ int fetch(int) const { return 0; }
    __device__ __forceinline__ void post(int, int) const {}
};
struct EpiMoe1 {
    static constexpr bool MID = false;
    unsigned char* H; const float* b1; const float* ers; const LAS int* sch; int noepi;
    __device__ __forceinline__ void operator()(const pg8::f32x4 (&acc)[2][2][4][2], const pg8::Unit& u, int, int wr, int wc, int fr, int fq) const {
        using namespace pg8;
        if (noepi) { asm volatile("s_waitcnt vmcnt(0)" ::: "memory"); return; }
        const int j0 = u.pn * 128 + wc * 32 + 8 * fq; const float* bb = b1 + (size_t)u.e * 2 * FF + j0;
        const f32x4 bg0 = *(const f32x4*)bb, bg1 = *(const f32x4*)(bb + 4), bu0 = *(const f32x4*)(bb + FF), bu1 = *(const f32x4*)(bb + FF + 4);
        const int hrow0 = (sch[u.e] + u.pm) * 256;
        float rsv[2][4];
#pragma unroll
        for (int ai = 0; ai < 2; ++ai)
#pragma unroll
            for (int m = 0; m < 4; ++m) { const int slot = u.pm * 256 + ai * HALF + wr * 64 + m * 16 + fr; rsv[ai][m] = ers[(size_t)u.e * M + (slot < u.cnt ? slot : u.cnt - 1)]; }
#pragma unroll
        for (int ai = 0; ai < 2; ++ai)
#pragma unroll
            for (int m = 0; m < 4; ++m) { const int rl = ai * HALF + wr * 64 + m * 16 + fr, slot = u.pm * 256 + rl;
                const float rs = rsv[ai][m] * (1.f / (SX * SW));
                const f32x4 g0 = acc[ai][0][m][0] * rs + bg0, g1 = acc[ai][0][m][1] * rs + bg1, u0 = acc[ai][1][m][0] * rs + bu0, u1 = acc[ai][1][m][1] * rs + bu1;
                f32x4 gg[2] = {g0, g1}, uu[2] = {u0, u1}, rr[2];
#pragma unroll
                for (int q = 0; q < 2; ++q) { f32x4 g = gg[q], t;
#pragma unroll
                    for (int j = 0; j < 4; ++j) { g[j] = fminf(g[j], 7.f); uu[q][j] = __builtin_amdgcn_fmed3f(uu[q][j], -7.f, 7.f); }
                    t = g * (-1.702f * LOG2E);
#pragma unroll
                    for (int j = 0; j < 4; ++j) t[j] = __builtin_amdgcn_exp2f(t[j]);
                    t = t + 1.f;
#pragma unroll
                    for (int j = 0; j < 4; ++j) t[j] = __builtin_amdgcn_rcpf(t[j]);
                    rr[q] = (g * t) * (uu[q] * SH + SH); }
                u32x2 w; w.x = pk4_fp8(rr[0][0], rr[0][1], rr[0][2], rr[0][3]); w.y = pk4_fp8(rr[1][0], rr[1][1], rr[1][2], rr[1][3]);
                *(u32x2*)(H + (size_t)(hrow0 + rl) * FF + j0) = w; }
    }
};
struct EpiMoe2 {
    static constexpr bool MID = false;
    unsigned char* Y; const float* b2; const int* etok; const float* ew; int noepi;
    __device__ __forceinline__ void operator()(const pg8::f32x4 (&acc)[2][2][4][2], const pg8::Unit& u, int, int wr, int wc, int fr, int fq) const {
        using namespace pg8;
        if (noepi) { asm volatile("s_waitcnt vmcnt(0)" ::: "memory"); return; }
        const int c0 = u.pn * 256 + wc * 32 + 8 * fq; const float* bb = b2 + (size_t)u.e * D + c0;
        f32x4 bv[2][2];
#pragma unroll
        for (int bj = 0; bj < 2; ++bj) { bv[bj][0] = *(const f32x4*)(bb + bj * HALF); bv[bj][1] = *(const f32x4*)(bb + bj * HALF + 4); }
        int tkv[2][4]; float wv[2][4];
#pragma unroll
        for (int ai = 0; ai < 2; ++ai)
#pragma unroll
            for (int m = 0; m < 4; ++m) { const int slot = u.pm * 256 + ai * HALF + wr * 64 + m * 16 + fr; const size_t o = (size_t)u.e * M + (slot < u.cnt ? slot : u.cnt - 1);
                const int t_ = etok[o]; tkv[ai][m] = slot < u.cnt ? t_ : M * 4; wv[ai][m] = ew[o]; }
#pragma unroll
        for (int ai = 0; ai < 2; ++ai)
#pragma unroll
            for (int m = 0; m < 4; ++m) { const int slot = u.pm * 256 + ai * HALF + wr * 64 + m * 16 + fr;
                const int tk = tkv[ai][m]; const float w8 = wv[ai][m]; (void)slot;
                {
#pragma unroll
                    for (int bj = 0; bj < 2; ++bj) { const f32x4 v0 = (acc[ai][bj][m][0] * (1.f / (SH * SW)) + bv[bj][0]) * (w8 * SY), v1 = (acc[ai][bj][m][1] * (1.f / (SH * SW)) + bv[bj][1]) * (w8 * SY);
                        u32x2 w; w.x = pk4_fp8(clamp8(v0[0]), clamp8(v0[1]), clamp8(v0[2]), clamp8(v0[3])); w.y = pk4_fp8(clamp8(v1[0]), clamp8(v1[1]), clamp8(v1[2]), clamp8(v1[3]));
                        *(u32x2*)(Y + (size_t)tk * D + c0 + bj * HALF) = w; } } }
    }
};

__device__ __forceinline__ void attn_phase_all(Frame& F, char* lds) {
    typedef attn_body::bf16 abf; using attn_body::attn_unit; using attn_body::attn_unit128;
    const int v = F.vcu;
    const abf* QA = (const abf*)(F.ws + WS_QA); const abf* KA = (const abf*)(F.ws + WS_KA); const abf* VA = (const abf*)(F.ws + WS_VA); unsigned char* O8 = F.ws + WS_O8;
    const abf* QB_ = (const abf*)(F.ws + WS_QB); const abf* KB = (const abf*)(F.ws + WS_KB); const abf* VB = (const abf*)(F.ws + WS_VB); abf* OD = (abf*)(F.ws + WS_OSWA) + 512;
    float lam; { const float p1 = F.in[5][F.lane] * F.in[6][F.lane], p2 = F.in[7][F.lane] * F.in[8][F.lane]; lam = __expf(wave_sum(p1)) - __expf(wave_sum(p2)) + 0.2f; }
    { const int vv = v;
        { const int bh = vv >> 3, h = bh & 3, b = bh >> 2, s = vv & 7;
#pragma unroll 1
          for (int i = 0; i < 4; ++i) { const int qb = (i >> 1) ? 15 - s : s, c = i & 1;
              attn_unit128<8>((long)b * SEQ, qb * 256, QB_ + (2 * h + c) * 64, KB + (2 * h + c) * 64, VB + h * 128, OD + h * 128, O8 + 512 + h * 128, c != 0, lam, F.in[9], lds); } }
        {
#pragma unroll 1
          for (int i = 0; i < 4; ++i) { const int un = 4 * vv + i, qb = un & 31, pj = (un >> 5) & 3, b = un >> 7, hq = 2 * pj;
              attn_unit<1, 128, 128, 8>((long)b * SEQ, qb * 128, QA + hq * 64, KA + (hq >> 2) * 64, VA + (hq >> 2) * 64, O8 + hq * 64, F.in[4][hq] * LOG2E, F.in[4][hq + 1] * LOG2E, lds); } }
    }
}

struct Args { const float* in[21]; float* out; unsigned char* ws; int ph_lo, ph_hi, noepi, pad; };
constexpr int N_PHASES = 10;
__global__ void __launch_bounds__(NWAVES * 64, 2) mk_fwd(Args args) {
    extern __shared__ __attribute__((aligned(16))) unsigned char lds[];
    Frame F;
    F.lds = (LAS unsigned char*)lds;
    F.MISC = (volatile LAS unsigned*)(F.lds + MISC_OFF);
    F.tid = threadIdx.x; F.lane = F.tid & 63; F.wave = __builtin_amdgcn_readfirstlane(F.tid >> 6);
    F.G = gridDim.x; { const int bx = blockIdx.x; F.vcu = (F.G % 8 == 0) ? (bx % 8) * (F.G / 8) + bx / 8 : bx; }
    F.ws = args.ws; F.ctl = (gu32*)(args.ws + WS_CTL); F.out = args.out;
#pragma unroll
    for (int i = 0; i < 21; ++i) F.in[i] = args.in[i];
    for (int u = F.tid; u < (LDS_BYTES - LDSCTL_OFF) / 4; u += NWAVES * 64) ((LAS unsigned*)(F.lds + LDSCTL_OFF))[u] = 0u;
    __syncthreads();
    const bool one = (args.ph_hi - args.ph_lo) > 1;
    XcdBarrier bar; bar.bar = (unsigned*)(F.ctl + CW_BAR); bar.x = 0; bar.st = nullptr;
    if (one) bar = xcd_barrier_post((unsigned*)(F.ctl + CW_BAR), F.MISC + 8);
    const int lo = args.ph_lo, hi = args.ph_hi;
#define IN(k) (lo <= (k) && (k) < hi)
#define SEAM(k) do { if (IN(k) && IN((k) + 1)) xcd_barrier(bar); } while (0)
    unsigned char* ws = F.ws;
    const LAS int* sch = (const LAS int*)(F.lds + SCHED_OFF);

    if (IN(0)) { p0_prologue(F); }
    SEAM(0);
    if (IN(1)) {
        pg8::Gemm g{ws + WS_XN, ws + WS_WIN, D * 2, (size_t)pg8::HALF * D * 2};
        if ((int)blockIdx.x < NCONV) { moe_weight_convert(F, (int)blockIdx.x * NWAVES + F.wave, NCONV * NWAVES, (LAS unsigned*)(F.lds + RING_OFF + F.wave * 16384)); __syncthreads(); }
        pg8::QueueOrder S; S.init(M, INW, (unsigned*)(F.ctl + CW_Q1), (volatile LAS int*)(F.MISC + 16), (int)(blockIdx.x & 7)); S.prime();
        EpiProj E{ws, F.in[3], (const unsigned*)(ws + WS_ROPE), args.noepi};
        pg8::gemm_phase<false>(F.lds + RING_OFF, g, S, E);
    }
    SEAM(1);
    if (IN(2)) { attn_phase_all(F, (char*)lds + RING_OFF); }
    SEAM(2);
    if (IN(4)) {
        pg8::StaticOrder S; S.init(M, D, F.G, (int)blockIdx.x);
        pg8::Gemm g{ws + WS_O8, ws + WS_WA, D, (size_t)pg8::HALF * D};
        EpiGateFused E{ws + WS_T, ws + WS_SGA, ws + WS_SGB};
        pg8::gemm_phase<true>(F.lds + RING_OFF, g, S, E);
    }
    SEAM(4);
    if (IN(5)) {
        pg8::Gemm g{ws + WS_T, ws + WS_WO, D, (size_t)pg8::HALF * D};
        pg8::StaticOrder S; S.init(M, D, F.G, (int)blockIdx.x);
        EpiX1 E{(const pg8::bf16_t*)(ws + WS_XN), (const float*)(ws + WS_RS0), F.in[1], (pg8::bf16_t*)(ws + WS_X1B), ws + WS_X1Q};
        pg8::gemm_phase<true>(F.lds + RING_OFF, g, S, E);
    }
    SEAM(5);
    if (IN(6)) {
        typedef float f32x16 __attribute__((ext_vector_type(16)));
        const int lane = F.lane, r32 = lane & 31, hi = lane >> 5;
        LAS int* wcnt = (LAS int*)(F.lds + RING_OFF);
        const int n_it = (M / 32) / (F.G * 4);
        for (int it = 0; it < n_it; ++it) {
            const int tile = (it * F.G + F.vcu) * 4 + (F.wave & 3), tok = tile * 32 + r32;
            int ti[4] = {0, 0, 0, 0}; float ex[4] = {0.f, 0.f, 0.f, 0.f}; float isum = 0.f, rstd = 0.f; int run0 = 0, run1 = 0, run2 = 0, run3 = 0;
            if (F.wave < 4) {
                const v4u* rwf = (const v4u*)(ws + WS_RWF);
                const pg8::bf16_t* xr = (const pg8::bf16_t*)(ws + WS_X1B) + (size_t)tok * D + 8 * hi;
                f32x16 acc = {}; float ss = 0.f;
#pragma unroll 8
                for (int ks = 0; ks < 64; ++ks) {
                    const v4u bh = *(const v4u*)(xr + 16 * ks);
                    ss += pg8::bf_lo(bh.x) * pg8::bf_lo(bh.x) + pg8::bf_hi(bh.x) * pg8::bf_hi(bh.x) + pg8::bf_lo(bh.y) * pg8::bf_lo(bh.y) + pg8::bf_hi(bh.y) * pg8::bf_hi(bh.y)
                        + pg8::bf_lo(bh.z) * pg8::bf_lo(bh.z) + pg8::bf_hi(bh.z) * pg8::bf_hi(bh.z) + pg8::bf_lo(bh.w) * pg8::bf_lo(bh.w) + pg8::bf_hi(bh.w) * pg8::bf_hi(bh.w);
                    const v4u ah = rwf[ks * 64 + lane], al = rwf[4096 + ks * 64 + lane];
                    acc = __builtin_amdgcn_mfma_f32_32x32x16_bf16(__builtin_bit_cast(bf16x8, ah), __builtin_bit_cast(bf16x8, bh), acc, 0, 0, 0);
                    acc = __builtin_amdgcn_mfma_f32_32x32x16_bf16(__builtin_bit_cast(bf16x8, al), __builtin_bit_cast(bf16x8, bh), acc, 0, 0, 0);
                }
                ss += __shfl_xor(ss, 32);
                rstd = 1.f / sqrtf(ss * (1.f / D) + RMS_EPS);
                float lg[32];
#pragma unroll
                for (int e = 0; e < 32; ++e) { const int he = (e >> 2) & 1, r = (e & 3) + 4 * (e >> 3); const float own = acc[r], oth = __shfl_xor(own, 32);
                    lg[e] = ((he == hi) ? own : oth) * rstd + F.in[15][e]; }
                float tv[4];
#pragma unroll
                for (int k = 0; k < 4; ++k) { float best = -3.0e38f; int bi = 0;
#pragma unroll
                    for (int e = 0; e < 32; ++e) { if (lg[e] > best) { best = lg[e]; bi = e; } }
                    tv[k] = best; ti[k] = bi;
#pragma unroll
                    for (int e = 0; e < 32; ++e) if (e == bi) lg[e] = -3.0e38f; }
                float sum = 0.f;
#pragma unroll
                for (int k = 0; k < 4; ++k) { ex[k] = __builtin_amdgcn_exp2f((tv[k] - tv[0]) * LOG2E); sum += ex[k]; }
                isum = 1.f / sum;
                const unsigned long long lt = (1ull << lane) - 1ull;
                int myc = 0;
#pragma unroll 1
                for (int e = 0; e < 32; ++e) {
                    const unsigned long long m0 = __ballot(hi == 0 && ti[0] == e), m1 = __ballot(hi == 0 && ti[1] == e), m2 = __ballot(hi == 0 && ti[2] == e), m3 = __ballot(hi == 0 && ti[3] == e);
                    const int c0 = __popcll(m0), c1 = __popcll(m1), c2 = __popcll(m2), c3 = __popcll(m3);
                    if (lane == e) myc = c0 + c1 + c2 + c3;
                    if (ti[0] == e) run0 = __popcll(m0 & lt);
                    if (ti[1] == e) run1 = c0 + __popcll(m1 & lt);
                    if (ti[2] == e) run2 = c0 + c1 + __popcll(m2 & lt);
                    if (ti[3] == e) run3 = c0 + c1 + c2 + __popcll(m3 & lt);
                }
                if (lane < 32) wcnt[F.wave * 32 + lane] = myc;
            }
            __syncthreads();
            if (F.wave == 0 && lane < 32) {
                const int c0 = wcnt[lane], c1 = wcnt[32 + lane], c2 = wcnt[64 + lane], c3 = wcnt[96 + lane], tot = c0 + c1 + c2 + c3;
                int base = 0; if (tot > 0) base = (int)__hip_atomic_fetch_add((unsigned*)(F.ctl + CW_CNT + 64 * lane), (unsigned)tot, RLX_AGENT);
                wcnt[128 + lane] = base; wcnt[160 + lane] = base + c0; wcnt[192 + lane] = base + c0 + c1; wcnt[224 + lane] = base + c0 + c1 + c2;
            }
            __syncthreads();
            if (F.wave < 4 && hi == 0) {
                int* etok = (int*)(ws + WS_ETOK); float* ew = (float*)(ws + WS_EW); float* ers = (float*)(ws + WS_ERS);
                const int pos[4] = {wcnt[128 + F.wave * 32 + ti[0]] + run0, wcnt[128 + F.wave * 32 + ti[1]] + run1, wcnt[128 + F.wave * 32 + ti[2]] + run2, wcnt[128 + F.wave * 32 + ti[3]] + run3};
#pragma unroll
                for (int k = 0; k < 4; ++k) { const size_t o = (size_t)ti[k] * M + pos[k];
                    etok[o] = tok * 4 + k; ew[o] = ex[k] * isum; ers[o] = rstd; }
            }
            __syncthreads();
        }
    }
    SEAM(6);
    if (IN(7) || IN(8)) {
        if (F.tid < 32) { ((LAS int*)sch)[64 + F.tid] = (int)__hip_atomic_load((unsigned*)(F.ctl + CW_CNT + 64 * F.tid), RLX_AGENT); }
        __syncthreads();
        if (F.tid == 0) { int a = 0; for (int e = 0; e < 32; ++e) { ((LAS int*)sch)[e] = a; a += (sch[64 + e] + 255) >> 8; } ((LAS int*)sch)[32] = a; }
        __syncthreads();
    }
    if (IN(7)) {
        const LAS unsigned short* gtab = (const LAS unsigned short*)(F.lds + GTAB_OFF);
        GroupSched<8, true> S{sch, gtab, F.G, F.vcu};
        { const int* etok = (const int*)(ws + WS_ETOK);
          int idx[17];
#pragma unroll
          for (int i = 0; i < 17; ++i) { pg8::Unit u; idx[i] = 0;
              if (S.next(i, u) && F.tid < 256) { const int slot = u.pm * 256 + F.tid; if (slot < u.cnt) idx[i] = etok[(size_t)u.e * M + slot] >> 2; } }
          if (F.tid < 256) {
#pragma unroll
              for (int i = 0; i < 17; ++i) ((LAS unsigned short*)gtab)[i * 256 + F.tid] = (unsigned short)idx[i]; } }
        VM_WAIT(); __syncthreads();
        pg8::Gemm g{ws + WS_X1Q, ws + WS_W1, D, (size_t)FF * D};
        EpiMoe1 E{ws + WS_H, F.in[17], (const float*)(ws + WS_ERS), sch, args.noepi};
        pg8::gemm_phase<true>(F.lds + RING_OFF, g, S, E);
    }
    SEAM(7);
    if (IN(8)) {
        GroupSched<4, false> S{sch, nullptr, F.G, F.vcu};
        pg8::Gemm g{ws + WS_H, ws + WS_W2, FF, (size_t)pg8::HALF * FF};
        EpiMoe2 E{ws + WS_Y, F.in[19], (const int*)(ws + WS_ETOK), (const float*)(ws + WS_EW), args.noepi};
        pg8::gemm_phase<true>(F.lds + RING_OFF, g, S, E);
    }
    SEAM(8);
    if (IN(9)) {
        unsigned poison = (__hip_atomic_load(F.ctl + CW_TMO, RLX_AGENT) != 0u) | (__hip_atomic_load((gu32*)((const unsigned*)(F.ctl + CW_BAR) + XB_TMO), RLX_AGENT) != 0u);
        const unsigned char* Y = ws + WS_Y; typedef float f32x2_ __attribute__((ext_vector_type(2)));
        const int gw = F.vcu * NWAVES + F.wave, NGW = F.G * NWAVES;
        f32x4 gfin[2][2];
#pragma unroll
        for (int j = 0; j < 2; ++j) { gfin[j][0] = *(const f32x4*)(F.in[20] + 8 * F.lane + 512 * j); gfin[j][1] = *(const f32x4*)(F.in[20] + 8 * F.lane + 512 * j + 4); }
        for (int m0 = 2 * gw; m0 < M; m0 += 2 * NGW) {
            v4u xa[2][2]; pg8::u32x2 yv[2][2][4];
#pragma unroll
            for (int q = 0; q < 2; ++q)
#pragma unroll
                for (int j = 0; j < 2; ++j) { const size_t c0 = 8 * F.lane + 512 * j; xa[q][j] = __builtin_nontemporal_load((const v4u*)((const pg8::bf16_t*)(ws + WS_X1B) + (size_t)(m0 + q) * D + c0));
#pragma unroll
                    for (int k = 0; k < 4; ++k) yv[q][j][k] = __builtin_nontemporal_load((const pg8::u32x2*)(Y + ((size_t)(m0 + q) * 4 + k) * D + c0)); }
#pragma unroll
            for (int q = 0; q < 2; ++q) { const int m = m0 + q;
                float v[2][8]; float ss = 0.f;
#pragma unroll
                for (int j = 0; j < 2; ++j) { const v4u a = xa[q][j];
                    v[j][0] = pg8::bf_lo(a.x); v[j][1] = pg8::bf_hi(a.x); v[j][2] = pg8::bf_lo(a.y); v[j][3] = pg8::bf_hi(a.y); v[j][4] = pg8::bf_lo(a.z); v[j][5] = pg8::bf_hi(a.z); v[j][6] = pg8::bf_lo(a.w); v[j][7] = pg8::bf_hi(a.w);
#pragma unroll
                    for (int k = 0; k < 4; ++k) { const pg8::u32x2 y = yv[q][j][k]; const f32x2_ a0 = __builtin_amdgcn_cvt_pk_f32_fp8((int)y.x, false), a1 = __builtin_amdgcn_cvt_pk_f32_fp8((int)y.x, true), a2 = __builtin_amdgcn_cvt_pk_f32_fp8((int)y.y, false), a3 = __builtin_amdgcn_cvt_pk_f32_fp8((int)y.y, true);
                        v[j][0] += a0.x * (1.f / SY); v[j][1] += a0.y * (1.f / SY); v[j][2] += a1.x * (1.f / SY); v[j][3] += a1.y * (1.f / SY); v[j][4] += a2.x * (1.f / SY); v[j][5] += a2.y * (1.f / SY); v[j][6] += a3.x * (1.f / SY); v[j][7] += a3.y * (1.f / SY); }
#pragma unroll
                    for (int t = 0; t < 8; ++t) ss += v[j][t] * v[j][t]; }
                float rstd = 1.f / sqrtf(wave_sum(ss) * (1.f / D) + RMS_EPS);
                if (poison) rstd = __builtin_nanf("");
#pragma unroll
                for (int j = 0; j < 2; ++j) { const size_t c0 = 8 * F.lane + 512 * j; const f32x4 g0 = gfin[j][0], g1 = gfin[j][1];
                    *(f32x4*)(F.out + (size_t)m * D + c0) = (f32x4){v[j][0] * rstd * g0[0], v[j][1] * rstd * g0[1], v[j][2] * rstd * g0[2], v[j][3] * rstd * g0[3]};
                    *(f32x4*)(F.out + (size_t)m * D + c0 + 4) = (f32x4){v[j][4] * rstd * g1[0], v[j][5] * rstd * g1[1], v[j][6] * rstd * g1[2], v[j][7] * rstd * g1[3]}; } }
        }
    }
#undef IN
#undef SEAM
}

#ifndef MK_REP
#define MK_REP -1
#endif
#ifndef MK_NOEPI
#define MK_NOEPI 0
#endif
#ifndef MK_CUTS
#define MK_CUTS 1
#endif
extern "C" void kernel_launch(void* const* d_in, const int* in_sizes, int n_in, void* d_out, int out_size, void* d_ws, size_t ws_size, hipStream_t stream) {
    static int grid = 0;
    if (grid == 0) {
        if (n_in != 21 || in_sizes[0] != M * D || out_size != M * D || ws_size < WS_END) { fprintf(stderr, "kernel_launch: unexpected shapes / workspace (n_in %d, ws %zu)\n", n_in, ws_size); grid = -1; return; }
        int dev = 0, cus = 0, per_cu = 0;
        if (hipGetDevice(&dev) != hipSuccess || hipDeviceGetAttribute(&cus, hipDeviceAttributeMultiprocessorCount, dev) != hipSuccess) { grid = -1; return; }
        if (hipFuncSetAttribute((const void*)mk_fwd, hipFuncAttributeMaxDynamicSharedMemorySize, LDS_BYTES) != hipSuccess) { fprintf(stderr, "kernel_launch: hipFuncSetAttribute failed\n"); grid = -1; return; }
        if (hipOccupancyMaxActiveBlocksPerMultiprocessor(&per_cu, (const void*)mk_fwd, NWAVES * 64, LDS_BYTES) != hipSuccess || per_cu < 1) { fprintf(stderr, "kernel_launch: occupancy query says %d\n", per_cu); }
        (void)hipGetLastError();
        grid = cus;
    }
    if (grid < 0) return;
    if (hipMemsetAsync((char*)d_ws + WS_CTL, 0, CTL_ZERO_BYTES, stream) != hipSuccess) return;
    Args a{};
    for (int i = 0; i < 21; ++i) a.in[i] = (const float*)d_in[i];
    a.out = (float*)d_out; a.ws = (unsigned char*)d_ws;
    if (MK_CUTS == 1) { a.ph_lo = 0; a.ph_hi = N_PHASES; hipLaunchKernelGGL(mk_fwd, dim3(grid), dim3(NWAVES * 64), LDS_BYTES, stream, a); }
    else for (int p = 0; p < N_PHASES; ++p) { a.ph_lo = p; a.ph_hi = p + 1; hipLaunchKernelGGL(mk_fwd, dim3(grid), dim3(NWAVES * 64), LDS_BYTES, stream, a);
        if (p == MK_REP) { if (p == 6) (void)hipMemsetAsync((char*)d_ws + WS_CTL, 0, CTL_ZERO_BYTES, stream); a.noepi = MK_NOEPI; hipLaunchKernelGGL(mk_fwd, dim3(grid), dim3(NWAVES * 64), LDS_BYTES, stream, a); a.noepi = 0; } }
}
```

```cpp
#include <hip/hip_runtime.h>
#include <hip/hip_bf16.h>
#include <cstdio>
#include <cstdint>
#include <cmath>
namespace pg8 {
#define PG8_LAS __attribute__((address_space(3)))
typedef unsigned short bf16_t;
typedef short bf16x8 __attribute__((ext_vector_type(8)));
typedef float f32x4 __attribute__((ext_vector_type(4)));
typedef float f32x2 __attribute__((ext_vector_type(2)));
typedef unsigned u32x4 __attribute__((ext_vector_type(4)));
typedef unsigned u32x2 __attribute__((ext_vector_type(2)));
typedef int v8i __attribute__((ext_vector_type(8)));
typedef int v4i __attribute__((ext_vector_type(4)));
constexpr int BM = 256, BK = 64, HALF = 128, HTB = HALF * BK * 2  , STAGE_BYTES = 8 * HTB, NXCD = 8, WGM = 8;

__host__ __device__ __forceinline__ int lds_byte(int r, int c) { const int st = (r >> 4) * 2 + (c >> 5), rr = r & 15, cc = c & 31, ob = rr * 64 + cc * 2; return st * 1024 + (ob ^ (((ob >> 9) & 1) << 5)); }
__host__ __device__ __forceinline__ void stage_rc(int b, int& R, int& C) { const int st = b / 1024, sb = b % 1024, swz = sb ^ (((sb >> 9) & 1) << 5); R = (st >> 1) * 16 + swz / 64; C = (st & 1) * 32 + (swz % 64) / 2; }
__host__ __device__ __forceinline__ int perm32(int rho) { const int n = rho >> 4, i = rho & 15; return 8 * (i >> 2) + 4 * n + (i & 3); }

struct Unit { int pm, pn, e, cnt; };
struct Gemm { const void* A; const void* Bt; int RB; size_t hstepB; };

struct StaticOrder {
    int nM, nN, nwg, G, c;
    __device__ void init(int M, int N, int G_, int c_) { nM = M / BM; nN = N / BM; nwg = nM * nN; G = G_; c = c_; }
    __device__ bool next(int i, Unit& u) const {
        const long L = (long)i * G + c; if (L >= nwg) return false;
        int wgid = (int)L; { const int q = nwg / NXCD, r = nwg % NXCD, xcd = wgid % NXCD, off = wgid / NXCD; wgid = (xcd < r ? xcd * (q + 1) : r * (q + 1) + (xcd - r) * q) + off; }
        const int nig = WGM * nN, gid = wgid / nig, fm = gid * WGM, gsz = (nM - fm) < WGM ? (nM - fm) : WGM;
        u.pm = fm + ((wgid % nig) % gsz); u.pn = (wgid % nig) / gsz; u.e = 0; u.cnt = 0; return true;
    }
    __device__ __forceinline__ int arow(int, const Unit& u, int r) const { return u.pm * BM + r; }
    __device__ __forceinline__ size_t boff(const Unit& u, int RB) const { return (size_t)u.pn * BM * RB; }
    __device__ __forceinline__ int fetch(int) const { return 0; }
    __device__ __forceinline__ void post(int, int) const {}
};
struct QueueOrder {
    int nM, nN, nwg; unsigned* ctr; volatile PG8_LAS int* mail;
    __device__ void init(int M, int N, unsigned* ctr_, volatile PG8_LAS int* mail_, int x_) { nM = M / BM; nN = N / BM; nwg = nM * nN; ctr = ctr_ + 64 * x_; mail = mail_; }
    __device__ void prime() const {
        if (threadIdx.x == 0) { const int t0_ = (int)__hip_atomic_fetch_add(ctr, 3u, __ATOMIC_RELAXED, __HIP_MEMORY_SCOPE_AGENT);
            for (int k = 0; k < 3; ++k) mail[k] = (int)(blockIdx.x & 7) + NXCD * (t0_ + k); }
        __syncthreads();
    }
    __device__ bool next(int i, Unit& u) const {
        const int L = __builtin_amdgcn_readfirstlane(mail[i & 3]); if (L >= nwg) return false;
        int wgid = L; { const int q = nwg / NXCD, r = nwg % NXCD, xcd = wgid % NXCD, off = wgid / NXCD; wgid = (xcd < r ? xcd * (q + 1) : r * (q + 1) + (xcd - r) * q) + off; }
        const int nig = WGM * nN, gid = wgid / nig, fm = gid * WGM, gsz = (nM - fm) < WGM ? (nM - fm) : WGM;
        u.pm = fm + ((wgid % nig) % gsz); u.pn = (wgid % nig) / gsz; u.e = 0; u.cnt = 0; return true;
    }
    __device__ __forceinline__ int arow(int, const Unit& u, int r) const { return u.pm * BM + r; }
    __device__ __forceinline__ size_t boff(const Unit& u, int RB) const { return (size_t)u.pn * BM * RB; }
    __device__ __forceinline__ int fetch(int) const { int v = 0; if (threadIdx.x == 0) v = (int)(blockIdx.x & 7) + NXCD * (int)__hip_atomic_fetch_add(ctr, 1u, __ATOMIC_RELAXED, __HIP_MEMORY_SCOPE_AGENT); return v; }
    __device__ __forceinline__ void post(int ui, int v) const { if (threadIdx.x == 0) mail[(ui + 3) & 3] = v; }
};

__device__ __forceinline__ unsigned cvt_pk_bf16(float lo, float hi) { unsigned r; asm volatile("v_cvt_pk_bf16_f32 %0, %1, %2" : "=v"(r) : "v"(lo), "v"(hi)); return r; }
__device__ __forceinline__ float bf_lo(unsigned w) { return __uint_as_float(w << 16); }
__device__ __forceinline__ float bf_hi(unsigned w) { return __uint_as_float(w & 0xffff0000u); }
__device__ __forceinline__ float sigm(float x) { return __builtin_amdgcn_rcpf(1.f + __builtin_amdgcn_exp2f(-1.4426950408889634f * x)); }

template <bool FP8, class Epi, class Sched>
__device__ __forceinline__ void gemm_phase(PG8_LAS unsigned char* lds, const Gemm g, const Sched& S, const Epi& E) {
    int tid = threadIdx.x; asm volatile("" : "+v"(tid));
    const int wid = __builtin_amdgcn_readfirstlane(tid >> 6), lane = tid & 63, wr = wid >> 2, wc = wid & 3, fr = lane & 15, fq = lane >> 4;
    const int RB = g.RB, nt = RB / (BK * 2);
    unsigned voffB[2];
#pragma unroll
    for (int i = 0; i < 2; ++i) { int R, C; stage_rc(tid * 16 + i * 8192, R, C); const int Rb = (R & ~31) + perm32(R & 31); voffB[i] = (unsigned)(Rb * RB + C * 2); }
    const size_t kstep = (size_t)(BK * 2);
    const size_t hstepB = g.hstepB;
    const unsigned ldsw = (unsigned)wid * 1024u;
    const int aoff = lds_byte(wr * 64 + fr, fq * 8), boff = lds_byte(wc * 32 + fr, fq * 8);
    constexpr int POFF = 1024;
#define PG8_SA(b, h) (((b) * 2 + (h)) * HTB)
#define PG8_SB(b, h) ((4 + (b) * 2 + (h)) * HTB)
#define PG8_STAGE(bufoff, gbase, voff) do { const char* gb_ = (const char*)(gbase); asm volatile("" : "+s"(gb_));     \
        _Pragma("unroll") for (int _i = 0; _i < 2; ++_i) { unsigned vo_ = (voff)[_i]; asm volatile("" : "+v"(vo_)); \
        __builtin_amdgcn_global_load_lds((const unsigned*)(gb_ + vo_), (PG8_LAS unsigned*)(lds + (bufoff) + ldsw + _i * 8192), 16, 0, 0); } } while (0)
#define PG8_LDA(dst, b, h) do { _Pragma("unroll") for (int m = 0; m < 4; ++m) { const v4i lo_ = *(const PG8_LAS v4i*)(lds + PG8_SA(b, h) + aoff + m * 2048), hi_ = *(const PG8_LAS v4i*)(lds + PG8_SA(b, h) + aoff + m * 2048 + POFF); \
        dst[m] = __builtin_shufflevector(lo_, hi_, 0, 1, 2, 3, 4, 5, 6, 7); } } while (0)
#define PG8_LDB(dst, b, h) do { _Pragma("unroll") for (int n = 0; n < 2; ++n) { const v4i lo_ = *(const PG8_LAS v4i*)(lds + PG8_SB(b, h) + boff + n * 2048), hi_ = *(const PG8_LAS v4i*)(lds + PG8_SB(b, h) + boff + n * 2048 + POFF); \
        dst[n] = __builtin_shufflevector(lo_, hi_, 0, 1, 2, 3, 4, 5, 6, 7); } } while (0)
#define PG8_MMA0(ai, bj, At, Bt) do { __builtin_amdgcn_s_setprio(1); _Pragma("unroll") for (int m = 0; m < 4; ++m) _Pragma("unroll") for (int n = 0; n < 2; ++n) { \
        asm volatile("v_mfma_f32_16x16x128_f8f6f4 %0, %1, %2, 0" : "=&v"(acc[ai][bj][m][n]) : "v"(Bt[n]), "v"(At[m])); } \
        __builtin_amdgcn_s_setprio(0); } while (0)
#define PG8_MMAZ(ai, bj, At, Bt) do { if (FP8 && t == 0) { PG8_MMA0(ai, bj, At, Bt); } else { PG8_MMA(ai, bj, At, Bt); } } while (0)
#define PG8_MMA(ai, bj, At, Bt) do { __builtin_amdgcn_s_setprio(1); _Pragma("unroll") for (int m = 0; m < 4; ++m) _Pragma("unroll") for (int n = 0; n < 2; ++n) { \
        if constexpr (FP8) asm volatile("v_mfma_f32_16x16x128_f8f6f4 %0, %1, %2, %0" : "+v"(acc[ai][bj][m][n]) : "v"(Bt[n]), "v"(At[m]));     \
        else { acc[ai][bj][m][n] = __builtin_amdgcn_mfma_f32_16x16x32_bf16(__builtin_bit_cast(bf16x8, __builtin_shufflevector(Bt[n], Bt[n], 0, 1, 2, 3)), __builtin_bit_cast(bf16x8, __builtin_shufflevector(At[m], At[m], 0, 1, 2, 3)), acc[ai][bj][m][n], 0, 0, 0); \
               acc[ai][bj][m][n] = __builtin_amdgcn_mfma_f32_16x16x32_bf16(__builtin_bit_cast(bf16x8, __builtin_shufflevector(Bt[n], Bt[n], 4, 5, 6, 7)), __builtin_bit_cast(bf16x8, __builtin_shufflevector(At[m], At[m], 4, 5, 6, 7)), acc[ai][bj][m][n], 0, 0, 0); } } \
        __builtin_amdgcn_s_setprio(0); } while (0)
#define PG8_WAIT_V(n) asm volatile("s_waitcnt vmcnt(" #n ")" ::: "memory")
#define PG8_WAIT_L(n) asm volatile("s_waitcnt lgkmcnt(" #n ")" ::: "memory")
#define PG8_BAR __builtin_amdgcn_s_barrier()
#define PG8_SCHED __builtin_amdgcn_sched_barrier(0)
#define PG8_OA(dst, ui_, u_) do { int t_ = threadIdx.x; asm volatile("" : "+v"(t_)); _Pragma("unroll") for (int _i = 0; _i < 2; ++_i) { int R_, C_; stage_rc(t_ * 16 + _i * 8192, R_, C_); \
        _Pragma("unroll") for (int _h = 0; _h < 2; ++_h) dst[_h][_i] = (unsigned)S.arow(ui_, u_, _h * HALF + R_) * (unsigned)RB + (unsigned)C_ * 2u; } } while (0)
    Unit cur, nxt; int ui = 0;
    if (!S.next(0, cur)) return;
    f32x4 acc[2][2][4][2];
#pragma unroll
    for (int a = 0; a < 2; ++a)
#pragma unroll
        for (int b = 0; b < 2; ++b)
#pragma unroll
            for (int m = 0; m < 4; ++m)
#pragma unroll
                for (int n = 0; n < 2; ++n) { if constexpr (!FP8) acc[a][b][m][n] = (f32x4){0.f, 0.f, 0.f, 0.f}; }
    v8i At[4], B0[2], B1[2];
    unsigned oaC[2][2];
    PG8_OA(oaC, 0, cur);
    const char* const gA = (const char*)g.A;
    const char* cB = (const char*)g.Bt + S.boff(cur, RB);
    PG8_STAGE(PG8_SB(0, 0), cB, voffB); PG8_STAGE(PG8_SB(0, 1), cB + hstepB, voffB); PG8_STAGE(PG8_SA(0, 0), gA, oaC[0]); PG8_STAGE(PG8_SA(0, 1), gA, oaC[1]);
    if (wr == 1) PG8_BAR;
    PG8_WAIT_V(2); PG8_BAR;
    PG8_STAGE(PG8_SB(1, 0), cB + kstep, voffB); PG8_STAGE(PG8_SA(1, 0), gA + kstep, oaC[0]); PG8_STAGE(PG8_SB(1, 1), cB + hstepB + kstep, voffB);
    PG8_WAIT_V(6); PG8_BAR;
    for (;;) {
        const bool has_next = S.next(ui + 1, nxt);
        const char* nB = has_next ? (const char*)g.Bt + S.boff(nxt, RB) : cB;
        for (int t = 0; t < nt; t += 2) {
            const bool last = (t == nt - 2);
            const bool first = (t == 0) && (ui > 0);
            if constexpr (Epi::MID) { if (t == nt / 2) { int fr_ = fr, fq_ = fq; asm volatile("" : "+v"(fr_), "+v"(fq_)); E.mid(acc, cur, wr, wc, fr_, fq_); } }
            const char* a1 = gA + (size_t)(t + 1) * kstep;
            const char* a2 = last ? gA : gA + (size_t)(t + 2) * kstep; const char* b2 = last ? nB : cB + (size_t)(t + 2) * kstep;
            const char* a3 = a2 + kstep; const char* b3 = b2 + kstep;
            unsigned o2[2][2];
#pragma unroll
            for (int h = 0; h < 2; ++h)
#pragma unroll
                for (int i = 0; i < 2; ++i) o2[h][i] = oaC[h][i];
            if (last && has_next) { PG8_OA(o2, ui + 1, nxt); }
            PG8_LDB(B0, 0, 0); PG8_LDB(B1, 0, 1); PG8_SCHED; PG8_LDA(At, 0, 0); if (!first) { PG8_STAGE(PG8_SA(1, 1), a1, oaC[1]); }
            if (!first) { PG8_WAIT_V(8); } PG8_WAIT_L(0); PG8_BAR; PG8_MMAZ(0, 0, At, B0); PG8_MMAZ(0, 1, At, B1); PG8_BAR; PG8_SCHED;
            PG8_LDA(At, 0, 1); PG8_STAGE(PG8_SB(0, 0), b2, voffB); PG8_STAGE(PG8_SB(0, 1), b2 + hstepB, voffB); PG8_STAGE(PG8_SA(0, 0), a2, o2[0]);
            if (!first) { PG8_WAIT_V(8); } PG8_WAIT_L(0); PG8_BAR; PG8_MMAZ(1, 0, At, B0); PG8_MMAZ(1, 1, At, B1); PG8_BAR; PG8_SCHED;
            PG8_LDB(B0, 1, 0); PG8_LDB(B1, 1, 1); PG8_SCHED; PG8_LDA(At, 1, 0); PG8_STAGE(PG8_SA(0, 1), a2, o2[1]);
            if (!first) { PG8_WAIT_V(8); } PG8_WAIT_L(0); PG8_BAR; PG8_MMA(0, 0, At, B0); PG8_MMA(0, 1, At, B1); PG8_BAR; PG8_SCHED;
            PG8_LDA(At, 1, 1); PG8_STAGE(PG8_SB(1, 0), b3, voffB); PG8_STAGE(PG8_SB(1, 1), b3 + hstepB, voffB); PG8_STAGE(PG8_SA(1, 0), a3, o2[0]);
            PG8_WAIT_V(8); PG8_WAIT_L(0); PG8_BAR; PG8_MMA(1, 0, At, B0); PG8_MMA(1, 1, At, B1); PG8_BAR; PG8_SCHED;
            if (last && has_next) { PG8_STAGE(PG8_SA(1, 1), a3, o2[1]); }
        }
        if (wr == 0) PG8_BAR;
        if constexpr (FP8) asm volatile("s_nop 15\n\ts_nop 15\n\ts_nop 15" ::: "memory");
        { int fr_ = fr, fq_ = fq; asm volatile("" : "+v"(fr_), "+v"(fq_));
          const int qv_ = S.fetch(ui); E(acc, cur, ui, wr, wc, fr_, fq_); S.post(ui, qv_); }
        if (!has_next) break;
#pragma unroll
        for (int a = 0; a < 2; ++a)
#pragma unroll
            for (int b = 0; b < 2; ++b)
#pragma unroll
                for (int m = 0; m < 4; ++m)
#pragma unroll
                    for (int n = 0; n < 2; ++n) { if constexpr (!FP8) acc[a][b][m][n] = (f32x4){0.f, 0.f, 0.f, 0.f}; }
        cur = nxt; cB = nB; ++ui;
        PG8_OA(oaC, ui, cur);
        if (wr == 1) PG8_BAR;
    }
    PG8_WAIT_V(0);
    PG8_BAR;
#undef PG8_SA
#undef PG8_SB
#undef PG8_STAGE
#undef PG8_LDA
#undef PG8_LDB
#undef PG8_MMA
#undef PG8_MMA0
#undef PG8_MMAZ
#undef PG8_WAIT_V
#undef PG8_WAIT_L
#undef PG8_BAR
#undef PG8_SCHED
#undef PG8_OA
}
}
#include <hip/hip_bf16.h>
#include <cmath>
namespace attn_body {
using bf16=__hip_bfloat16;
using bf16x8=__attribute__((ext_vector_type(8)))short;
using s16x4=__attribute__((ext_vector_type(4)))short;
using f32x16=__attribute__((ext_vector_type(16)))float;
using u32x4=__attribute__((ext_vector_type(4)))unsigned;
using u32x2=__attribute__((ext_vector_type(2)))unsigned;
constexpr int SEQ=4096,D=64,QP=512,OP=1024;
constexpr int NW=8,QBLK=32,QB=QBLK*NW,KVBLK=64,NQB=SEQ/QB;
constexpr int ATTN_UNIT_ROWS=QB;
__device__ __forceinline__ int crow(int r,int hi){return (r&3)+8*(r>>2)+4*hi;}
#define SBAR() __builtin_amdgcn_sched_barrier(0)
__device__ __forceinline__ void cmask(f32x16&p0,f32x16&p1,int jb,int qrel,int hi){
  const float NEG=-INFINITY; int kb=64*jb+4*hi;
  #pragma unroll
  for(int r=0;r<16;++r){int kv=kb+(r&3)+8*(r>>2); if(kv>qrel)p0[r]=NEG; if(kv+32>qrel)p1[r]=NEG;}
}

__device__ __forceinline__ void smask(f32x16&p0,f32x16&p1,int jb,int qrel,int hi){
  const float NEG=-INFINITY; int kb=64*jb+4*hi;
  #pragma unroll
  for(int r=0;r<16;++r){int kv=kb+(r&3)+8*(r>>2); if(kv>qrel||kv<=qrel-128)p0[r]=NEG; if(kv+32>qrel||kv+32<=qrel-128)p1[r]=NEG;}
}
constexpr int NSLOT=3, SLOTB=8192;
constexpr int LDS_K=0, LDS_V=NSLOT*SLOTB, LDS_WS=2*NSLOT*SLOTB, LDS_OST=LDS_WS+NW*64*4, LDS_BYTES=LDS_OST+NW*4096;
constexpr float C2=0.125f*1.4426950408889634f;
__device__ __forceinline__ void glds16(const void*gsrc,unsigned lds_dst){unsigned keep;
  asm volatile("s_mov_b32 %0, m0\n\ts_mov_b32 m0, %2\n\ts_nop 0\n\tglobal_load_lds_dwordx4 %1, off\n\ts_mov_b32 m0, %0":"=&s"(keep):"v"(gsrc),"s"(lds_dst):"memory");}
__device__ __forceinline__ float max3f(float a,float b,float c){float r;asm("v_max3_f32 %0, %1, %2, %3":"=v"(r):"v"(a),"v"(b),"v"(c));return r;}
__device__ __forceinline__ float max2f(float a,float b){float r;asm("v_max_f32_e32 %0, %1, %2":"=v"(r):"v"(a),"v"(b));return r;}
__device__ __forceinline__ float fadd_s(float a,float b){float r;asm("v_add_f32_e32 %0, %1, %2":"=v"(r):"v"(a),"v"(b));return r;}
__device__ __forceinline__ float fsub_s(float a,float b){float r;asm("v_sub_f32_e32 %0, %1, %2":"=v"(r):"v"(a),"v"(b));return r;}
typedef float f32x2_t __attribute__((ext_vector_type(2))); typedef __bf16 bf16x2_t __attribute__((ext_vector_type(2)));
constexpr float SO8=16.f;
__device__ __forceinline__ unsigned o8pk(float a,float b,float c,float d){int w=0;w=__builtin_amdgcn_cvt_pk_fp8_f32(__builtin_amdgcn_fmed3f(a,-448.f,448.f),__builtin_amdgcn_fmed3f(b,-448.f,448.f),w,false);w=__builtin_amdgcn_cvt_pk_fp8_f32(__builtin_amdgcn_fmed3f(c,-448.f,448.f),__builtin_amdgcn_fmed3f(d,-448.f,448.f),w,true);return (unsigned)w;}
__device__ __forceinline__ unsigned cvtpk_s(float lo,float hi){f32x2_t v={lo,hi};bf16x2_t b=__builtin_convertvector(v,bf16x2_t);return __builtin_bit_cast(unsigned,b);}
#define WAIT_BAR(N) asm volatile("s_waitcnt vmcnt(" #N ") lgkmcnt(0)\n\ts_barrier":::"memory")

__device__ __forceinline__ void qkt(f32x16&p0,f32x16&p1,const char*Kslot,const bf16x8*qr,const f32x16&negm,int r32,int hi){
  const char*kb=Kslot+hi*1024+r32*16;
  #pragma unroll
  for(int d0=0;d0<4;++d0){
    const bf16x8 b0=*reinterpret_cast<const bf16x8*>(kb+d0*2048);
    const bf16x8 b1=*reinterpret_cast<const bf16x8*>(kb+d0*2048+512);
    if(d0==0){p0=__builtin_amdgcn_mfma_f32_32x32x16_bf16(b0,qr[0],negm,0,0,0);p1=__builtin_amdgcn_mfma_f32_32x32x16_bf16(b1,qr[0],negm,0,0,0);}
    else{p0=__builtin_amdgcn_mfma_f32_32x32x16_bf16(b0,qr[d0],p0,0,0,0);p1=__builtin_amdgcn_mfma_f32_32x32x16_bf16(b1,qr[d0],p1,0,0,0);}}
}
typedef __attribute__((address_space(3))) const char* lds_cptr;
typedef short v4i16_t __attribute__((ext_vector_type(4)));
__device__ __forceinline__ void kload8(bf16x8*kf,lds_cptr kp){
  kf[0]=*(const __attribute__((address_space(3))) bf16x8*)(kp);      kf[1]=*(const __attribute__((address_space(3))) bf16x8*)(kp+512);
  kf[2]=*(const __attribute__((address_space(3))) bf16x8*)(kp+2048); kf[3]=*(const __attribute__((address_space(3))) bf16x8*)(kp+2560);
  kf[4]=*(const __attribute__((address_space(3))) bf16x8*)(kp+4096); kf[5]=*(const __attribute__((address_space(3))) bf16x8*)(kp+4608);
  kf[6]=*(const __attribute__((address_space(3))) bf16x8*)(kp+6144); kf[7]=*(const __attribute__((address_space(3))) bf16x8*)(kp+6656);
}
__device__ __forceinline__ void kload2(bf16x8*kf,lds_cptr kp,int j){ kf[2*j]=*(const __attribute__((address_space(3))) bf16x8*)(kp+j*2048); kf[2*j+1]=*(const __attribute__((address_space(3))) bf16x8*)(kp+j*2048+512); }
__device__ __forceinline__ s16x4 vtr(lds_cptr p){ return __builtin_bit_cast(s16x4,__builtin_amdgcn_ds_read_tr16_b64_v4i16((__attribute__((address_space(3))) v4i16_t*)p)); }
__device__ __forceinline__ float rowmax(const f32x16&p0,const f32x16&p1){
  float a=max3f(p0[0],p0[1],p1[0]),b=max3f(p0[2],p0[3],p1[1]);a=max3f(a,p1[2],p1[3]);
  #pragma unroll
  for(int r=4;r<16;r+=4){a=max3f(a,p0[r],p0[r+1]);b=max3f(b,p0[r+2],p0[r+3]);a=max3f(a,p1[r],p1[r+1]);b=max3f(b,p1[r+2],p1[r+3]);}
  const float m=max2f(a,b);
  auto rr=__builtin_amdgcn_permlane32_swap(__float_as_uint(m),__float_as_uint(m),false,false);
  return max2f(__uint_as_float(rr[0]),__uint_as_float(rr[1]));
}
__device__ __forceinline__ void pv(f32x16*o,int vb,bf16x8 pa0,bf16x8 pa1,bf16x8 pa2,bf16x8 pa3){
  #pragma unroll
  for(int d0=0;d0<2;++d0){s16x4 lo[4],hi[4];
    #pragma unroll
    for(int ks=0;ks<4;++ks){
      asm volatile("ds_read_b64_tr_b16 %0,%1 offset:%c2":"=&v"(lo[ks]):"v"(vb),"i"(d0*4096+ks*1024):"memory");
      asm volatile("ds_read_b64_tr_b16 %0,%1 offset:%c2":"=&v"(hi[ks]):"v"(vb),"i"(d0*4096+ks*1024+512):"memory");}
    asm volatile("s_waitcnt lgkmcnt(0)":::"memory");SBAR();
    #define PK(k) (bf16x8){lo[k][0],lo[k][1],lo[k][2],lo[k][3],hi[k][0],hi[k][1],hi[k][2],hi[k][3]}
    o[d0]=__builtin_amdgcn_mfma_f32_32x32x16_bf16(pa0,PK(0),o[d0],0,0,0);
    o[d0]=__builtin_amdgcn_mfma_f32_32x32x16_bf16(pa1,PK(1),o[d0],0,0,0);
    o[d0]=__builtin_amdgcn_mfma_f32_32x32x16_bf16(pa2,PK(2),o[d0],0,0,0);
    o[d0]=__builtin_amdgcn_mfma_f32_32x32x16_bf16(pa3,PK(3),o[d0],0,0,0);
    #undef PK
  }
}

#ifndef ATTN_STORE16
#define ATTN_STORE16(p,v) (*(u32x4*)(p)=(v))
#endif
template<int MODE,int KP,int VP,int THRL> __device__ __forceinline__ void attn_unit(long rowbase,int q0,const bf16*Qh,const bf16*__restrict__ Kh0,const bf16*__restrict__ Vh0,unsigned char*Oh,float sink2a,float sink2b,char*shm){
  int tid=threadIdx.x; asm volatile("":"+v"(tid));
  const int lane=tid&63,r32=lane&31,hi=lane>>5; const int wid=__builtin_amdgcn_readfirstlane(tid>>6);
  const int t0=(MODE==1&&q0>=128)?(q0/KVBLK-2):0;
  const int wrow=(MODE==1)?(wid&3)*QBLK:wid*QBLK, whd=(MODE==1)?(wid>>2)*D:0;
  const float sink2=(MODE==1&&(wid>>2))?sink2b:sink2a;
  const bf16*Qw=Qh+whd+(rowbase+q0+wrow)*QP;
  const bf16*Kh=Kh0+(rowbase+(long)t0*KVBLK)*KP,*Vh=Vh0+(rowbase+(long)t0*KVBLK)*VP;
  const unsigned lds0=(unsigned)(uintptr_t)shm;
  float*wsf=(float*)(shm+LDS_WS)+wid*64;
  const bf16*ksrc=Kh+(long)lane*KP+wid*8;
  const bf16*vsrc=Vh+(long)(16*(wid&3)+(lane>>2))*VP+(wid>>2)*32+(lane&3)*8;
  const unsigned kdst=lds0+LDS_K+wid*1024, vdst=lds0+LDS_V+wid*1024;
  #define DMA_K(t,slot) glds16(ksrc+(long)(t)*KVBLK*KP,(unsigned)__builtin_amdgcn_readfirstlane(kdst+(slot)))
  #define DMA_V(t,slot) glds16(vsrc+(long)(t)*KVBLK*VP,(unsigned)__builtin_amdgcn_readfirstlane(vdst+(slot)))
  const int vb0=(int)(lds0+LDS_V)+((lane>>4)&1)*32+(lane&3)*8+(4*hi+((lane&15)>>2))*64;
  const char*Kbase=shm+LDS_K; bf16x8 kf[8];
  const lds_cptr shm3=(lds_cptr)shm; const lds_cptr kp0=shm3+LDS_K+hi*1024+r32*16; const lds_cptr vp0=shm3+LDS_V+((lane>>4)&1)*32+(lane&3)*8+(4*hi+((lane&15)>>2))*64;
  const int NT=(MODE==1)?4:(q0+QB)/KVBLK;
  const int jb0=(MODE==1)?(t0-q0/KVBLK):0;
  DMA_K(0,0);DMA_V(0,0);DMA_K(1,SLOTB);
  bf16x8 qr[4];
  #pragma unroll
  for(int d0=0;d0<4;++d0)qr[d0]=*reinterpret_cast<const bf16x8*>(&Qw[(long)r32*QP+d0*16+hi*8]);
  float mhat=0.f,l_reg=0.f;f32x16 o[2];o[0]=f32x16{};o[1]=f32x16{};f32x16 negm=f32x16{};asm volatile("":"+v"(negm));
  const int qrel=wrow+r32;
  #define CMASK(P0,P1,t) do{int jb_=(t)-(NT-4); if(MODE==1)smask(P0,P1,(t)+jb0,qrel,hi); else if(jb_>=0)cmask(P0,P1,jb_,qrel,hi);}while(0)
  bool resc=false;
  #define START(P0,P1) do{ const float rm=rowmax(P0,P1); resc=false; \
    { const float dl=max2f(rm,-64.f); mhat=fadd_s(mhat,dl); \
      _Pragma("unroll") for(int r=0;r<16;++r){P0[r]=fsub_s(P0[r],dl);P1[r]=fsub_s(P1[r],dl);} \
      _Pragma("unroll") for(int r=0;r<16;++r)negm[r]=-mhat; asm volatile("":"+v"(negm)); } \
    _Pragma("unroll") for(int r=0;r<16;++r)P0[r]=__builtin_amdgcn_exp2f(P0[r]); }while(0)
  #define RESC() do{ if(resc){ asm volatile("s_waitcnt lgkmcnt(0)":::"memory"); \
      _Pragma("unroll") for(int d_=0;d_<2;++d_) _Pragma("unroll") for(int r=0;r<16;++r)o[d_][r]*=wsf[crow(r,hi)]; } }while(0)
  f32x16 pA0,pA1,pB0,pB1;
  int sl_prev=0,sl_cur=0,sl_next=SLOTB;
  #define ROT() do{sl_prev=sl_cur;sl_cur=sl_next;sl_next=(sl_next==(NSLOT-1)*SLOTB)?0:sl_next+SLOTB;}while(0)
  DMA_K(2,2*SLOTB);
  WAIT_BAR(3);
  qkt(pA0,pA1,Kbase,qr,negm,r32,hi);asm volatile("s_nop 15\n\ts_nop 7":"+v"(pA0),"+v"(pA1));CMASK(pA0,pA1,0);
  START(pA0,pA1);
  _Pragma("unroll") for(int r=0;r<16;++r)pA1[r]=__builtin_amdgcn_exp2f(pA1[r]);
  WAIT_BAR(0);
  DMA_K(3,0);DMA_V(1,SLOTB);
  ROT();
  kload8(kf,kp0+sl_cur);
  WAIT_BAR(2);
  s16x4 vlo[8],vhi[8]; u32x4 pw0,pw1,pw2,pw3;
  #define PKW(P,B) cvtpk_s(P[B],P[B+1])
  #define PAF(k) __builtin_bit_cast(bf16x8,pw##k)
  #define VFR(i) (bf16x8){vlo[i][0],vlo[i][1],vlo[i][2],vlo[i][3],vhi[i][0],vhi[i][1],vhi[i][2],vhi[i][3]}
  #define PIN(x) asm volatile("":"+v"(x))
  #define MX3(a,b,c) __builtin_fmaxf(__builtin_fmaxf((a),(b)),(c))
  #define GAPA(MF,A0,A1,A2,A3,W0,W1,PW) do{ MF; sacc+=A0; sacc+=A1; sacc+=A2; sacc+=A3; PIN(sacc); W0; W1; PIN(PW); SBAR(); }while(0)
  #define EX(v) __builtin_amdgcn_exp2f(v)
  #define GAPB(MF,X,B) do{ MF; X[B]=EX(X[B]); X[B+1]=EX(X[B+1]); X[B+2]=EX(X[B+2]); X[B+3]=EX(X[B+3]); PIN(X); SBAR(); }while(0)
  #define VRD(i) do{ vlo[i]=vtr(vp_+(((i)>>2)*4096+((i)&3)*1024)); vhi[i]=vtr(vp_+(((i)>>2)*4096+((i)&3)*1024+512)); }while(0)
  #define KRD(G,j) do{ if(G){ kload2(kf,kp0+sl_next,j); SBAR(); } }while(0)
  #define STEP(C0,C1,P0,P1,t,GK,GV,GL) do{ SBAR(); \
    const lds_cptr vp_=vp0+sl_prev; \
    VRD(0); SBAR(); float sacc=(P0[0]+P0[1]); \
    GAPA(C0=__builtin_amdgcn_mfma_f32_32x32x16_bf16(kf[0],qr[0],negm,0,0,0), P0[2],P0[3],P0[4],P0[5],     pw0[0]=PKW(P0,0), pw0[1]=PKW(P0,2), pw0); \
    VRD(4); SBAR(); GAPA(C1=__builtin_amdgcn_mfma_f32_32x32x16_bf16(kf[1],qr[0],negm,0,0,0), P0[6],P0[7],P0[8],P0[9],     pw0[2]=PKW(P0,4), pw0[3]=PKW(P0,6), pw0); \
    VRD(1); SBAR(); GAPA(C0=__builtin_amdgcn_mfma_f32_32x32x16_bf16(kf[2],qr[1],C0,0,0,0),   P0[10],P0[11],P0[12],P0[13], pw1[0]=PKW(P0,8), pw1[1]=PKW(P0,10), pw1); \
    VRD(5); SBAR(); GAPA(C1=__builtin_amdgcn_mfma_f32_32x32x16_bf16(kf[3],qr[1],C1,0,0,0),   P0[14],P0[15],P1[0],P1[1],   pw1[2]=PKW(P0,12),pw1[3]=PKW(P0,14), pw1); \
    VRD(2); SBAR(); GAPA(C0=__builtin_amdgcn_mfma_f32_32x32x16_bf16(kf[4],qr[2],C0,0,0,0),   P1[2],P1[3],P1[4],P1[5],     pw2[0]=PKW(P1,0), pw2[1]=PKW(P1,2), pw2); \
    VRD(6); SBAR(); GAPA(C1=__builtin_amdgcn_mfma_f32_32x32x16_bf16(kf[5],qr[2],C1,0,0,0),   P1[6],P1[7],P1[8],P1[9],     pw2[2]=PKW(P1,4), pw2[3]=PKW(P1,6), pw2); \
    VRD(3); SBAR(); GAPA(C0=__builtin_amdgcn_mfma_f32_32x32x16_bf16(kf[6],qr[3],C0,0,0,0),   P1[10],P1[11],P1[12],P1[13], pw3[0]=PKW(P1,8), pw3[1]=PKW(P1,10), pw3); \
    VRD(7); SBAR(); GAPA(C1=__builtin_amdgcn_mfma_f32_32x32x16_bf16(kf[7],qr[3],C1,0,0,0),   P1[14],P1[15],0.f,0.f,       pw3[2]=PKW(P1,12),pw3[3]=PKW(P1,14), pw3); \
    l_reg+=sacc; \
    if(GK){DMA_K((t)+3,sl_cur);} if(GV){DMA_V((t)+1,sl_next);} \
    CMASK(C0,C1,t); \
    { float a=MX3(C0[0],C0[1],C1[0]),b=MX3(C0[2],C0[3],C1[1]); a=MX3(a,C1[2],C1[3]); \
      _Pragma("unroll") for(int r=4;r<16;r+=4){a=MX3(a,C0[r],C0[r+1]);b=MX3(b,C0[r+2],C0[r+3]);a=MX3(a,C1[r],C1[r+1]);b=MX3(b,C1[r+2],C1[r+3]);} \
      float rm=__builtin_fmaxf(a,b); { auto rr=__builtin_amdgcn_permlane32_swap(__float_as_uint(rm),__float_as_uint(rm),false,false); rm=__builtin_fmaxf(__uint_as_float(rr[0]),__uint_as_float(rr[1])); } \
      resc=false; \
      if(__builtin_expect(__any(rm>(float)THRL),0)){ const float dl=__builtin_fmaxf(rm,0.f); mhat+=dl; \
        _Pragma("unroll") for(int r=0;r<16;++r){C0[r]-=dl;C1[r]-=dl;} \
        _Pragma("unroll") for(int r=0;r<16;++r)negm[r]=-mhat; asm volatile("":"+v"(negm)); \
        const float f=__builtin_amdgcn_exp2f(-dl); l_reg*=f; if(hi==0)wsf[r32]=f; resc=true; } } \
    SBAR(); \
    GAPB(o[0]=__builtin_amdgcn_mfma_f32_32x32x16_bf16(PAF(0),VFR(0),o[0],0,0,0), C0,0); \
    GAPB(o[1]=__builtin_amdgcn_mfma_f32_32x32x16_bf16(PAF(0),VFR(4),o[1],0,0,0), C0,4); \
    KRD(GL,0); GAPB(o[0]=__builtin_amdgcn_mfma_f32_32x32x16_bf16(PAF(1),VFR(1),o[0],0,0,0), C0,8); \
    KRD(GL,1); GAPB(o[1]=__builtin_amdgcn_mfma_f32_32x32x16_bf16(PAF(1),VFR(5),o[1],0,0,0), C0,12); \
    KRD(GL,2); GAPB(o[0]=__builtin_amdgcn_mfma_f32_32x32x16_bf16(PAF(2),VFR(2),o[0],0,0,0), C1,0); \
    KRD(GL,3); GAPB(o[1]=__builtin_amdgcn_mfma_f32_32x32x16_bf16(PAF(2),VFR(6),o[1],0,0,0), C1,4); \
    GAPB(o[0]=__builtin_amdgcn_mfma_f32_32x32x16_bf16(PAF(3),VFR(3),o[0],0,0,0), C1,8); \
    GAPB(o[1]=__builtin_amdgcn_mfma_f32_32x32x16_bf16(PAF(3),VFR(7),o[1],0,0,0), C1,12); \
    }while(0)
  int t=1;
  #undef CMASK
  #define CMASK(P0,P1,t) do{}while(0)
  for(;t+5<NT;t+=2){
    STEP(pB0,pB1,pA0,pA1,t,true,true,true);     WAIT_BAR(2); RESC(); ROT();
    STEP(pA0,pA1,pB0,pB1,t+1,true,true,true);   WAIT_BAR(2); RESC(); ROT();
  }
  #undef CMASK
  #define CMASK(P0,P1,t) do{int jb_=(t)-(NT-4); if(MODE==1)smask(P0,P1,(t)+jb0,qrel,hi); else if(jb_>=0)cmask(P0,P1,jb_,qrel,hi);}while(0)
  #define ENDW(tt) do{ if((tt)+3<NT){WAIT_BAR(2);} else if((tt)+2<NT){WAIT_BAR(1);} else {WAIT_BAR(0);} }while(0)
  for(;t+1<NT;t+=2){
    STEP(pB0,pB1,pA0,pA1,t,(t+3<NT),(t+1<NT),(t+1<NT));       ENDW(t);   RESC(); ROT();
    STEP(pA0,pA1,pB0,pB1,t+1,(t+4<NT),(t+2<NT),(t+2<NT));     ENDW(t+1); RESC(); ROT();
  }
  STEP(pB0,pB1,pA0,pA1,NT-1,false,false,false); RESC();
  { float sacc=pB0[0]+pB0[1]; _Pragma("unroll") for(int r=2;r<16;++r)sacc+=pB0[r]; _Pragma("unroll") for(int r=0;r<16;++r)sacc+=pB1[r]; l_reg+=sacc;
    pw0=(u32x4){PKW(pB0,0),PKW(pB0,2),PKW(pB0,4),PKW(pB0,6)};pw1=(u32x4){PKW(pB0,8),PKW(pB0,10),PKW(pB0,12),PKW(pB0,14)};pw2=(u32x4){PKW(pB1,0),PKW(pB1,2),PKW(pB1,4),PKW(pB1,6)};pw3=(u32x4){PKW(pB1,8),PKW(pB1,10),PKW(pB1,12),PKW(pB1,14)};
    SBAR(); pv(o,vb0+sl_cur,PAF(0),PAF(1),PAF(2),PAF(3)); }
  #undef PKW
  #undef PAF
  #undef VFR
  #undef PIN
  #undef MX3
  #undef GAPA
  #undef GAPB
  #undef EX
  #undef VRD
  #undef KRD
  #undef STEP
  #undef ENDW
  {auto rr=__builtin_amdgcn_permlane32_swap(__float_as_uint(l_reg),__float_as_uint(l_reg),false,false);l_reg=__uint_as_float(rr[0])+__uint_as_float(rr[1]);}
  if(MODE==1)l_reg+=__builtin_amdgcn_exp2f(sink2-mhat);
  if(hi==0)wsf[32+r32]=l_reg;asm volatile("s_waitcnt lgkmcnt(0)":::"memory");
  float rli[16];
  #pragma unroll
  for(int r=0;r<16;++r)rli[r]=__builtin_amdgcn_rcpf(wsf[32+crow(r,hi)]);
  unsigned char*Ow=Oh+whd+(rowbase+q0+wrow)*OP;
  { bf16*stg=(bf16*)(shm+LDS_OST)+wid*2048;
    #pragma unroll
    for(int r=0;r<16;++r){const int orow=crow(r,hi);
      #pragma unroll
      for(int d0=0;d0<2;++d0)stg[orow*64+d0*32+r32]=__float2bfloat16(o[d0][r]*rli[r]);}
    asm volatile("s_waitcnt lgkmcnt(0)":::"memory");
    #pragma unroll
    for(int i=0;i<4;++i){const int row=i*8+(lane>>3),ch=lane&7; const u32x4 v=*(const u32x4*)(stg+row*64+ch*8);
      u32x2 w8; w8[0]=o8pk(__uint_as_float(v[0]<<16)*SO8,__uint_as_float(v[0]&0xffff0000u)*SO8,__uint_as_float(v[1]<<16)*SO8,__uint_as_float(v[1]&0xffff0000u)*SO8);
      w8[1]=o8pk(__uint_as_float(v[2]<<16)*SO8,__uint_as_float(v[2]&0xffff0000u)*SO8,__uint_as_float(v[3]<<16)*SO8,__uint_as_float(v[3]&0xffff0000u)*SO8);
      *(u32x2*)(Ow+(long)row*OP+ch*8)=w8;} }
  asm volatile("s_waitcnt lgkmcnt(0)\n\ts_barrier":::"memory");
  #undef DMA_K
  #undef DMA_V
  #undef CMASK
  #undef START
  #undef RESC
  #undef ROT
}
constexpr int V2SLOT=16384;
constexpr int L2_K=0, L2_V=NSLOT*SLOTB, L2_WS=L2_V+NSLOT*V2SLOT, L2_OST=L2_WS+NW*64*4, L2_BYTES=L2_OST+NW*4096;
template<int THRL> __device__ __forceinline__ void attn_unit128(long rowbase,int q0,const bf16*Qh,const bf16*__restrict__ Kh0,const bf16*__restrict__ Vh0,bf16*Oh,unsigned char*O8h,bool cmb,float lam,const float*gsub,char*shm){
  constexpr int KP=512,VP=512;
  int tid=threadIdx.x; asm volatile("":"+v"(tid));
  const int lane=tid&63,r32=lane&31,hi=lane>>5; const int wid=__builtin_amdgcn_readfirstlane(tid>>6);
  const bf16*Qw=Qh+(rowbase+q0+wid*QBLK)*QP;
  const bf16*Kh=Kh0+rowbase*KP,*Vh=Vh0+rowbase*VP;
  const unsigned lds0=(unsigned)(uintptr_t)shm;
  float*wsf=(float*)(shm+L2_WS)+wid*64;
  const bf16*ksrc=Kh+(long)lane*KP+wid*8;
  const bf16*vsrc=Vh+(long)(16*(wid&3)+(lane>>2))*VP+(wid>>2)*32+(lane&3)*8;
  const unsigned kdst=lds0+L2_K+wid*1024, vdst=lds0+L2_V+wid*1024;
  #define DK128(t,slot) glds16(ksrc+(long)(t)*KVBLK*KP,(unsigned)__builtin_amdgcn_readfirstlane(kdst+(slot)))
  #define DV128(t,slot) do{ glds16(vsrc+(long)(t)*KVBLK*VP,(unsigned)__builtin_amdgcn_readfirstlane(vdst+(slot))); glds16(vsrc+(long)(t)*KVBLK*VP+64,(unsigned)__builtin_amdgcn_readfirstlane(vdst+(slot)+8192)); }while(0)
  const lds_cptr shm3=(lds_cptr)shm; const lds_cptr kp0=shm3+L2_K+hi*1024+r32*16; const lds_cptr vp0=shm3+L2_V+((lane>>4)&1)*32+(lane&3)*8+(4*hi+((lane&15)>>2))*64;
  const int NT=(q0+QB)/KVBLK;
  DK128(0,0);DV128(0,0);DK128(1,SLOTB);
  typedef __attribute__((address_space(3))) bf16x8* lds_q8;
  const lds_q8 qst=(lds_q8)(shm3+L2_OST+wid*4096+lane*16);
  { bf16x8 qt[4];
    #pragma unroll
    for(int d0=0;d0<4;++d0)qt[d0]=*reinterpret_cast<const bf16x8*>(&Qw[(long)r32*QP+d0*16+hi*8]);
    #pragma unroll
    for(int d0=0;d0<4;++d0)qst[d0*64]=qt[d0]; }
  float mhat=0.f,l_reg=0.f;f32x16 o[4];o[0]=f32x16{};o[1]=f32x16{};o[2]=f32x16{};o[3]=f32x16{};f32x16 negm=f32x16{};asm volatile("":"+v"(negm));
  const int qrel=wid*QBLK+r32;
  bool resc=false;
  f32x16 C0,C1; u32x4 pw0,pw1,pw2,pw3; bf16x8 kf[8]; s16x4 vfl[16],vfh[16];
  int ip=0,ic=0,in=1;
  #define ROT128() do{ip=ic;ic=in;in=(in==NSLOT-1)?0:in+1;}while(0)
  #define MF32(a,b,c) __builtin_amdgcn_mfma_f32_32x32x16_bf16(a,b,c,0,0,0)
  #define PV32(acc,a,b) do{ const bf16x8 a_=(a), b_=(b); asm volatile("v_mfma_f32_32x32x16_bf16 %0, %1, %2, %0":"+v"(acc):"v"(a_),"v"(b_)); }while(0)
  #define PIN(x) asm volatile("":"+v"(x))
  #define EXP2(CX,B) do{ CX[B]=__builtin_amdgcn_exp2f(CX[B]); CX[(B)+1]=__builtin_amdgcn_exp2f(CX[(B)+1]); sacc+=CX[B]; sacc+=CX[(B)+1]; }while(0)
  #define PACK2(CX,B,PN,W) do{ PN[W]=cvtpk_s(CX[B],CX[(B)+1]); }while(0)
  #define QK128(slotb) do{ kload8(kf,kp0+(slotb)); const bf16x8 q0_=qst[0],q1_=qst[64],q2_=qst[128],q3_=qst[192]; \
    C0=MF32(kf[0],q0_,negm); C1=MF32(kf[1],q0_,negm); C0=MF32(kf[2],q1_,C0); C1=MF32(kf[3],q1_,C1); \
    C0=MF32(kf[4],q2_,C0);   C1=MF32(kf[5],q2_,C1);   C0=MF32(kf[6],q3_,C0); C1=MF32(kf[7],q3_,C1); }while(0)
  #define QK128P(slotb) do{ kload8(kf,kp0+(slotb)); const bf16x8 q0_=qst[0],q1_=qst[64],q2_=qst[128],q3_=qst[192]; float sacc=0.f; SBAR(); \
    C0=MF32(kf[0],q0_,negm); EXP2(C1,0);  EXP2(C1,2);  PIN(sacc); PIN(C1); SBAR(); \
    C0=MF32(kf[2],q1_,C0);   EXP2(C1,4);  EXP2(C1,6);  PIN(sacc); PIN(C1); SBAR(); \
    C0=MF32(kf[4],q2_,C0);   EXP2(C1,8);  EXP2(C1,10); PIN(sacc); PIN(C1); SBAR(); \
    C0=MF32(kf[6],q3_,C0);   EXP2(C1,12); EXP2(C1,14); PIN(sacc); PIN(C1); SBAR(); \
    PACK2(C1,0,pw2,0); PACK2(C1,2,pw2,1); PACK2(C1,4,pw2,2); PACK2(C1,6,pw2,3); PACK2(C1,8,pw3,0); PACK2(C1,10,pw3,1); PACK2(C1,12,pw3,2); PACK2(C1,14,pw3,3); PIN(pw2); PIN(pw3); l_reg+=sacc; SBAR(); \
    C1=MF32(kf[1],q0_,negm); C1=MF32(kf[3],q1_,C1); C1=MF32(kf[5],q2_,C1); C1=MF32(kf[7],q3_,C1); }while(0)
  #define MX3(a,b,c) __builtin_fmaxf(__builtin_fmaxf((a),(b)),(c))
  #define ROWMAX128(rm) do{ float a_=MX3(C0[0],C0[1],C1[0]),b_=MX3(C0[2],C0[3],C1[1]); a_=MX3(a_,C1[2],C1[3]); \
      _Pragma("unroll") for(int r=4;r<16;r+=4){a_=MX3(a_,C0[r],C0[r+1]);b_=MX3(b_,C0[r+2],C0[r+3]);a_=MX3(a_,C1[r],C1[r+1]);b_=MX3(b_,C1[r+2],C1[r+3]);} \
      rm=__builtin_fmaxf(a_,b_); { auto rr=__builtin_amdgcn_permlane32_swap(__float_as_uint(rm),__float_as_uint(rm),false,false); rm=__builtin_fmaxf(__uint_as_float(rr[0]),__uint_as_float(rr[1])); } }while(0)
  #define VRD128(i,vp_) do{ vfl[i]=vtr((vp_)+(((i)>>2)*4096+((i)&3)*1024)); vfh[i]=vtr((vp_)+(((i)>>2)*4096+((i)&3)*1024+512)); }while(0)
  #define VFR128(i) (bf16x8){vfl[i][0],vfl[i][1],vfl[i][2],vfl[i][3],vfh[i][0],vfh[i][1],vfh[i][2],vfh[i][3]}
  #define VD128 4
  #define VPRE128(vp_) do{ VRD128(0,vp_); VRD128(4,vp_); VRD128(8,vp_); VRD128(12,vp_); }while(0)
  #define GAP128(g,PP,vp_) do{ PV32(o[(g)&3],__builtin_bit_cast(bf16x8,PP),VFR128(4*((g)&3)+((g)>>2))); \
      if((g)+VD128<16){ VRD128(4*(((g)+VD128)&3)+(((g)+VD128)>>2),vp_); } if(((g)&1)==0){ EXP2(C0,g); PIN(C0); } \
      if((g)>=8){ if((g)<12){ PACK2(C0,2*((g)-8),pw0,(g)-8); PIN(pw0); } else { PACK2(C0,2*((g)-8),pw1,(g)-12); PIN(pw1); } } PIN(sacc); SBAR(); }while(0)
  #define PHASEB128(vp_) do{ float sacc=0.f; SBAR(); \
      GAP128(0,pw0,vp_);  GAP128(1,pw0,vp_);  GAP128(2,pw0,vp_);  GAP128(3,pw0,vp_); \
      GAP128(4,pw1,vp_);  GAP128(5,pw1,vp_);  GAP128(6,pw1,vp_);  GAP128(7,pw1,vp_); \
      GAP128(8,pw2,vp_);  GAP128(9,pw2,vp_);  GAP128(10,pw2,vp_); GAP128(11,pw2,vp_); \
      GAP128(12,pw3,vp_); GAP128(13,pw3,vp_); GAP128(14,pw3,vp_); GAP128(15,pw3,vp_); \
      l_reg+=sacc; }while(0)
  #define RESC128() do{ if(resc){ asm volatile("s_waitcnt lgkmcnt(0)\n\ts_nop 15\n\ts_nop 15":::"memory"); \
      _Pragma("unroll") for(int d_=0;d_<4;++d_) _Pragma("unroll") for(int r=0;r<16;++r)o[d_][r]*=wsf[crow(r,hi)]; } }while(0)
  #define STEP128(t,GK,GV,MASKED) do{ SBAR(); \
    QK128P(ic*SLOTB); \
    if(GK){DK128((t)+2,ip*SLOTB);} if(GV){DV128((t)+1,in*V2SLOT);} \
    { const lds_cptr vpe_=vp0+ip*V2SLOT; VPRE128(vpe_); } \
    if(MASKED){ const int jb_=(t)-(NT-4); if(jb_>=0)cmask(C0,C1,jb_,qrel,hi); } \
    { float rm; ROWMAX128(rm); resc=false; \
      if(__builtin_expect(__any(rm>(float)THRL),0)){ const float dl=__builtin_fmaxf(rm,0.f); mhat+=dl; \
        _Pragma("unroll") for(int r=0;r<16;++r){C0[r]-=dl;C1[r]-=dl;} \
        _Pragma("unroll") for(int r=0;r<16;++r)negm[r]=-mhat; asm volatile("":"+v"(negm)); \
        const float f=__builtin_amdgcn_exp2f(-dl); l_reg*=f; if(hi==0)wsf[r32]=f; resc=true; } } \
    SBAR(); \
    { const lds_cptr vpp_=vp0+ip*V2SLOT; PHASEB128(vpp_); } \
    }while(0)
  WAIT_BAR(3);
  QK128(0);
  if(NT==4)cmask(C0,C1,0,qrel,hi);
  { float rm; ROWMAX128(rm); const float dl=__builtin_fmaxf(rm,-64.f); mhat=dl;
    #pragma unroll
    for(int r=0;r<16;++r){C0[r]-=dl;C1[r]-=dl;}
    #pragma unroll
    for(int r=0;r<16;++r)negm[r]=-mhat;
    asm volatile("":"+v"(negm));
    float sacc=0.f;
    #pragma unroll
    for(int w=0;w<4;++w){ EXP2(C0,2*w); PACK2(C0,2*w,pw0,w); EXP2(C0,8+2*w); PACK2(C0,8+2*w,pw1,w); }
    l_reg=sacc; }
  DK128(2,2*SLOTB); DV128(1,V2SLOT);
  WAIT_BAR(3);
  ROT128();
  #pragma unroll 1
  for(int t=1;t<NT;++t){
    const bool gk=t+2<NT,gv=t+1<NT,msk=t>=NT-4;
    STEP128(t,gk,gv,msk);
    if(gk){WAIT_BAR(3);}else if(gv){WAIT_BAR(2);}else{WAIT_BAR(0);}
    RESC128(); if(gv)ROT128();
  }
  { float sacc=0.f;
    #pragma unroll
    for(int w=0;w<4;++w){ EXP2(C1,2*w); PACK2(C1,2*w,pw2,w); EXP2(C1,8+2*w); PACK2(C1,8+2*w,pw3,w); }
    l_reg+=sacc; }
  { const lds_cptr vpp_=vp0+ic*V2SLOT;
    #pragma unroll
    for(int i=0;i<16;++i)VRD128(i,vpp_);
    #pragma unroll
    for(int g=0;g<16;++g){ const int db=g&3,kc=g>>2; const u32x4 pp=kc==0?pw0:kc==1?pw1:kc==2?pw2:pw3; PV32(o[db],__builtin_bit_cast(bf16x8,pp),VFR128(4*db+kc)); }
    asm volatile("s_nop 15\n\ts_nop 15\n\ts_nop 7":"+v"(o[0]),"+v"(o[1]),"+v"(o[2]),"+v"(o[3])); }
  {auto rr=__builtin_amdgcn_permlane32_swap(__float_as_uint(l_reg),__float_as_uint(l_reg),false,false);l_reg=__uint_as_float(rr[0])+__uint_as_float(rr[1]);}
  if(hi==0)wsf[32+r32]=l_reg;asm volatile("s_waitcnt lgkmcnt(0)":::"memory");
  float rli[16];
  #pragma unroll
  for(int r=0;r<16;++r)rli[r]=__builtin_amdgcn_rcpf(wsf[32+crow(r,hi)]);
  bf16*Ow=Oh+(rowbase+q0+wid*QBLK)*OP;
  { bf16*stg=(bf16*)(shm+L2_OST)+wid*2048;
    u32x4 my[2][4];
    #pragma unroll
    for(int rd=0;rd<2;++rd){
      #pragma unroll
      for(int r=0;r<16;++r){const int orow=crow(r,hi);
        #pragma unroll
        for(int d0=0;d0<2;++d0)stg[orow*64+d0*32+r32]=__float2bfloat16(o[2*rd+d0][r]*rli[r]);}
      asm volatile("s_waitcnt lgkmcnt(0)":::"memory");
      #pragma unroll
      for(int i=0;i<4;++i){const int row=i*8+(lane>>3),ch=lane&7; my[rd][i]=*(const u32x4*)(stg+row*64+ch*8);}
      asm volatile("s_waitcnt lgkmcnt(0)":::"memory"); }
    if(!cmb){
      #pragma unroll
      for(int rd=0;rd<2;++rd)
        #pragma unroll
        for(int i=0;i<4;++i){const int row=i*8+(lane>>3),ch=lane&7; ATTN_STORE16(Ow+(long)row*OP+rd*64+ch*8,my[rd][i]);}
    } else {
      u32x4 o1[2][4]; float gv[2][8];
      #pragma unroll
      for(int rd=0;rd<2;++rd){
        #pragma unroll
        for(int i=0;i<4;++i){const int row=i*8+(lane>>3),ch=lane&7; o1[rd][i]=*(const u32x4*)(Ow+(long)row*OP+rd*64+ch*8);}
        #pragma unroll
        for(int j=0;j<8;++j)gv[rd][j]=gsub[rd*64+(lane&7)*8+j]; }
      #define BFLO(w) __uint_as_float((w)<<16)
      #define BFHI(w) __uint_as_float((w)&0xffff0000u)
      float dv[2][4][8]; float ss[4]={0.f,0.f,0.f,0.f};
      #pragma unroll
      for(int rd=0;rd<2;++rd)
        #pragma unroll
        for(int i=0;i<4;++i){ const u32x4 a=o1[rd][i],b2=my[rd][i];
          dv[rd][i][0]=BFLO(a[0])-lam*BFLO(b2[0]); dv[rd][i][1]=BFHI(a[0])-lam*BFHI(b2[0]); dv[rd][i][2]=BFLO(a[1])-lam*BFLO(b2[1]); dv[rd][i][3]=BFHI(a[1])-lam*BFHI(b2[1]);
          dv[rd][i][4]=BFLO(a[2])-lam*BFLO(b2[2]); dv[rd][i][5]=BFHI(a[2])-lam*BFHI(b2[2]); dv[rd][i][6]=BFLO(a[3])-lam*BFLO(b2[3]); dv[rd][i][7]=BFHI(a[3])-lam*BFHI(b2[3]);
          #pragma unroll
          for(int j=0;j<8;++j)ss[i]+=dv[rd][i][j]*dv[rd][i][j]; }
      #pragma unroll
      for(int i=0;i<4;++i){ ss[i]+=__shfl_xor(ss[i],1); ss[i]+=__shfl_xor(ss[i],2); ss[i]+=__shfl_xor(ss[i],4); ss[i]=(0.8f*SO8)/sqrtf(ss[i]*(1.f/128.f)+1e-5f); }
      unsigned char*O8w=O8h+(rowbase+q0+wid*QBLK)*OP;
      #pragma unroll
      for(int rd=0;rd<2;++rd)
        #pragma unroll
        for(int i=0;i<4;++i){ const int row=i*8+(lane>>3),ch=lane&7; const float rr_=ss[i]; u32x2 w;
          w[0]=o8pk(dv[rd][i][0]*rr_*gv[rd][0],dv[rd][i][1]*rr_*gv[rd][1],dv[rd][i][2]*rr_*gv[rd][2],dv[rd][i][3]*rr_*gv[rd][3]);
          w[1]=o8pk(dv[rd][i][4]*rr_*gv[rd][4],dv[rd][i][5]*rr_*gv[rd][5],dv[rd][i][6]*rr_*gv[rd][6],dv[rd][i][7]*rr_*gv[rd][7]);
          *(u32x2*)(O8w+(long)row*OP+rd*64+ch*8)=w; }
      #undef BFLO
      #undef BFHI
    } }
  asm volatile("s_waitcnt lgkmcnt(0)\n\ts_barrier":::"memory");
  #undef DK128
  #undef DV128
  #undef ROT128
  #undef MF32
  #undef PV32
  #undef QK128
  #undef QK128P
  #undef MX3
  #undef ROWMAX128
  #undef PIN
  #undef VRD128
  #undef VFR128
  #undef EXP2
  #undef PACK2
  #undef GAP128
  #undef VD128
  #undef VPRE128
  #undef PHASEB128
  #undef RESC128
  #undef STEP128
}
constexpr int ATTN_LDS_BYTES=(LDS_BYTES>L2_BYTES)?LDS_BYTES:L2_BYTES;
#undef SBAR
#undef WAIT_BAR
}
#define GAS __attribute__((address_space(1)))
#define LAS __attribute__((address_space(3)))
typedef unsigned short bf16;
typedef unsigned v4u __attribute__((ext_vector_type(4)));
typedef float f32x4 __attribute__((ext_vector_type(4)));
typedef short bf16x8 __attribute__((ext_vector_type(8)));
typedef GAS unsigned gu32;
typedef GAS unsigned long long gu64;
#define RLX_AGENT __ATOMIC_RELAXED, __HIP_MEMORY_SCOPE_AGENT
#define LDS_WAIT() asm volatile("s_waitcnt lgkmcnt(0)" ::: "memory")
#define VM_WAIT() asm volatile("s_waitcnt vmcnt(0)" ::: "memory")
__device__ __forceinline__ unsigned long long rt() { return __builtin_amdgcn_s_memrealtime(); }
__device__ __forceinline__ unsigned f2bf(float f) { unsigned u = __builtin_bit_cast(unsigned, f); return (u + 0x7fffu + ((u >> 16) & 1u)) >> 16; }
__device__ __forceinline__ unsigned pk2(float lo, float hi) { return f2bf(lo) | (f2bf(hi) << 16); }

#define XB_TMO      128
#define XB_XCNT(j)  (256  + 64 * (j))
#define XB_XSUB(j)  (1280 + 64 * (j))
#define XB_XGEN(j)  (2304 + 64 * (j))
#define XB_TOP      3328
#define XB_TOPGEN   3392
#define XCD_BAR_WORDS 3456
#define XB_SPIN_CAP (1u << 18)

__device__ __forceinline__ unsigned xb_ld(unsigned* p)              { return __hip_atomic_load(p, __ATOMIC_RELAXED, __HIP_MEMORY_SCOPE_AGENT); }
__device__ __forceinline__ unsigned xb_add(unsigned* p, unsigned v) { return __hip_atomic_fetch_add(p, v, __ATOMIC_RELAXED, __HIP_MEMORY_SCOPE_AGENT); }
__device__ __forceinline__ unsigned xb_xcc_id() { return (unsigned)__builtin_amdgcn_s_getreg((3 << 11) | 20) & 0xFu; }
#define XB_SPIN(cond, bar) do { unsigned _sp = 0; while (cond) { __builtin_amdgcn_s_sleep(1); \
    if ((++_sp & 255u) == 0u) { if (xb_ld(&(bar)[XB_TMO])) break; if (_sp > XB_SPIN_CAP) { atomicAdd(&(bar)[XB_TMO], 1u); break; } } } } while (0)

struct XcdBarrier {
    unsigned* bar; unsigned x;
    volatile LAS unsigned* st;
};

__device__ __forceinline__ XcdBarrier xcd_barrier_post(unsigned* bar, volatile LAS unsigned* st) {
    XcdBarrier b; b.bar = bar; b.x = xb_xcc_id(); b.st = st;
    if (threadIdx.x == 0) (void)xb_add(&bar[XB_XCNT(b.x)], 1u);
    return b;
}
__device__ __forceinline__ void xcd_barrier_complete(unsigned* bar, unsigned x, unsigned& nloc, unsigned& nx) {
    const unsigned G = gridDim.x * gridDim.y * gridDim.z;
    unsigned sum, cnt, mine, sp = 0u;
    for (;;) {
        sum = 0u; cnt = 0u; mine = 0u;
#pragma unroll
        for (unsigned j = 0; j < 16; ++j) { const unsigned c = xb_ld(&bar[XB_XCNT(j)]); sum += c; cnt += (c > 0u) ? 1u : 0u; mine = (j == x) ? c : mine; }
        if (sum == G) break;
        __builtin_amdgcn_s_sleep(1);
        if ((++sp & 255u) == 0u) { if (xb_ld(&bar[XB_TMO])) break; if (sp > XB_SPIN_CAP) { atomicAdd(&bar[XB_TMO], 1u); break; } }
    }
    nloc = mine > 0u ? mine : 1u; nx = cnt > 0u ? cnt : 1u;
}

__device__ __forceinline__ void xcd_barrier(const XcdBarrier& b) {
    asm volatile("s_waitcnt vmcnt(0)" ::: "memory");
    __syncthreads();
    if (threadIdx.x == 0) {
        unsigned* bar = b.bar;
        __builtin_amdgcn_s_waitcnt(0);
        unsigned nloc = b.st[0], nx = b.st[1];
        if (nloc == 0u) { xcd_barrier_complete(bar, b.x, nloc, nx); b.st[0] = nloc; b.st[1] = nx; }
        const unsigned old = xb_add(&bar[XB_XSUB(b.x)], 1u);
        const unsigned gen = old / nloc;
        if (old + 1u == (gen + 1u) * nloc) {
            __builtin_amdgcn_fence(__ATOMIC_RELEASE, "agent");
            asm volatile("s_waitcnt vmcnt(0)" ::: "memory");
            const unsigned og = xb_add(&bar[XB_TOP], 1u);
            const unsigned tg = og / nx;
            if (og + 1u == (tg + 1u) * nx) xb_add(&bar[XB_TOPGEN], 1u);
            else XB_SPIN(xb_ld(&bar[XB_TOPGEN]) == tg, bar);
            __builtin_amdgcn_fence(__ATOMIC_ACQUIRE, "agent");
            xb_add(&bar[XB_XGEN(b.x)], 1u);
            asm volatile("s_waitcnt vmcnt(0)" ::: "memory");
        } else {
            XB_SPIN(xb_ld(&bar[XB_XGEN(b.x)]) == gen, bar);
            __builtin_amdgcn_fence(__ATOMIC_ACQUIRE, "agent");
            asm volatile("s_waitcnt vmcnt(0)" ::: "memory");
        }
    }
    __syncthreads();
}

constexpr int NWAVES = 8;
constexpr int NB = 8, SEQ = 4096, D = 1024, M = NB * SEQ, INW = 4352, NE = 32, FF = 1024;
constexpr float RMS_EPS = 1e-5f;
constexpr float QSCALE = 0.125f * 1.4426950408889634f;
constexpr float LOG2E = 1.4426950408889634f;
constexpr float SX = 16.f, SW = 512.f, SH = 4.f, SY = 64.f, ST = 16.f, SO = 16.f;
constexpr size_t MiB = 1u << 20;
constexpr size_t WS_CTL = 0, CTL_ZERO_BYTES = 1 * MiB;
constexpr size_t WS_ROPE = 1 * MiB;
constexpr size_t WS_ETOK = 2 * MiB;
constexpr size_t WS_ERS = 10 * MiB;
constexpr size_t WS_RWF = 14 * MiB;
constexpr size_t WS_WIN = 16 * MiB;
constexpr size_t WS_WA = 25 * MiB, WS_WO = 27 * MiB;
constexpr size_t WS_W1 = 30 * MiB;
constexpr size_t WS_W2 = 158 * MiB;
constexpr size_t WS_XN = 222 * MiB;
constexpr size_t WS_RS0 = 14 * MiB + 512 * 1024;
constexpr size_t WS_X1Q = 494 * MiB;
constexpr size_t WS_QA = 286 * MiB, WS_KA = 318 * MiB, WS_VA = 326 * MiB, WS_QB = 334 * MiB, WS_KB = 366 * MiB, WS_VB = 398 * MiB;
constexpr size_t WS_SGA = 430 * MiB, WS_SGB = 494 * MiB, WS_OSWA = 558 * MiB, WS_OD1 = 590 * MiB, WS_OD2 = 622 * MiB, WS_T = 654 * MiB;
constexpr size_t WS_H = 286 * MiB;
constexpr size_t WS_X1B = 430 * MiB;
constexpr size_t WS_Y = 558 * MiB;
constexpr size_t WS_O8 = 687 * MiB;
constexpr size_t WS_XN8 = 720 * MiB;
constexpr size_t WS_WING8 = 20 * MiB;
constexpr size_t WS_END = 815 * MiB;
constexpr int CW_TMO = 0, CW_CODE = 1, CW_BAR = 4096, CW_CNT = 8192, CW_Q1 = 10240, CW_Q2 = 10752;
constexpr int NCONV = 64;
static_assert((CW_CNT + 64 * NE) * 4 <= (int)CTL_ZERO_BYTES, "CTL words inside the memset region");
constexpr int RING_OFF = 0, RING_BYTES = 131072;
constexpr int LDSCTL_OFF = RING_BYTES, MISC_OFF = LDSCTL_OFF + 320;
constexpr int SCHED_OFF = LDSCTL_OFF + 512;
constexpr int GTAB_OFF = SCHED_OFF + 1024;
constexpr int UTAB_OFF = GTAB_OFF + 17 * 256 * 2;
constexpr int LDS_BYTES = 147456;
static_assert(GTAB_OFF + 17 * 512 <= LDS_BYTES, "LDS map");

__device__ const float INV_FREQ[32] = {1.000000000e+00f, 7.498942614e-01f, 5.623413324e-01f, 4.216965139e-01f, 3.162277639e-01f, 2.371373773e-01f, 1.778279394e-01f, 1.333521307e-01f, 1.000000015e-01f, 7.498941571e-02f, 5.623413250e-02f, 4.216965288e-02f, 3.162277490e-02f, 2.371373773e-02f, 1.778279431e-02f, 1.333521493e-02f, 9.999999776e-03f, 7.498941850e-03f, 5.623413250e-03f, 4.216964822e-03f, 3.162277630e-03f, 2.371373586e-03f, 1.778279431e-03f, 1.333521446e-03f, 1.000000047e-03f, 7.498942432e-04f, 5.623413017e-04f, 4.216965172e-04f, 3.162277571e-04f, 2.371373703e-04f, 1.778279402e-04f, 1.333521504e-04f};

struct Frame {
    LAS unsigned char* lds;
    volatile LAS unsigned* MISC;
    gu32* ctl;
    unsigned char* ws;
    int tid, lane, wave;
    int vcu, G;
    const float* in[21]; float* out;
};
__device__ __forceinline__ float wave_sum(float v) {
#pragma unroll
    for (int o = 1; o < 64; o <<= 1) v += __shfl_xor(v, o);
    return v;
}
__device__ __forceinline__ int proj_mode(int hb) { return hb < 4 ? 0 : hb == 4 ? 1 : hb == 5 ? 2 : hb < 10 ? 0 : hb < 14 ? 1 : hb < 18 ? 2 : 3; }
__device__ __forceinline__ void proj_dst(int hb, size_t& off, int& ldc, int& col0) {
    if (hb < 4) { off = WS_QA; ldc = 512; col0 = 128 * hb; }
    else if (hb == 4) { off = WS_KA; ldc = 128; col0 = 0; }
    else if (hb == 5) { off = WS_VA; ldc = 128; col0 = 0; }
    else if (hb < 10) { off = WS_QB; ldc = 512; col0 = 128 * (hb - 6); }
    else if (hb < 14) { off = WS_KB; ldc = 512; col0 = 128 * (hb - 10); }
    else if (hb < 18) { off = WS_VB; ldc = 512; col0 = 128 * (hb - 14); }
    else if (hb < 26) { off = WS_SGA; ldc = 1024; col0 = 128 * (hb - 18); }
    else { off = WS_SGB; ldc = 1024; col0 = 128 * (hb - 26); }
}
__device__ __forceinline__ int proj_rowmap(int n) { const int hb = n >> 7; if (proj_mode(hb) > 1) return n; const int d = n & 63; return (n & ~63) + 8 * ((d & 31) >> 2) + 4 * (d >> 5) + (d & 3); }
__device__ __forceinline__ int proj_row(int n) {
    if (n < 768) return proj_rowmap(n);
    if (n < 1792) { const int m = n - 768, t = m >> 9, sl = (m & 511) >> 6, d = m & 63, h = sl >> 1, c = sl & 1, dp = 8 * ((d & 31) >> 2) + 4 * (d >> 5) + (d & 3);
        const int r = (2 * t + (h >> 1)) * 128 + (h & 1) * 64 + dp; return c ? 768 + r : r; }
    if (n < 2304) return 512 + (n - 1792);
    const int g = n - 2304; return 1280 + (g & ~255) + 128 * ((g >> 3) & 1) + 8 * ((g & 255) >> 4) + (g & 7);
}
__device__ __forceinline__ int proj_block_bf16(int j) { return j < 16 ? 768 + (j >> 3) * 512 + (2 * ((j >> 1) & 3)) * 64 + (j & 1) * 32 : 1792 + (j - 16) * 32; }
__device__ __forceinline__ int proj_block_fp8(int j) { if (j < 24) return 32 * j; if (j < 40) { const int jj = j - 24; return 768 + (jj >> 3) * 512 + (2 * ((jj >> 1) & 3) + 1) * 64 + (jj & 1) * 32; } return 2304 + (j - 40) * 32; }
struct ProjHalf { int mode; size_t off; int ldc, col0, hs, nreg; };
template <bool G8> __device__ __forceinline__ ProjHalf proj_half(int gh) {
    ProjHalf h; h.hs = 64;
    if (G8) {
        if (gh < 6) { h.mode = proj_mode(gh); proj_dst(gh, h.off, h.ldc, h.col0); h.nreg = gh < 4 ? 0 : gh == 4 ? 512 : 640; }
        else if (gh < 10) { const int t = (gh - 6) >> 1, i = (gh - 6) & 1; h.mode = t; h.off = t ? WS_KB : WS_QB; h.ldc = 512; h.col0 = 256 * i + 64; h.hs = 128; h.nreg = t ? 1280 : 768; }
        else { const int hb = gh + 8; h.mode = 3; proj_dst(hb, h.off, h.ldc, h.col0); h.nreg = hb < 26 ? 2304 : 3328; }
    } else {
        if (gh < 4) { const int t = gh >> 1, i = gh & 1; h.mode = t; h.off = t ? WS_KB : WS_QB; h.ldc = 512; h.col0 = 256 * i; h.hs = 128; h.nreg = t ? 1280 : 768; }
        else { h.mode = 2; h.off = WS_VB; h.ldc = 512; h.col0 = 128 * (gh - 4); h.nreg = 1792; }
    }
    return h;
}

__device__ __forceinline__ unsigned pk4_fp8(float a, float b, float c, float d) { int w = 0; w = __builtin_amdgcn_cvt_pk_fp8_f32(a, b, w, false); w = __builtin_amdgcn_cvt_pk_fp8_f32(c, d, w, true); return (unsigned)w; }
__device__ __forceinline__ float clamp8(float v) { return __builtin_amdgcn_fmed3f(v, -448.f, 448.f); }
template <int RMODE> __device__ __forceinline__ void p0_transpose_item(const float* W, int K, int N, bf16* WT, const float* kscale, LAS float* scr, int item, int lane, int pitch = 0, int koff = 0) {
    if (pitch == 0) pitch = K;
    const int nblk = N / 32, kb = item / nblk, nb = item % nblk, k0 = 64 * kb, n0 = 32 * nb;
#pragma unroll 8
    for (int i = 0; i < 32; ++i) { const int kk = 2 * i + (lane >> 5); float v = W[(size_t)(k0 + kk) * N + n0 + (lane & 31)]; if (kscale) v *= kscale[k0 + kk]; scr[kk * 33 + (lane & 31)] = v; }
    LDS_WAIT(); asm volatile("" ::: "memory");
    const int c = lane & 7;
#pragma unroll
    for (int j = 0; j < 4; ++j) { const int n = (lane >> 3) + 8 * j; const LAS float* s = scr + (8 * c) * 33 + n;
        v4u o; o.x = pk2(s[0 * 33], s[1 * 33]); o.y = pk2(s[2 * 33], s[3 * 33]); o.z = pk2(s[4 * 33], s[5 * 33]); o.w = pk2(s[6 * 33], s[7 * 33]);
        const int drow = RMODE ? proj_row(n0 + n) : (n0 + n);
        *(GAS v4u*)(WT + (size_t)drow * pitch + koff + k0 + 8 * c) = o; }
    LDS_WAIT(); asm volatile("" ::: "memory");
}
struct Fp8Item { const float* W; unsigned char* WT; const float* kscale; int K, N, k0, n0, rmode; };
__device__ __forceinline__ Fp8Item fp8_item_make(const float* W, int K, int N, unsigned char* WT, const float* kscale, int item, int ncols = 0, int rmode = 0) {
    const int nblk = (ncols ? ncols : N) / 32, kb = item / nblk, nb = item % nblk; Fp8Item it{W, WT, kscale, K, N, 128 * kb, 32 * nb, rmode}; return it; }
__device__ __forceinline__ void fp8_item_load(const Fp8Item& it, f32x4 (&v)[4][4], f32x4 (&ksv)[4], int lane) {
    const int n4 = lane & 7, kq = lane >> 3;
#pragma unroll
    for (int p = 0; p < 4; ++p)
#pragma unroll
        for (int r = 0; r < 4; ++r) v[p][r] = __builtin_nontemporal_load((const GAS f32x4*)(it.W + (size_t)(it.k0 + 32 * p + 4 * kq + r) * it.N + it.n0 + 4 * n4));
#pragma unroll
    for (int p = 0; p < 4; ++p) ksv[p] = it.kscale ? *(const GAS f32x4*)(it.kscale + it.k0 + 32 * p + 4 * kq) : (f32x4){1.f, 1.f, 1.f, 1.f};
}
__device__ __forceinline__ void fp8_item_finish(const Fp8Item& it, const f32x4 (&v)[4][4], const f32x4 (&ksv)[4], float scale, LAS unsigned* scr, int lane) {
    const int n4 = lane & 7, kq = lane >> 3;
#pragma unroll
    for (int p = 0; p < 4; ++p) { float ks[4];
#pragma unroll
        for (int r = 0; r < 4; ++r) ks[r] = ksv[p][r] * scale;
#pragma unroll
        for (int j = 0; j < 4; ++j) { int w = 0; w = __builtin_amdgcn_cvt_pk_fp8_f32(v[p][0][j] * ks[0], v[p][1][j] * ks[1], w, false); w = __builtin_amdgcn_cvt_pk_fp8_f32(v[p][2][j] * ks[2], v[p][3][j] * ks[3], w, true);
            scr[(8 * p + kq) * 33 + 4 * n4 + j] = (unsigned)w; } }
    LDS_WAIT(); asm volatile("" ::: "memory");
    const int c = lane & 7, nn = lane >> 3;
#pragma unroll
    for (int i = 0; i < 4; ++i) { const int n = nn + 8 * i; const LAS unsigned* sp = scr + (4 * c) * 33 + n;
        v4u o; o.x = sp[0]; o.y = sp[33]; o.z = sp[66]; o.w = sp[99];
        const int cn = it.n0 + n;
        const int drow = it.rmode == 1 ? proj_row(cn) : it.rmode == 2 ? (cn & ~255) + 128 * ((cn >> 3) & 1) + 8 * ((cn & 255) >> 4) + (cn & 7) : cn;
        __builtin_nontemporal_store(o, (GAS v4u*)(it.WT + (size_t)drow * it.K + it.k0 + 16 * c)); }
    LDS_WAIT(); asm volatile("" ::: "memory");
}
__device__ __forceinline__ void rms_rows2_to_bf16(const float* xrow, const float* g, bf16* orow, unsigned char* orow8, float* invr, int lane) {
    const GAS f32x4* xr = (const GAS f32x4*)xrow + lane;
    f32x4 v[2][4]; float s[2] = {0.f, 0.f};
#pragma unroll
    for (int q = 0; q < 2; ++q)
#pragma unroll
        for (int j = 0; j < 4; ++j) v[q][j] = __builtin_nontemporal_load(xr + q * (D / 4) + 64 * j);
#pragma unroll
    for (int q = 0; q < 2; ++q)
#pragma unroll
        for (int j = 0; j < 4; ++j) s[q] += (v[q][j].x * v[q][j].x + v[q][j].y * v[q][j].y) + (v[q][j].z * v[q][j].z + v[q][j].w * v[q][j].w);
    f32x4 gg[4];
#pragma unroll
    for (int j = 0; j < 4; ++j) gg[j] = ((const GAS f32x4*)g)[lane + 64 * j];
#pragma unroll
    for (int q = 0; q < 2; ++q) { const float rt_ = sqrtf(wave_sum(s[q]) * (1.f / D) + RMS_EPS), rstd = 1.f / rt_; if (lane == 0) invr[q] = rt_;
        GAS unsigned long long* o8 = (GAS unsigned long long*)(orow + (size_t)q * D) + lane;
#pragma unroll
        for (int j = 0; j < 4; ++j) o8[64 * j] = (unsigned long long)pk2(v[q][j].x * rstd * gg[j].x, v[q][j].y * rstd * gg[j].y) | ((unsigned long long)pk2(v[q][j].z * rstd * gg[j].z, v[q][j].w * rstd * gg[j].w) << 32);
        GAS unsigned* o4 = (GAS unsigned*)(orow8 + (size_t)q * D) + lane; const float r8 = rstd * SX;
#pragma unroll
        for (int j = 0; j < 4; ++j) o4[64 * j] = pk4_fp8(clamp8(v[q][j].x * r8 * gg[j].x), clamp8(v[q][j].y * r8 * gg[j].y), clamp8(v[q][j].z * r8 * gg[j].z), clamp8(v[q][j].w * r8 * gg[j].w)); }
}
__device__ __forceinline__ void p0_prologue(Frame& F) {
    LAS float* scr = (LAS float*)(F.lds + RING_OFF + F.wave * 16384);
    const int gw = F.vcu * NWAVES + F.wave, NGW = F.G * NWAVES;
    const float* w_in = F.in[2];
    bf16* WIN = (bf16*)(F.ws + WS_WIN);
    constexpr int I_IN = (D / 64) * 32, I_8 = (D / 128) * 104;
    constexpr int NITEMS = I_IN + I_8;
    for (int it = gw; it < NITEMS; it += NGW) {
        if (it < I_IN) { p0_transpose_item<1>(w_in, D, INW, WIN, nullptr, scr, (it >> 5) * (INW / 32) + proj_block_bf16(it & 31) / 32, F.lane); continue; }
        const int i8 = it - I_IN;
        const Fp8Item fi = fp8_item_make(w_in, D, INW, F.ws + WS_WING8, nullptr, (i8 / 104) * (INW / 32) + proj_block_fp8(i8 % 104) / 32, 0, 1);
        f32x4 fv[4][4], fk[4]; fp8_item_load(fi, fv, fk, F.lane); fp8_item_finish(fi, fv, fk, SW, (LAS unsigned*)scr, F.lane);
    }
    bf16* XN = (bf16*)(F.ws + WS_XN);
    for (int m = 2 * gw; m < M; m += 2 * NGW) rms_rows2_to_bf16(F.in[0] + (size_t)m * D, F.in[1], XN + (size_t)m * D, F.ws + WS_XN8 + (size_t)m * D, (float*)(F.ws + WS_RS0) + m, F.lane);
    const int gt = F.vcu * (NWAVES * 64) + F.tid, NGT = F.G * NWAVES * 64;
    unsigned* rope = (unsigned*)(F.ws + WS_ROPE);
    for (int idx = gt; idx < SEQ * 32; idx += NGT) { const int s = idx >> 5, i = idx & 31; const float ang = (float)s * INV_FREQ[i];
        const double rev = (double)ang * 0.15915494309189535; const double fr = rev - rint(rev);
        rope[idx] = pk2(__builtin_amdgcn_cosf((float)fr), __builtin_amdgcn_sinf((float)fr)); }
    v4u* rwf = (v4u*)(F.ws + WS_RWF);
    for (int idx = gt; idx < 64 * 64; idx += NGT) { const int ks = idx >> 6, ln = idx & 63, e = ln & 31, kb = 16 * ks + 8 * (ln >> 5);
        float v[8]; unsigned h[8], l[8];
#pragma unroll
        for (int j = 0; j < 8; ++j) { v[j] = F.in[13][kb + j] * F.in[14][(size_t)(kb + j) * NE + e]; h[j] = f2bf(v[j]); l[j] = f2bf(v[j] - __uint_as_float(h[j] << 16)); }
        v4u oh, ol; oh.x = h[0] | (h[1] << 16); oh.y = h[2] | (h[3] << 16); oh.z = h[4] | (h[5] << 16); oh.w = h[6] | (h[7] << 16);
        ol.x = l[0] | (l[1] << 16); ol.y = l[2] | (l[3] << 16); ol.z = l[4] | (l[5] << 16); ol.w = l[6] | (l[7] << 16);
        rwf[idx] = oh; rwf[4096 + idx] = ol; }
}

__device__ __forceinline__ Fp8Item moe_item(const float* w1, const float* w2, const float* wo, const float* waa, const float* wab, unsigned char* W1, unsigned char* W2, unsigned char* WO, unsigned char* WA, const float* g, int r) {
    constexpr int I_1 = (D / 128) * (2 * FF / 32), I_2 = (FF / 128) * (D / 32);
    if (r < NE * I_1) { const int e = r / I_1; return fp8_item_make(w1 + (size_t)e * D * 2 * FF, D, 2 * FF, W1 + (size_t)e * 2 * FF * D, g, r % I_1); }
    const int r2 = r - NE * I_1, e = r2 / I_2;
    if (e <= NE) return fp8_item_make(e < NE ? w2 + (size_t)e * FF * D : wo, FF, D, e < NE ? W2 + (size_t)e * D * FF : WO, nullptr, r2 % I_2, 0, 2);
    const int r3 = r2 - (NE + 1) * I_2, hb = r3 >> 7;
    return fp8_item_make(hb ? wab : waa, D, D, WA + 512 * hb, nullptr, r3 & 127, 0, 2);
}
__device__ __forceinline__ void moe_weight_convert(Frame& F, int gw, int NGW, LAS unsigned* scr) {
    constexpr int NIT = NE * ((D / 128) * (2 * FF / 32) + (FF / 128) * (D / 32)) + 2 * (FF / 128) * (D / 32);
    const float* w1 = F.in[16]; const float* w2 = F.in[18]; const float* wo = F.in[12]; unsigned char* W1 = F.ws + WS_W1; unsigned char* W2 = F.ws + WS_W2; unsigned char* WO = F.ws + WS_WO; unsigned char* WA = F.ws + WS_WA; const float* waa = F.in[10]; const float* wab = F.in[11]; const float* g = F.in[13];
    int ra = gw, rb = gw + NGW;
    if (ra >= NIT) return;
    Fp8Item a = moe_item(w1, w2, wo, waa, wab, W1, W2, WO, WA, g, ra), b = moe_item(w1, w2, wo, waa, wab, W1, W2, WO, WA, g, rb < NIT ? rb : NIT - 1);
    f32x4 va[4][4], vb[4][4], ka[4], kb[4];
    fp8_item_load(a, va, ka, F.lane); fp8_item_load(b, vb, kb, F.lane);
#pragma unroll 1
    for (;;) {
        fp8_item_finish(a, va, ka, SW, scr, F.lane);
        ra += 2 * NGW; const bool more_a = ra < NIT;
        a = moe_item(w1, w2, wo, waa, wab, W1, W2, WO, WA, g, more_a ? ra : NIT - 1); fp8_item_load(a, va, ka, F.lane);
        if (rb < NIT) fp8_item_finish(b, vb, kb, SW, scr, F.lane);
        rb += 2 * NGW; const bool more_b = rb < NIT;
        b = moe_item(w1, w2, wo, waa, wab, W1, W2, WO, WA, g, more_b ? rb : NIT - 1); fp8_item_load(b, vb, kb, F.lane);
        if (!more_a) break;
    }
    asm volatile("s_waitcnt vmcnt(0)" ::: "memory");
}
template <bool G8> struct EpiProj {
    static constexpr bool MID = false;
    unsigned char* ws; const float* bias; const unsigned* rope; int noepi;
    __device__ __forceinline__ void operator()(const pg8::f32x4 (&acc)[2][2][4][2], const pg8::Unit& u, int, int wr, int wc, int fr, int fq) const {
        using namespace pg8;
        if (noepi) { asm volatile("s_waitcnt vmcnt(0)" ::: "memory"); return; }
        if (G8 && u.pn >= 5) {
            const int gt = u.pn - 5, c0 = (gt & 3) * 256 + 16 * (4 * wc + fq); unsigned char* dst = ws + (gt < 4 ? WS_SGA : WS_SGB);
            const float* bp = bias + 2304 + gt * 256 + 16 * (4 * wc + fq);
            f32x4 bv[2][2];
#pragma unroll
            for (int bj = 0; bj < 2; ++bj) { bv[bj][0] = *(const f32x4*)(bp + 8 * bj); bv[bj][1] = *(const f32x4*)(bp + 8 * bj + 4); }
#pragma unroll
            for (int ai = 0; ai < 2; ++ai)
#pragma unroll
                for (int m = 0; m < 4; ++m) { const int row = u.pm * BM + ai * HALF + wr * 64 + m * 16 + fr; u32x4 w;
#pragma unroll
                    for (int bj = 0; bj < 2; ++bj)
#pragma unroll
                        for (int n = 0; n < 2; ++n) {
                            f32x4 t = (acc[ai][bj][m][n] * (1.f / (SX * SW)) + bv[bj][n]) * (-LOG2E);
#pragma unroll
                            for (int j = 0; j < 4; ++j) t[j] = __builtin_amdgcn_exp2f(t[j]);
                            t = t + 1.f;
#pragma unroll
                            for (int j = 0; j < 4; ++j) t[j] = __builtin_amdgcn_rcpf(t[j]);
                            t = t * 255.f + 8388608.f;
                            w[2 * bj + n] = __builtin_amdgcn_perm(__builtin_amdgcn_perm(__float_as_uint(t[3]), __float_as_uint(t[2]), 0x04000c0cu), __builtin_amdgcn_perm(__float_as_uint(t[1]), __float_as_uint(t[0]), 0x0c0c0400u), 0x07060100u); }
                    *(u32x4*)(dst + (size_t)row * 1024 + c0) = w; }
            return;
        }
        const ProjHalf h0 = proj_half<G8>(2 * u.pn), h1 = proj_half<G8>(2 * u.pn + 1);
        const int m0 = h0.mode, m1 = h1.mode;
        constexpr float AS = G8 ? 1.f / (SX * SW) : 1.f;
        const int dlo = 4 * (4 * (wc & 1) + fq);
        u32x4 cs[2][4];
        if (m0 <= 1 || m1 <= 1) {
#pragma unroll
            for (int ai = 0; ai < 2; ++ai)
#pragma unroll
                for (int m = 0; m < 4; ++m) { const int s = (u.pm * BM + ai * HALF + wr * 64 + m * 16 + fr) & (SEQ - 1);
                    cs[ai][m] = *(const u32x4*)(rope + (size_t)(s * 32 + dlo)); }
        }
        f32x4 bv[2][2];
#pragma unroll
        for (int bj = 0; bj < 2; ++bj) { const ProjHalf& h = bj ? h1 : h0; const float* bp = bias + h.nreg + h.col0 + (h.mode <= 1 ? h.hs * (wc >> 1) + dlo : wc * 32 + 8 * fq);
            bv[bj][0] = *(const f32x4*)bp; bv[bj][1] = *(const f32x4*)(bp + (h.mode <= 1 ? 32 : 4)); }
#pragma unroll
        for (int bj = 0; bj < 2; ++bj) {
            const ProjHalf& h = bj ? h1 : h0; const int mode = h.mode, ldc = h.ldc, col0 = h.col0;
            bf16_t* dst = (bf16_t*)(ws + h.off);
            if (mode <= 1) {
                const int hcol = col0 + h.hs * (wc >> 1);
                const float sc = mode == 0 ? QSCALE : 1.f;
#pragma unroll
                for (int ai = 0; ai < 2; ++ai)
#pragma unroll
                    for (int m = 0; m < 4; ++m) { const int row = u.pm * BM + ai * HALF + wr * 64 + m * 16 + fr;
                        const u32x4 cw = cs[ai][m];
                        const f32x4 x1 = acc[ai][bj][m][0] * AS + bv[bj][0], x2 = acc[ai][bj][m][1] * AS + bv[bj][1];
                        const f32x4 c = {bf_lo(cw.x), bf_lo(cw.y), bf_lo(cw.z), bf_lo(cw.w)}, sn = {bf_hi(cw.x), bf_hi(cw.y), bf_hi(cw.z), bf_hi(cw.w)};
                        const f32x4 o1 = (x1 * c - x2 * sn) * sc, o2 = (x2 * c + x1 * sn) * sc;
                        bf16_t* rp = dst + (size_t)row * ldc + hcol + dlo;
                        u32x2 w1, w2; w1.x = cvt_pk_bf16(o1[0], o1[1]); w1.y = cvt_pk_bf16(o1[2], o1[3]); w2.x = cvt_pk_bf16(o2[0], o2[1]); w2.y = cvt_pk_bf16(o2[2], o2[3]);
                        *(u32x2*)rp = w1; *(u32x2*)(rp + 32) = w2; }
            } else {
                const int c8 = wc * 32 + 8 * fq;
#pragma unroll
                for (int ai = 0; ai < 2; ++ai)
#pragma unroll
                    for (int m = 0; m < 4; ++m) { const int row = u.pm * BM + ai * HALF + wr * 64 + m * 16 + fr;
                        f32x4 v0 = acc[ai][bj][m][0] * AS + bv[bj][0], v1 = acc[ai][bj][m][1] * AS + bv[bj][1];
                        if (mode == 3) {
                            f32x4 t0 = v0 * (-LOG2E), t1 = v1 * (-LOG2E);
#pragma unroll
                            for (int j = 0; j < 4; ++j) { t0[j] = __builtin_amdgcn_exp2f(t0[j]); t1[j] = __builtin_amdgcn_exp2f(t1[j]); }
                            t0 = t0 + 1.f; t1 = t1 + 1.f;
#pragma unroll
                            for (int j = 0; j < 4; ++j) { t0[j] = __builtin_amdgcn_rcpf(t0[j]); t1[j] = __builtin_amdgcn_rcpf(t1[j]); }
                            t0 = t0 * 255.f + 8388608.f; t1 = t1 * 255.f + 8388608.f;
                            u32x2 w;
                            w.x = __builtin_amdgcn_perm(__builtin_amdgcn_perm(__float_as_uint(t0[3]), __float_as_uint(t0[2]), 0x04000c0cu), __builtin_amdgcn_perm(__float_as_uint(t0[1]), __float_as_uint(t0[0]), 0x0c0c0400u), 0x07060100u);
                            w.y = __builtin_amdgcn_perm(__builtin_amdgcn_perm(__float_as_uint(t1[3]), __float_as_uint(t1[2]), 0x04000c0cu), __builtin_amdgcn_perm(__float_as_uint(t1[1]), __float_as_uint(t1[0]), 0x0c0c0400u), 0x07060100u); *(u32x2*)((unsigned char*)dst + (size_t)row * ldc + col0 + c8) = w;
                        } else {
                        u32x4 w; w.x = cvt_pk_bf16(v0[0], v0[1]); w.y = cvt_pk_bf16(v0[2], v0[3]); w.z = cvt_pk_bf16(v1[0], v1[1]); w.w = cvt_pk_bf16(v1[2], v1[3]);
                        *(u32x4*)(dst + (size_t)row * ldc + col0 + c8) = w; } }
            }
        }
    }
};
struct EpiGateFused {
    static constexpr bool MID = true;
    unsigned char* T; const unsigned char* sga; const unsigned char* sgb;
    __device__ __forceinline__ void mid(pg8::f32x4 (&acc)[2][2][4][2], const pg8::Unit& u, int wr, int wc, int fr, int fq) const {
        using namespace pg8;
        u32x4 ga[2][4], gb[2][4];
#pragma unroll
        for (int ai = 0; ai < 2; ++ai)
#pragma unroll
            for (int m = 0; m < 4; ++m) { const size_t o = (size_t)(u.pm * BM + ai * HALF + wr * 64 + m * 16 + fr) * D + u.pn * BM + 16 * (4 * wc + fq);
                ga[ai][m] = *(const u32x4*)(sga + o); gb[ai][m] = *(const u32x4*)(sgb + o); }
#pragma unroll
        for (int ai = 0; ai < 2; ++ai)
#pragma unroll
            for (int m = 0; m < 4; ++m)
#pragma unroll
                for (int bj = 0; bj < 2; ++bj)
#pragma unroll
                    for (int n = 0; n < 2; ++n) { const unsigned a = ga[ai][m][2 * bj + n], b = gb[ai][m][2 * bj + n]; f32x4 r;
#pragma unroll
                        for (int j = 0; j < 4; ++j) { const unsigned bb = (b >> (8 * j)) & 0xffu; r[j] = (float)((a >> (8 * j)) & 0xffu) * __builtin_amdgcn_rcpf((float)(bb ? bb : 1u)); }
                        acc[ai][bj][m][n] = acc[ai][bj][m][n] * r; }
    }
    __device__ __forceinline__ void operator()(const pg8::f32x4 (&acc)[2][2][4][2], const pg8::Unit& u, int, int wr, int wc, int fr, int fq) const {
        using namespace pg8;
        u32x4 gb[2][4];
#pragma unroll
        for (int ai = 0; ai < 2; ++ai)
#pragma unroll
            for (int m = 0; m < 4; ++m) gb[ai][m] = *(const u32x4*)(sgb + (size_t)(u.pm * BM + ai * HALF + wr * 64 + m * 16 + fr) * D + u.pn * BM + 16 * (4 * wc + fq));
#pragma unroll
        for (int ai = 0; ai < 2; ++ai)
#pragma unroll
            for (int m = 0; m < 4; ++m) { const size_t o = (size_t)(u.pm * BM + ai * HALF + wr * 64 + m * 16 + fr) * D + u.pn * BM + 16 * (4 * wc + fq); u32x4 w;
#pragma unroll
                for (int bj = 0; bj < 2; ++bj) {
                    const f32x4 a0 = acc[ai][bj][m][0] * (ST / (255.f * SO * SW)), a1 = acc[ai][bj][m][1] * (ST / (255.f * SO * SW));
                    const unsigned g0 = gb[ai][m][2 * bj], g1 = gb[ai][m][2 * bj + 1];
                    float g[8];
#pragma unroll
                    for (int j = 0; j < 4; ++j) { const unsigned b0 = (g0 >> (8 * j)) & 0xffu, b1 = (g1 >> (8 * j)) & 0xffu; g[j] = (float)(b0 ? b0 : 1u); g[4 + j] = (float)(b1 ? b1 : 1u); }
                    w[2 * bj] = pk4_fp8(clamp8(a0[0] * g[0]), clamp8(a0[1] * g[1]), clamp8(a0[2] * g[2]), clamp8(a0[3] * g[3])); w[2 * bj + 1] = pk4_fp8(clamp8(a1[0] * g[4]), clamp8(a1[1] * g[5]), clamp8(a1[2] * g[6]), clamp8(a1[3] * g[7])); }
                *(u32x4*)(T + o) = w; }
    }
};
struct EpiX1 {
    static constexpr bool MID = false;
    const pg8::bf16_t* xn; const float* invr; const float* g0; pg8::bf16_t* x1; unsigned char* x1q;
    __device__ __forceinline__ void operator()(const pg8::f32x4 (&acc)[2][2][4][2], const pg8::Unit& u, int, int wr, int wc, int fr, int fq) const {
        using namespace pg8;
        const int c0 = u.pn * BM + 16 * (4 * wc + fq);
        f32x4 gi[2][2];
#pragma unroll
        for (int bj = 0; bj < 2; ++bj) { const float* gp = g0 + c0 + 8 * bj; gi[bj][0] = *(const f32x4*)gp; gi[bj][1] = *(const f32x4*)(gp + 4); }
#pragma unroll
        for (int ai = 0; ai < 2; ++ai) {
            u32x4 xv[4][2]; float ir[4];
#pragma unroll
            for (int m = 0; m < 4; ++m) { const int row = u.pm * BM + ai * HALF + wr * 64 + m * 16 + fr; ir[m] = invr[row];
#pragma unroll
                for (int bj = 0; bj < 2; ++bj) xv[m][bj] = *(const u32x4*)(xn + (size_t)row * D + c0 + 8 * bj); }
            if (ai == 0) {
#pragma unroll
                for (int bj = 0; bj < 2; ++bj)
#pragma unroll
                    for (int q = 0; q < 2; ++q)
#pragma unroll
                        for (int j = 0; j < 4; ++j) gi[bj][q][j] = __builtin_amdgcn_rcpf(gi[bj][q][j]); }
#pragma unroll
            for (int m = 0; m < 4; ++m) { const size_t o = (size_t)(u.pm * BM + ai * HALF + wr * 64 + m * 16 + fr) * D + c0; const float r_ = ir[m]; u32x4 wq;
#pragma unroll
                for (int bj = 0; bj < 2; ++bj) {
                    const u32x4 xw = xv[m][bj];
                    const f32x4 x0 = (f32x4){bf_lo(xw.x), bf_hi(xw.x), bf_lo(xw.y), bf_hi(xw.y)} * gi[bj][0] * r_, x1v = (f32x4){bf_lo(xw.z), bf_hi(xw.z), bf_lo(xw.w), bf_hi(xw.w)} * gi[bj][1] * r_;
                    const f32x4 v0 = x0 + acc[ai][bj][m][0] * (1.f / (ST * SW)), v1 = x1v + acc[ai][bj][m][1] * (1.f / (ST * SW));
                    u32x4 wb; wb.x = cvt_pk_bf16(v0[0], v0[1]); wb.y = cvt_pk_bf16(v0[2], v0[3]); wb.z = cvt_pk_bf16(v1[0], v1[1]); wb.w = cvt_pk_bf16(v1[2], v1[3]);
                    *(u32x4*)(x1 + o + 8 * bj) = wb;
                    wq[2 * bj] = pk4_fp8(clamp8(v0[0] * SX), clamp8(v0[1] * SX), clamp8(v0[2] * SX), clamp8(v0[3] * SX)); wq[2 * bj + 1] = pk4_fp8(clamp8(v1[0] * SX), clamp8(v1[1] * SX), clamp8(v1[2] * SX), clamp8(v1[3] * SX)); }
                *(u32x4*)(x1q + o) = wq; }
        }
    }
};
template <int NCT, bool GATHER> struct GroupSched {
    const LAS int* sch; const LAS unsigned short* gtab; int G, c; const LAS int* utab;
    __device__ __forceinline__ bool search(int i, pg8::Unit& u) const {
        const int L = i * G + c; if (L >= sch[32] * NCT) return false;
        int e = 0;
#pragma unroll 1
        for (int j = 16; j >= 1; j >>= 1) if (sch[e + j] * NCT <= L) e += j;
        const int local = L - sch[e] * NCT; u.e = e; u.pm = local / NCT; u.pn = local % NCT; u.cnt = sch[64 + e]; return true;
    }
    __device__ __forceinline__ void build(int tid) const {
        if (tid < 18) { pg8::Unit u; u.e = -1; u.pm = 0; u.pn = 0; u.cnt = 0; if (!search(tid, u)) u.e = -1;
            LAS int* t = (LAS int*)utab + 4 * tid; t[0] = u.e; t[1] = u.pm; t[2] = u.pn; t[3] = u.cnt; }
        __syncthreads();
    }
    __device__ __forceinline__ bool next(int i, pg8::Unit& u) const {
        const pg8::v4i t = *(const LAS pg8::v4i*)(utab + 4 * i); if (t.x < 0) return false;
        u.e = t.x; u.pm = t.y; u.pn = t.z; u.cnt = t.w; return true;
    }
    __device__ __forceinline__ int arow(int ui, const pg8::Unit& u, int r) const { if (GATHER) return (int)gtab[ui * 256 + r]; return (sch[u.e] + u.pm) * 256 + r; }
    __device__ __forceinline__ size_t boff(const pg8::Unit& u, int RB) const {
        if (GATHER) return ((size_t)u.e * 2 * FF + (size_t)u.pn * 128) * RB;
        return ((size_t)u.e * D + (size_t)u.pn * 256) * RB; }
    __device__ __forceinline__ int fetch(int) const { return 0; }
    __device__ __forceinline__ void post(int, int) const {}
};
struct EpiMoe1 {
    static constexpr bool MID = false;
    unsigned char* H; const float* b1; const float* ers; const LAS int* sch; int noepi;
    __device__ __forceinline__ void operator()(const pg8::f32x4 (&acc)[2][2][4][2], const pg8::Unit& u, int, int wr, int wc, int fr, int fq) const {
        using namespace pg8;
        if (noepi) { asm volatile("s_waitcnt vmcnt(0)" ::: "memory"); return; }
        const int j0 = u.pn * 128 + wc * 32 + 8 * fq; const float* bb = b1 + (size_t)u.e * 2 * FF + j0;
        const f32x4 bg0 = *(const f32x4*)bb, bg1 = *(const f32x4*)(bb + 4), bu0 = *(const f32x4*)(bb + FF), bu1 = *(const f32x4*)(bb + FF + 4);
        const int hrow0 = (sch[u.e] + u.pm) * 256;
        float rsv[2][4];
#pragma unroll
        for (int ai = 0; ai < 2; ++ai)
#pragma unroll
            for (int m = 0; m < 4; ++m) { const int slot = u.pm * 256 + ai * HALF + wr * 64 + m * 16 + fr; rsv[ai][m] = ers[(size_t)u.e * M + (slot < u.cnt ? slot : u.cnt - 1)]; }
#pragma unroll
        for (int ai = 0; ai < 2; ++ai)
#pragma unroll
            for (int m = 0; m < 4; ++m) { const int rl = ai * HALF + wr * 64 + m * 16 + fr, slot = u.pm * 256 + rl;
                const float rs = rsv[ai][m] * (1.f / (SX * SW));
                const f32x4 g0 = acc[ai][0][m][0] * rs + bg0, g1 = acc[ai][0][m][1] * rs + bg1, u0 = acc[ai][1][m][0] * rs + bu0, u1 = acc[ai][1][m][1] * rs + bu1;
                f32x4 gg[2] = {g0, g1}, uu[2] = {u0, u1}, rr[2];
#pragma unroll
                for (int q = 0; q < 2; ++q) { f32x4 g = gg[q], t;
#pragma unroll
                    for (int j = 0; j < 4; ++j) { g[j] = fminf(g[j], 7.f); uu[q][j] = __builtin_amdgcn_fmed3f(uu[q][j], -7.f, 7.f); }
                    t = g * (-1.702f * LOG2E);
#pragma unroll
                    for (int j = 0; j < 4; ++j) t[j] = __builtin_amdgcn_exp2f(t[j]);
                    t = t + 1.f;
#pragma unroll
                    for (int j = 0; j < 4; ++j) t[j] = __builtin_amdgcn_rcpf(t[j]);
                    rr[q] = (g * t) * (uu[q] * SH + SH); }
                u32x2 w; w.x = pk4_fp8(rr[0][0], rr[0][1], rr[0][2], rr[0][3]); w.y = pk4_fp8(rr[1][0], rr[1][1], rr[1][2], rr[1][3]);
                *(u32x2*)(H + (size_t)(hrow0 + rl) * FF + j0) = w; }
    }
};
struct EpiMoe2 {
    static constexpr bool MID = false;
    unsigned char* Y; const float* b2; const pg8::u32x2* etok; int noepi;
    __device__ __forceinline__ void operator()(const pg8::f32x4 (&acc)[2][2][4][2], const pg8::Unit& u, int, int wr, int wc, int fr, int fq) const {
        using namespace pg8;
        if (noepi) { asm volatile("s_waitcnt vmcnt(0)" ::: "memory"); return; }
        const int c0 = u.pn * 256 + 16 * (4 * wc + fq); const float* bb = b2 + (size_t)u.e * D + c0;
        f32x4 bv[2][2];
#pragma unroll
        for (int bj = 0; bj < 2; ++bj) { bv[bj][0] = *(const f32x4*)(bb + 8 * bj); bv[bj][1] = *(const f32x4*)(bb + 8 * bj + 4); }
        int tkv[2][4]; float wv[2][4];
#pragma unroll
        for (int ai = 0; ai < 2; ++ai)
#pragma unroll
            for (int m = 0; m < 4; ++m) { const int slot = u.pm * 256 + ai * HALF + wr * 64 + m * 16 + fr; const size_t o = (size_t)u.e * M + (slot < u.cnt ? slot : u.cnt - 1);
                const pg8::u32x2 rec = etok[o]; tkv[ai][m] = slot < u.cnt ? (int)rec.x : M * 4; wv[ai][m] = __uint_as_float(rec.y); }
#pragma unroll
        for (int ai = 0; ai < 2; ++ai)
#pragma unroll
            for (int m = 0; m < 4; ++m) { const int tk = tkv[ai][m]; const float w8 = wv[ai][m]; u32x4 w;
#pragma unroll
                for (int bj = 0; bj < 2; ++bj) { const f32x4 v0 = (acc[ai][bj][m][0] * (1.f / (SH * SW)) + bv[bj][0]) * (w8 * SY), v1 = (acc[ai][bj][m][1] * (1.f / (SH * SW)) + bv[bj][1]) * (w8 * SY);
                    w[2 * bj] = pk4_fp8(clamp8(v0[0]), clamp8(v0[1]), clamp8(v0[2]), clamp8(v0[3])); w[2 * bj + 1] = pk4_fp8(clamp8(v1[0]), clamp8(v1[1]), clamp8(v1[2]), clamp8(v1[3])); }
                *(u32x4*)(Y + (size_t)tk * D + c0) = w; }
    }
};

__device__ __forceinline__ void attn_phase_all(Frame& F, char* lds) {
    typedef attn_body::bf16 abf; using attn_body::attn_unit; using attn_body::attn_unit128;
    const int v = F.vcu;
    const abf* QA = (const abf*)(F.ws + WS_QA); const abf* KA = (const abf*)(F.ws + WS_KA); const abf* VA = (const abf*)(F.ws + WS_VA); unsigned char* O8 = F.ws + WS_O8;
    const abf* QB_ = (const abf*)(F.ws + WS_QB); const abf* KB = (const abf*)(F.ws + WS_KB); const abf* VB = (const abf*)(F.ws + WS_VB); abf* OD = (abf*)(F.ws + WS_OSWA) + 512;
    float lam; { const float p1 = F.in[5][F.lane] * F.in[6][F.lane], p2 = F.in[7][F.lane] * F.in[8][F.lane]; lam = __expf(wave_sum(p1)) - __expf(wave_sum(p2)) + 0.2f; }
    { const int vv = v;
        { const int bh = vv >> 3, h = bh & 3, b = bh >> 2, s = vv & 7;
#pragma unroll 1
          for (int i = 0; i < 4; ++i) { const int qb = (i >> 1) ? 15 - s : s, c = i & 1;
              attn_unit128<8>((long)b * SEQ, qb * 256, QB_ + (2 * h + c) * 64, KB + (2 * h + c) * 64, VB + h * 128, OD + h * 128, O8 + 512 + h * 128, c != 0, lam, F.in[9], lds); } }
        {
#pragma unroll 1
          for (int i = 0; i < 4; ++i) { const int un = 4 * vv + i, qb = un & 31, pj = (un >> 5) & 3, b = un >> 7, hq = 2 * pj;
              attn_unit<1, 128, 128, 8>((long)b * SEQ, qb * 128, QA + hq * 64, KA + (hq >> 2) * 64, VA + (hq >> 2) * 64, O8 + hq * 64, F.in[4][hq] * LOG2E, F.in[4][hq + 1] * LOG2E, lds); } }
    }
}

struct Args { const float* in[21]; float* out; unsigned char* ws; int ph_lo, ph_hi, noepi, pad; };
constexpr int N_PHASES = 10;
__global__ void __launch_bounds__(NWAVES * 64, 2) mk_fwd(Args args) {
    extern __shared__ __attribute__((aligned(16))) unsigned char lds[];
    Frame F;
    F.lds = (LAS unsigned char*)lds;
    F.MISC = (volatile LAS unsigned*)(F.lds + MISC_OFF);
    F.tid = threadIdx.x; F.lane = F.tid & 63; F.wave = __builtin_amdgcn_readfirstlane(F.tid >> 6);
    F.G = gridDim.x; { const int bx = blockIdx.x; F.vcu = (F.G % 8 == 0) ? (bx % 8) * (F.G / 8) + bx / 8 : bx; }
    F.ws = args.ws; F.ctl = (gu32*)(args.ws + WS_CTL); F.out = args.out;
#pragma unroll
    for (int i = 0; i < 21; ++i) F.in[i] = args.in[i];
    for (int u = F.tid; u < (LDS_BYTES - LDSCTL_OFF) / 4; u += NWAVES * 64) ((LAS unsigned*)(F.lds + LDSCTL_OFF))[u] = 0u;
    __syncthreads();
    const bool one = (args.ph_hi - args.ph_lo) > 1;
    XcdBarrier bar; bar.bar = (unsigned*)(F.ctl + CW_BAR); bar.x = 0; bar.st = nullptr;
    if (one) bar = xcd_barrier_post((unsigned*)(F.ctl + CW_BAR), F.MISC + 8);
    const int lo = args.ph_lo, hi = args.ph_hi;
#define IN(k) (lo <= (k) && (k) < hi)
#define SEAM(k) do { if (IN(k) && IN((k) + 1)) xcd_barrier(bar); } while (0)
    unsigned char* ws = F.ws;
    const LAS int* sch = (const LAS int*)(F.lds + SCHED_OFF);

    if (IN(0)) { p0_prologue(F); }
    SEAM(0);
    if (IN(1)) {
        pg8::Gemm g{ws + WS_XN, ws + WS_WIN, D * 2, (size_t)pg8::HALF * D * 2};
        if ((int)blockIdx.x < NCONV) { moe_weight_convert(F, (int)blockIdx.x * NWAVES + F.wave, NCONV * NWAVES, (LAS unsigned*)(F.lds + RING_OFF + F.wave * 16384)); __syncthreads(); }
        { pg8::QueueOrder S; S.init(M, 1024, (unsigned*)(F.ctl + CW_Q1), (volatile LAS int*)(F.MISC + 16), (int)(blockIdx.x & 7)); S.prime();
          EpiProj<false> E{ws, F.in[3], (const unsigned*)(ws + WS_ROPE), args.noepi};
          pg8::gemm_phase<false>(F.lds + RING_OFF, g, S, E); }
        { pg8::Gemm g8{ws + WS_XN8, ws + WS_WING8, D, (size_t)pg8::HALF * D};
          pg8::QueueOrder S; S.init(M, 3328, (unsigned*)(F.ctl + CW_Q2), (volatile LAS int*)(F.MISC + 16), (int)(blockIdx.x & 7)); S.prime();
          EpiProj<true> E{ws, F.in[3], (const unsigned*)(ws + WS_ROPE), args.noepi};
          pg8::gemm_phase<true>(F.lds + RING_OFF, g8, S, E); }
    }
    SEAM(1);
    if (IN(2)) { attn_phase_all(F, (char*)lds + RING_OFF); }
    SEAM(2);
    if (IN(4)) {
        pg8::StaticOrder S; S.init(M, D, F.G, (int)blockIdx.x);
        pg8::Gemm g{ws + WS_O8, ws + WS_WA, D, (size_t)pg8::HALF * D};
        EpiGateFused E{ws + WS_T, ws + WS_SGA, ws + WS_SGB};
        pg8::gemm_phase<true>(F.lds + RING_OFF, g, S, E);
    }
    SEAM(4);
    if (IN(5)) {
        pg8::Gemm g{ws + WS_T, ws + WS_WO, D, (size_t)pg8::HALF * D};
        pg8::StaticOrder S; S.init(M, D, F.G, (int)blockIdx.x);
        EpiX1 E{(const pg8::bf16_t*)(ws + WS_XN), (const float*)(ws + WS_RS0), F.in[1], (pg8::bf16_t*)(ws + WS_X1B), ws + WS_X1Q};
        if ((blockIdx.x >> 3) & 1) { __builtin_amdgcn_s_sleep(127); }
        pg8::gemm_phase<true>(F.lds + RING_OFF, g, S, E);
    }
    SEAM(5);
    if (IN(6)) {
        typedef float f32x16 __attribute__((ext_vector_type(16)));
        const int lane = F.lane, r32 = lane & 31, hi = lane >> 5;
        LAS int* wcnt = (LAS int*)(F.lds + RING_OFF + 24576);
        const int kh = F.wave >> 2;
        const int n_it = (M / 32) / (F.G * 4);
        for (int it = 0; it < n_it; ++it) {
            const int tile = (it * F.G + F.vcu) * 4 + (F.wave & 3), tok = tile * 32 + r32;
            int ti[4] = {0, 0, 0, 0}; float ex[4] = {0.f, 0.f, 0.f, 0.f}; float isum = 0.f, rstd = 0.f; int run0 = 0, run1 = 0, run2 = 0, run3 = 0;
            typedef float f32x16_ __attribute__((ext_vector_type(16)));
            f32x16_ acc = {}; float ss = 0.f;
            {
                const v4u* rwf = (const v4u*)(ws + WS_RWF) + 32 * kh * 64;
                const pg8::bf16_t* xr = (const pg8::bf16_t*)(ws + WS_X1B) + (size_t)tok * D + 8 * hi + 512 * kh;
#pragma unroll 8
                for (int ks = 0; ks < 32; ++ks) {
                    const v4u bh = *(const v4u*)(xr + 16 * ks);
                    ss += pg8::bf_lo(bh.x) * pg8::bf_lo(bh.x) + pg8::bf_hi(bh.x) * pg8::bf_hi(bh.x) + pg8::bf_lo(bh.y) * pg8::bf_lo(bh.y) + pg8::bf_hi(bh.y) * pg8::bf_hi(bh.y)
                        + pg8::bf_lo(bh.z) * pg8::bf_lo(bh.z) + pg8::bf_hi(bh.z) * pg8::bf_hi(bh.z) + pg8::bf_lo(bh.w) * pg8::bf_lo(bh.w) + pg8::bf_hi(bh.w) * pg8::bf_hi(bh.w);
                    const v4u ah = rwf[ks * 64 + lane], al = rwf[4096 + ks * 64 + lane];
                    acc = __builtin_amdgcn_mfma_f32_32x32x16_bf16(__builtin_bit_cast(bf16x8, ah), __builtin_bit_cast(bf16x8, bh), acc, 0, 0, 0);
                    acc = __builtin_amdgcn_mfma_f32_32x32x16_bf16(__builtin_bit_cast(bf16x8, al), __builtin_bit_cast(bf16x8, bh), acc, 0, 0, 0);
                }
                LAS float* xa = (LAS float*)(F.lds + RING_OFF) + (F.wave & 3) * (64 * 17) + lane;
                if (kh == 1) {
#pragma unroll
                    for (int r = 0; r < 16; ++r) xa[64 * r] = acc[r];
                    xa[64 * 16] = ss; }
                __syncthreads();
                if (kh == 0) {
#pragma unroll
                    for (int r = 0; r < 16; ++r) acc[r] += xa[64 * r];
                    ss += xa[64 * 16]; }
            }
            if (F.wave < 4) {
                ss += __shfl_xor(ss, 32);
                rstd = 1.f / sqrtf(ss * (1.f / D) + RMS_EPS);
                float lg[32];
#pragma unroll
                for (int e = 0; e < 32; ++e) { const int he = (e >> 2) & 1, r = (e & 3) + 4 * (e >> 3); const float own = acc[r], oth = __shfl_xor(own, 32);
                    lg[e] = ((he == hi) ? own : oth) * rstd + F.in[15][e]; }
                float tv[4];
#pragma unroll
                for (int k = 0; k < 4; ++k) { float best = -3.0e38f; int bi = 0;
#pragma unroll
                    for (int e = 0; e < 32; ++e) { if (lg[e] > best) { best = lg[e]; bi = e; } }
                    tv[k] = best; ti[k] = bi;
#pragma unroll
                    for (int e = 0; e < 32; ++e) if (e == bi) lg[e] = -3.0e38f; }
                float sum = 0.f;
#pragma unroll
                for (int k = 0; k < 4; ++k) { ex[k] = __builtin_amdgcn_exp2f((tv[k] - tv[0]) * LOG2E); sum += ex[k]; }
                isum = 1.f / sum;
                const unsigned long long lt = (1ull << lane) - 1ull;
                int myc = 0;
#pragma unroll 1
                for (int e = 0; e < 32; ++e) {
                    const unsigned long long m0 = __ballot(hi == 0 && ti[0] == e), m1 = __ballot(hi == 0 && ti[1] == e), m2 = __ballot(hi == 0 && ti[2] == e), m3 = __ballot(hi == 0 && ti[3] == e);
                    const int c0 = __popcll(m0), c1 = __popcll(m1), c2 = __popcll(m2), c3 = __popcll(m3);
                    if (lane == e) myc = c0 + c1 + c2 + c3;
                    if (ti[0] == e) run0 = __popcll(m0 & lt);
                    if (ti[1] == e) run1 = c0 + __popcll(m1 & lt);
                    if (ti[2] == e) run2 = c0 + c1 + __popcll(m2 & lt);
                    if (ti[3] == e) run3 = c0 + c1 + c2 + __popcll(m3 & lt);
                }
                if (lane < 32) wcnt[F.wave * 32 + lane] = myc;
            }
            __syncthreads();
            if (F.wave == 0 && lane < 32) {
                const int c0 = wcnt[lane], c1 = wcnt[32 + lane], c2 = wcnt[64 + lane], c3 = wcnt[96 + lane], tot = c0 + c1 + c2 + c3;
                int base = 0; if (tot > 0) base = (int)__hip_atomic_fetch_add((unsigned*)(F.ctl + CW_CNT + 64 * lane), (unsigned)tot, RLX_AGENT);
                wcnt[128 + lane] = base; wcnt[160 + lane] = base + c0; wcnt[192 + lane] = base + c0 + c1; wcnt[224 + lane] = base + c0 + c1 + c2;
            }
            __syncthreads();
            if (F.wave < 4 && hi == 0) {
                pg8::u32x2* etok = (pg8::u32x2*)(ws + WS_ETOK); float* ers = (float*)(ws + WS_ERS);
                const int pos[4] = {wcnt[128 + F.wave * 32 + ti[0]] + run0, wcnt[128 + F.wave * 32 + ti[1]] + run1, wcnt[128 + F.wave * 32 + ti[2]] + run2, wcnt[128 + F.wave * 32 + ti[3]] + run3};
#pragma unroll
                for (int k = 0; k < 4; ++k) { const size_t o = (size_t)ti[k] * M + pos[k];
                    pg8::u32x2 rec; rec.x = (unsigned)(tok * 4 + k); rec.y = __float_as_uint(ex[k] * isum); etok[o] = rec; ers[o] = rstd; }
            }
            __syncthreads();
        }
    }
    SEAM(6);
    if (IN(7) || IN(8)) {
        if (F.tid < 32) { ((LAS int*)sch)[64 + F.tid] = (int)__hip_atomic_load((unsigned*)(F.ctl + CW_CNT + 64 * F.tid), RLX_AGENT); }
        __syncthreads();
        if (F.tid == 0) { int a = 0; for (int e = 0; e < 32; ++e) { ((LAS int*)sch)[e] = a; a += (sch[64 + e] + 255) >> 8; } ((LAS int*)sch)[32] = a; }
        __syncthreads();
    }
    if (IN(7)) {
        const LAS unsigned short* gtab = (const LAS unsigned short*)(F.lds + GTAB_OFF);
        GroupSched<8, true> S{sch, gtab, F.G, F.vcu, (const LAS int*)(F.lds + UTAB_OFF)}; S.build(F.tid);
        { const int* etok = (const int*)(ws + WS_ETOK);
          int idx[17];
#pragma unroll
          for (int i = 0; i < 17; ++i) { pg8::Unit u; idx[i] = 0;
              if (S.next(i, u) && F.tid < 256) { const int slot = u.pm * 256 + F.tid; if (slot < u.cnt) idx[i] = etok[2 * ((size_t)u.e * M + slot)] >> 2; } }
          if (F.tid < 256) {
#pragma unroll
              for (int i = 0; i < 17; ++i) ((LAS unsigned short*)gtab)[i * 256 + F.tid] = (unsigned short)idx[i]; } }
        VM_WAIT(); __syncthreads();
        pg8::Gemm g{ws + WS_X1Q, ws + WS_W1, D, (size_t)FF * D};
        EpiMoe1 E{ws + WS_H, F.in[17], (const float*)(ws + WS_ERS), sch, args.noepi};
        pg8::gemm_phase<true>(F.lds + RING_OFF, g, S, E);
    }
    SEAM(7);
    if (IN(8)) {
        GroupSched<4, false> S{sch, nullptr, F.G, F.vcu, (const LAS int*)(F.lds + UTAB_OFF)}; S.build(F.tid);
        pg8::Gemm g{ws + WS_H, ws + WS_W2, FF, (size_t)pg8::HALF * FF};
        EpiMoe2 E{ws + WS_Y, F.in[19], (const pg8::u32x2*)(ws + WS_ETOK), args.noepi};
        pg8::gemm_phase<true>(F.lds + RING_OFF, g, S, E);
    }
    SEAM(8);
    if (IN(9)) {
        unsigned poison = (__hip_atomic_load(F.ctl + CW_TMO, RLX_AGENT) != 0u) | (__hip_atomic_load((gu32*)((const unsigned*)(F.ctl + CW_BAR) + XB_TMO), RLX_AGENT) != 0u);
        const unsigned char* Y = ws + WS_Y; typedef float f32x2_ __attribute__((ext_vector_type(2)));
        const int gw = F.vcu * NWAVES + F.wave, NGW = F.G * NWAVES;
        f32x4 gfin[2][2];
#pragma unroll
        for (int j = 0; j < 2; ++j) { gfin[j][0] = *(const f32x4*)(F.in[20] + 8 * F.lane + 512 * j); gfin[j][1] = *(const f32x4*)(F.in[20] + 8 * F.lane + 512 * j + 4); }
        for (int m0 = 2 * gw; m0 < M; m0 += 2 * NGW) {
            v4u xa[2][2]; pg8::u32x2 yv[2][2][4];
#pragma unroll
            for (int q = 0; q < 2; ++q)
#pragma unroll
                for (int j = 0; j < 2; ++j) { const size_t c0 = 8 * F.lane + 512 * j; xa[q][j] = __builtin_nontemporal_load((const v4u*)((const pg8::bf16_t*)(ws + WS_X1B) + (size_t)(m0 + q) * D + c0));
#pragma unroll
                    for (int k = 0; k < 4; ++k) yv[q][j][k] = __builtin_nontemporal_load((const pg8::u32x2*)(Y + ((size_t)(m0 + q) * 4 + k) * D + c0)); }
#pragma unroll
            for (int q = 0; q < 2; ++q) { const int m = m0 + q;
                float v[2][8]; float ss = 0.f;
#pragma unroll
                for (int j = 0; j < 2; ++j) { const v4u a = xa[q][j];
                    v[j][0] = pg8::bf_lo(a.x); v[j][1] = pg8::bf_hi(a.x); v[j][2] = pg8::bf_lo(a.y); v[j][3] = pg8::bf_hi(a.y); v[j][4] = pg8::bf_lo(a.z); v[j][5] = pg8::bf_hi(a.z); v[j][6] = pg8::bf_lo(a.w); v[j][7] = pg8::bf_hi(a.w);
#pragma unroll
                    for (int k = 0; k < 4; ++k) { const pg8::u32x2 y = yv[q][j][k]; const f32x2_ a0 = __builtin_amdgcn_cvt_pk_f32_fp8((int)y.x, false), a1 = __builtin_amdgcn_cvt_pk_f32_fp8((int)y.x, true), a2 = __builtin_amdgcn_cvt_pk_f32_fp8((int)y.y, false), a3 = __builtin_amdgcn_cvt_pk_f32_fp8((int)y.y, true);
                        v[j][0] += a0.x * (1.f / SY); v[j][1] += a0.y * (1.f / SY); v[j][2] += a1.x * (1.f / SY); v[j][3] += a1.y * (1.f / SY); v[j][4] += a2.x * (1.f / SY); v[j][5] += a2.y * (1.f / SY); v[j][6] += a3.x * (1.f / SY); v[j][7] += a3.y * (1.f / SY); }
#pragma unroll
                    for (int t = 0; t < 8; ++t) ss += v[j][t] * v[j][t]; }
                float rstd = 1.f / sqrtf(wave_sum(ss) * (1.f / D) + RMS_EPS);
                if (poison) rstd = __builtin_nanf("");
#pragma unroll
                for (int j = 0; j < 2; ++j) { const size_t c0 = 8 * F.lane + 512 * j; const f32x4 g0 = gfin[j][0], g1 = gfin[j][1];
                    *(f32x4*)(F.out + (size_t)m * D + c0) = (f32x4){v[j][0] * rstd * g0[0], v[j][1] * rstd * g0[1], v[j][2] * rstd * g0[2], v[j][3] * rstd * g0[3]};
                    *(f32x4*)(F.out + (size_t)m * D + c0 + 4) = (f32x4){v[j][4] * rstd * g1[0], v[j][5] * rstd * g1[1], v[j][6] * rstd * g1[2], v[j][7] * rstd * g1[3]}; } }
        }
    }
#undef IN
#undef SEAM
}

#ifndef MK_REP
#define MK_REP -1
#endif
#ifndef MK_NOEPI
#define MK_NOEPI 0
#endif
#ifndef MK_CUTS
#define MK_CUTS 1
#endif
extern "C" void kernel_launch(void* const* d_in, const int* in_sizes, int n_in, void* d_out, int out_size, void* d_ws, size_t ws_size, hipStream_t stream) {
    static int grid = 0;
    if (grid == 0) {
        if (n_in != 21 || in_sizes[0] != M * D || out_size != M * D || ws_size < WS_END) { fprintf(stderr, "kernel_launch: unexpected shapes / workspace (n_in %d, ws %zu)\n", n_in, ws_size); grid = -1; return; }
        int dev = 0, cus = 0, per_cu = 0;
        if (hipGetDevice(&dev) != hipSuccess || hipDeviceGetAttribute(&cus, hipDeviceAttributeMultiprocessorCount, dev) != hipSuccess) { grid = -1; return; }
        if (hipFuncSetAttribute((const void*)mk_fwd, hipFuncAttributeMaxDynamicSharedMemorySize, LDS_BYTES) != hipSuccess) { fprintf(stderr, "kernel_launch: hipFuncSetAttribute failed\n"); grid = -1; return; }
        if (hipOccupancyMaxActiveBlocksPerMultiprocessor(&per_cu, (const void*)mk_fwd, NWAVES * 64, LDS_BYTES) != hipSuccess || per_cu < 1) { fprintf(stderr, "kernel_launch: occupancy query says %d\n", per_cu); }
        (void)hipGetLastError();
        grid = cus;
    }
    if (grid < 0) return;
    if (hipMemsetAsync((char*)d_ws + WS_CTL, 0, CTL_ZERO_BYTES, stream) != hipSuccess) return;
    Args a{};
    for (int i = 0; i < 21; ++i) a.in[i] = (const float*)d_in[i];
    a.out = (float*)d_out; a.ws = (unsigned char*)d_ws;
    if (MK_CUTS == 1) { a.ph_lo = 0; a.ph_hi = N_PHASES; hipLaunchKernelGGL(mk_fwd, dim3(grid), dim3(NWAVES * 64), LDS_BYTES, stream, a); }
    else for (int p = 0; p < N_PHASES; ++p) { a.ph_lo = p; a.ph_hi = p + 1; hipLaunchKernelGGL(mk_fwd, dim3(grid), dim3(NWAVES * 64), LDS_BYTES, stream, a);
        if (p == MK_REP) { if (p == 6) (void)hipMemsetAsync((char*)d_ws + WS_CTL, 0, CTL_ZERO_BYTES, stream); a.noepi = MK_NOEPI; hipLaunchKernelGGL(mk_fwd, dim3(grid), dim3(NWAVES * 64), LDS_BYTES, stream, a); a.noepi = 0; } }
}
```
